# Optimizing an MI355X kernel written in HIP

```python
import jax, jax.numpy as jnp
from jax import lax
import numpy as np

D_MODEL = 2048
BATCH = 1
SEQ = 16384
DEPTH = 4
DEC_BATCH = 32
DEC_SEQ = 64
PAST_LEN = 4096

CHUNK = 64
N_MIXERS = 3
N_A = (DEPTH + 2) // 3
N_B = (DEPTH + 1) // 3
N_C = DEPTH // 3
NORM_EPS = 1e-5
D_FF = 4 * D_MODEL

ATTN_HEADS = 32
ATTN_KV_HEADS = 4
ATTN_GROUP = ATTN_HEADS // ATTN_KV_HEADS
HEAD_DIM = D_MODEL // ATTN_HEADS
WINDOW = 128
WINDOW_CHUNKS = WINDOW // CHUNK
ROT_DIM = HEAD_DIM // 4
ROPE_THETA = 500000.0
QKV_DIM = (ATTN_HEADS + 2 * ATTN_KV_HEADS) * HEAD_DIM

RET_HEADS = 8
RET_DK = D_MODEL // RET_HEADS
RET_DV = 2 * RET_DK
RET_THETA = 10000.0
RET_GN_EPS = 1e-5
RET_IN_DIM = 2 * RET_HEADS * RET_DK + 2 * RET_HEADS * RET_DV

RWKV_HS = 64
RWKV_HEADS = D_MODEL // RWKV_HS
DECAY_LORA = 96
AAA_LORA = 96
GATE_LORA = 256
RWKV_GN_EPS = 64e-5

kernel_name = 'hybrid_swa_retnet_rwkv7_stream_step'

f32 = jnp.float32


def rmsnorm(x, g):
    xf = x.astype(f32)
    y = xf * lax.rsqrt(jnp.mean(xf * xf, axis=-1, keepdims=True) + NORM_EPS)
    return (y * g).astype(x.dtype)


def rope(x, pos, rot_dim, theta):
    half = rot_dim // 2
    inv = theta ** (-jnp.arange(half, dtype=f32) / half)
    ang = pos.astype(f32)[:, None] * inv[None, :]
    cos = jnp.cos(ang)[:, None, :]
    sin = jnp.sin(ang)[:, None, :]
    xf = x.astype(f32)
    x1, x2 = xf[..., :half], xf[..., half:rot_dim]
    out = jnp.concatenate([x1 * cos - x2 * sin, x2 * cos + x1 * sin, xf[..., rot_dim:]], axis=-1)
    return out.astype(x.dtype)


def sq_relu_mlp(h, w_up, w_down):
    return jnp.square(jax.nn.relu(h @ w_up)) @ w_down


def attn_qkv(h, w_qkv, pos):
    B, T, _ = h.shape
    qkv = h @ w_qkv
    qd, kd = ATTN_HEADS * HEAD_DIM, ATTN_KV_HEADS * HEAD_DIM
    q = qkv[..., :qd].reshape(B, T, ATTN_HEADS, HEAD_DIM)
    k = qkv[..., qd:qd + kd].reshape(B, T, ATTN_KV_HEADS, HEAD_DIM)
    v = qkv[..., qd + kd:].reshape(B, T, ATTN_KV_HEADS, HEAD_DIM)
    return rope(q, pos, ROT_DIM, ROPE_THETA), rope(k, pos, ROT_DIM, ROPE_THETA), v


def sink_attend(q, k, v, sinks, mask):
    s = jnp.einsum('bnqkgd,bnskd->bnkgqs', q, k).astype(f32) * (HEAD_DIM ** -0.5)
    if mask is not None:
        s = jnp.where(mask, s, -jnp.inf)
    sink = jnp.broadcast_to(sinks.astype(f32).reshape(ATTN_KV_HEADS, ATTN_GROUP, 1, 1), s.shape[:-1] + (1,))
    p = jax.nn.softmax(jnp.concatenate([s, sink], axis=-1), axis=-1)[..., :-1]
    return jnp.einsum('bnkgqs,bnskd->bnqkgd', p.astype(v.dtype), v)


def attn_prompt(h, w_qkv, sinks, w_o):
    B, T, _ = h.shape
    nc = T // CHUNK
    q, k, v = attn_qkv(h, w_qkv, jnp.arange(T))
    qc = q.reshape(B, nc, CHUNK, ATTN_KV_HEADS, ATTN_GROUP, HEAD_DIM)

    def band(x):
        xp = jnp.concatenate([jnp.zeros((B, WINDOW, ATTN_KV_HEADS, HEAD_DIM), x.dtype), x], axis=1)
        xp = xp.reshape(B, nc + WINDOW_CHUNKS, CHUNK, ATTN_KV_HEADS, HEAD_DIM)
        return jnp.concatenate([xp[:, j:j + nc] for j in range(WINDOW_CHUNKS + 1)], axis=2)

    kb, vb = band(k), band(v)
    key_chunk = jnp.arange(nc)[:, None] + jnp.arange((WINDOW_CHUNKS + 1) * CHUNK)[None, :] // CHUNK - WINDOW_CHUNKS
    mask = (key_chunk >= 0)[None, :, None, None, None, :]
    o = sink_attend(qc, kb, vb, sinks, mask).reshape(B, T, ATTN_HEADS * HEAD_DIM)
    return o @ w_o, k[:, -WINDOW:], v[:, -WINDOW:]


def attn_sample(h, cache_k, cache_v, w_qkv, sinks, w_o):
    B, T, _ = h.shape
    q, k, v = attn_qkv(h, w_qkv, PAST_LEN + jnp.arange(T))
    k_all = jnp.concatenate([cache_k.astype(k.dtype), k], axis=1)
    v_all = jnp.concatenate([cache_v.astype(v.dtype), v], axis=1)
    qc = q.reshape(B, 1, T, ATTN_KV_HEADS, ATTN_GROUP, HEAD_DIM)
    o = sink_attend(qc, k_all[:, None], v_all[:, None], sinks, None).reshape(B, T, ATTN_HEADS * HEAD_DIM)
    return o @ w_o, k_all[:, -WINDOW:], v_all[:, -WINDOW:]


def ret_project(h, w_in, pos):
    B, T, _ = h.shape
    proj = h @ w_in
    qd, vd = RET_HEADS * RET_DK, RET_HEADS * RET_DV
    q = proj[..., :qd].reshape(B, T, RET_HEADS, RET_DK)
    k = proj[..., qd:2 * qd].reshape(B, T, RET_HEADS, RET_DK)
    v = proj[..., 2 * qd:2 * qd + vd].reshape(B, T, RET_HEADS, RET_DV)
    g = proj[..., 2 * qd + vd:]
    q = rope(q, pos, RET_DK, RET_THETA)
    k = rope(k, pos, RET_DK, RET_THETA) * (RET_DK ** -0.5)
    return q, k, v, g


def retention_chunk(S, q, k, v):
    L = q.shape[1]
    lg = jnp.log1p(-jnp.exp2(-5.0 - jnp.arange(RET_HEADS, dtype=f32)))
    idx = jnp.arange(L, dtype=f32)
    diff = idx[:, None] - idx[None, :]
    decay = jnp.where(diff >= 0, jnp.exp(lg[:, None, None] * jnp.maximum(diff, 0.0)[None]), 0.0)
    qf, kf, vf = q.astype(f32), k.astype(f32), v.astype(f32)
    scores = jnp.einsum('blhd,bmhd->bhlm', qf, kf) * decay[None]
    xi = jnp.exp(lg[None, :] * (idx + 1.0)[:, None])
    zeta = jnp.exp(lg[None, :] * (L - 1.0 - idx)[:, None])
    o = jnp.einsum('bhlm,bmhe->blhe', scores, vf) + jnp.einsum('blhd,bhde->blhe', qf * xi[None, :, :, None], S)
    S_new = jnp.exp(lg * L)[None, :, None, None] * S + jnp.einsum('blhd,blhe->bhde', kf * zeta[None, :, :, None], vf)
    return S_new, o


def ret_output(o, g, gn_w, w_o):
    B, T = o.shape[:2]
    mu = jnp.mean(o, axis=-1, keepdims=True)
    var = jnp.mean(jnp.square(o - mu), axis=-1, keepdims=True)
    on = ((o - mu) * lax.rsqrt(var + RET_GN_EPS)).reshape(B, T, RET_HEADS * RET_DV) * gn_w
    return (jax.nn.silu(g.astype(f32)) * on).astype(g.dtype) @ w_o


def retention_prompt(h, w_in, gn_w, w_o):
    B, T, _ = h.shape
    nc = T // CHUNK
    q, k, v, g = ret_project(h, w_in, jnp.arange(T))
    to_chunks = lambda x: jnp.moveaxis(x.reshape((B, nc, CHUNK) + x.shape[2:]), 1, 0)
    S0 = jnp.zeros((B, RET_HEADS, RET_DK, RET_DV), f32)
    S, o = lax.scan(lambda s, qkv: retention_chunk(s, *qkv), S0, (to_chunks(q), to_chunks(k), to_chunks(v)))
    o = jnp.moveaxis(o, 0, 1).reshape(B, T, RET_HEADS, RET_DV)
    return ret_output(o, g, gn_w, w_o), S.astype(h.dtype)


def retention_sample(h, S_prev, w_in, gn_w, w_o):
    T = h.shape[1]
    q, k, v, g = ret_project(h, w_in, PAST_LEN + jnp.arange(T))
    S, o = retention_chunk(S_prev.astype(f32), q, k, v)
    return ret_output(o, g, gn_w, w_o), S.astype(S_prev.dtype)


def rwkv_mix(h, shift_prev, S0, mu, w_rkv, w_o, w0, w1, w2, a0, a1, a2, g1, g2, k_k, k_a, r_k, ln_w, ln_b):
    B, T, D = h.shape
    x_prev = jnp.concatenate([shift_prev[:, None].astype(h.dtype), h[:, :-1]], axis=1)
    xx = x_prev - h
    lerp = lambda i: h + xx * mu[i]
    r = lerp(0) @ w_rkv[0]
    k = lerp(2) @ w_rkv[1]
    v = lerp(3) @ w_rkv[2]
    w_log = -jax.nn.softplus(-(w0 + jnp.tanh(lerp(1) @ w1) @ w2).astype(f32)) - 0.5
    a = jax.nn.sigmoid((a0 + (lerp(4) @ a1) @ a2).astype(f32))
    g = jax.nn.sigmoid(lerp(5) @ g1) @ g2
    heads = lambda x: x.astype(f32).reshape(B, T, RWKV_HEADS, RWKV_HS)
    per_head = lambda p: p.astype(f32).reshape(RWKV_HEADS, RWKV_HS)
    r, k, v, a = heads(r), heads(k), heads(v), heads(a)
    decay = jnp.exp(-jnp.exp(heads(w_log)))
    kk = k * per_head(k_k)
    kk = kk / jnp.maximum(jnp.sqrt(jnp.sum(kk * kk, axis=-1, keepdims=True)), 1e-12)
    k = k * (1.0 + (a - 1.0) * per_head(k_a))

    def step(S, inp):
        r_t, k_t, v_t, w_t, kk_t, a_t = inp
        S = (S * w_t[:, :, None, :]
             + jnp.einsum('bhvk,bhk->bhv', S, -kk_t)[..., None] * (kk_t * a_t)[:, :, None, :]
             + v_t[..., None] * k_t[:, :, None, :])
        return S, jnp.einsum('bhvk,bhk->bhv', S, r_t)

    xs = tuple(jnp.moveaxis(t, 1, 0) for t in (r, k, v, decay, kk, a))
    S, o = lax.scan(step, S0.astype(f32), xs)
    o = jnp.moveaxis(o, 0, 1)
    mu_o = jnp.mean(o, axis=-1, keepdims=True)
    var_o = jnp.mean(jnp.square(o - mu_o), axis=-1, keepdims=True)
    on = ((o - mu_o) * lax.rsqrt(var_o + RWKV_GN_EPS)).reshape(B, T, D) * ln_w + ln_b
    bonus = (jnp.sum(r * k * r_k.astype(f32), axis=-1, keepdims=True) * v).reshape(B, T, D)
    out = ((on + bonus) * g.astype(f32)).astype(h.dtype) @ w_o
    return out, h[:, -1], S.astype(S0.dtype)


def setup_inputs(seed: int = 0) -> dict:
    key = jax.random.key(seed)
    ks = iter(jax.random.split(key, 48))

    def nrm(shape, scale):
        return jax.random.normal(next(ks), shape, f32) * scale

    def gain(shape):
        return 1.0 + nrm(shape, 0.02)

    D = D_MODEL
    return {
        'x_prompt': nrm((BATCH, SEQ, D), 1.0),
        'x_sample': nrm((DEC_BATCH, DEC_SEQ, D), 1.0),
        'cache_attn_k': nrm((N_A, DEC_BATCH, WINDOW, ATTN_KV_HEADS, HEAD_DIM), 1.0),
        'cache_attn_v': nrm((N_A, DEC_BATCH, WINDOW, ATTN_KV_HEADS, HEAD_DIM), 1.0),
        'state_ret': nrm((N_B, DEC_BATCH, RET_HEADS, RET_DK, RET_DV), 1.0),
        'state_rwkv': nrm((N_C, DEC_BATCH, RWKV_HEADS, RWKV_HS, RWKV_HS), 0.2),
        'state_rwkv_shift': nrm((N_C, DEC_BATCH, D), 1.0),
        'norm_mix': gain((DEPTH, D)),
        'norm_mlp': gain((DEPTH, D)),
        'norm_final': gain((D,)),
        'attn_w_qkv': nrm((N_A, D, QKV_DIM), D ** -0.5),
        'attn_sinks': nrm((N_A, ATTN_HEADS), 1.0),
        'attn_w_o': nrm((N_A, ATTN_HEADS * HEAD_DIM, D), (ATTN_HEADS * HEAD_DIM) ** -0.5),
        'ret_w_in': nrm((N_B, D, RET_IN_DIM), D ** -0.5),
        'ret_gn_w': gain((N_B, RET_HEADS * RET_DV)),
        'ret_w_o': nrm((N_B, RET_HEADS * RET_DV, D), (RET_HEADS * RET_DV) ** -0.5),
        'rwkv_mu': jax.random.uniform(next(ks), (N_C, 6, D), f32),
        'rwkv_w_rkv': nrm((N_C, 3, D, D), D ** -0.5),
        'rwkv_w_o': nrm((N_C, D, D), D ** -0.5),
        'rwkv_w0': -2.0 + nrm((N_C, D), 0.5),
        'rwkv_w1': nrm((N_C, D, DECAY_LORA), D ** -0.5),
        'rwkv_w2': nrm((N_C, DECAY_LORA, D), 0.5 * DECAY_LORA ** -0.5),
        'rwkv_a0': nrm((N_C, D), 0.1),
        'rwkv_a1': nrm((N_C, D, AAA_LORA), D ** -0.5),
        'rwkv_a2': nrm((N_C, AAA_LORA, D), 0.5 * AAA_LORA ** -0.5),
        'rwkv_g1': nrm((N_C, D, GATE_LORA), D ** -0.5),
        'rwkv_g2': nrm((N_C, GATE_LORA, D), GATE_LORA ** -0.5),
        'rwkv_k_k': 0.85 + nrm((N_C, D), 0.05),
        'rwkv_k_a': 1.0 + nrm((N_C, D), 0.05),
        'rwkv_r_k': nrm((N_C, RWKV_HEADS, RWKV_HS), 0.1),
        'rwkv_ln_w': gain((N_C, D)),
        'rwkv_ln_b': nrm((N_C, D), 0.02),
        'mlp_w_up': nrm((DEPTH, D, D_FF), D ** -0.5),
        'mlp_w_down': nrm((DEPTH, D_FF, D), D_FF ** -0.5),
    }


def reference(x_prompt, x_sample, cache_attn_k, cache_attn_v, state_ret, state_rwkv, state_rwkv_shift,
              norm_mix, norm_mlp, norm_final,
              attn_w_qkv, attn_sinks, attn_w_o,
              ret_w_in, ret_gn_w, ret_w_o,
              rwkv_mu, rwkv_w_rkv, rwkv_w_o, rwkv_w0, rwkv_w1, rwkv_w2, rwkv_a0, rwkv_a1, rwkv_a2,
              rwkv_g1, rwkv_g2, rwkv_k_k, rwkv_k_a, rwkv_r_k, rwkv_ln_w, rwkv_ln_b,
              mlp_w_up, mlp_w_down):
    xp, xs = x_prompt, x_sample
    kp_l, vp_l, ks_l, vs_l = [], [], [], []
    rp_l, rs_l = [], []
    wp_l, ws_l, shp_l, shs_l = [], [], [], []
    for i in range(DEPTH):
        hp, hs = rmsnorm(xp, norm_mix[i]), rmsnorm(xs, norm_mix[i])
        j = i // N_MIXERS
        kind = i % N_MIXERS
        if kind == 0:
            mp, kp, vp = attn_prompt(hp, attn_w_qkv[j], attn_sinks[j], attn_w_o[j])
            ms, ks_, vs_ = attn_sample(hs, cache_attn_k[j], cache_attn_v[j], attn_w_qkv[j], attn_sinks[j], attn_w_o[j])
            kp_l.append(kp); vp_l.append(vp); ks_l.append(ks_); vs_l.append(vs_)
        elif kind == 1:
            mp, Sp = retention_prompt(hp, ret_w_in[j], ret_gn_w[j], ret_w_o[j])
            ms, Ss = retention_sample(hs, state_ret[j], ret_w_in[j], ret_gn_w[j], ret_w_o[j])
            rp_l.append(Sp); rs_l.append(Ss)
        else:
            prm = (rwkv_mu[j], rwkv_w_rkv[j], rwkv_w_o[j], rwkv_w0[j], rwkv_w1[j], rwkv_w2[j],
                   rwkv_a0[j], rwkv_a1[j], rwkv_a2[j], rwkv_g1[j], rwkv_g2[j],
                   rwkv_k_k[j], rwkv_k_a[j], rwkv_r_k[j], rwkv_ln_w[j], rwkv_ln_b[j])
            Bp = hp.shape[0]
            mp, shp, Sp = rwkv_mix(hp, jnp.zeros((Bp, D_MODEL), hp.dtype),
                                   jnp.zeros((Bp, RWKV_HEADS, RWKV_HS, RWKV_HS), state_rwkv.dtype), *prm)
            ms, shs, Ss = rwkv_mix(hs, state_rwkv_shift[j], state_rwkv[j], *prm)
            wp_l.append(Sp); ws_l.append(Ss); shp_l.append(shp); shs_l.append(shs)
        xp = xp + mp
        xs = xs + ms
        xp = xp + sq_relu_mlp(rmsnorm(xp, norm_mlp[i]), mlp_w_up[i], mlp_w_down[i])
        xs = xs + sq_relu_mlp(rmsnorm(xs, norm_mlp[i]), mlp_w_up[i], mlp_w_down[i])
    y_prompt = rmsnorm(xp, norm_final)
    y_sample = rmsnorm(xs, norm_final)
    return (y_prompt, y_sample,
            jnp.stack(kp_l), jnp.stack(vp_l), jnp.stack(ks_l), jnp.stack(vs_l),
            jnp.stack(rp_l), jnp.stack(rs_l),
            jnp.stack(wp_l), jnp.stack(ws_l), jnp.stack(shp_l), jnp.stack(shs_l))
```

```cpp
#include <hip/hip_runtime.h>
#include <cstdio>
#include <cstdint>

#ifndef MK_PER_PHASE
#define MK_PER_PHASE 0
#endif

#define GAS __attribute__((address_space(1)))
#define LAS __attribute__((address_space(3)))
#define DI __device__ __forceinline__
typedef unsigned short bf16_t;
typedef short bf16x8 __attribute__((ext_vector_type(8)));
typedef short s16x4 __attribute__((ext_vector_type(4)));
typedef float f32x2 __attribute__((ext_vector_type(2)));
typedef float f32x4 __attribute__((ext_vector_type(4)));
typedef float f32x16 __attribute__((ext_vector_type(16)));
typedef unsigned u32x2 __attribute__((ext_vector_type(2)));
typedef unsigned u32x4 __attribute__((ext_vector_type(4)));
typedef __bf16 bf16x2_t __attribute__((ext_vector_type(2)));
typedef GAS unsigned gu32;

DI unsigned pk2(float lo, float hi) { f32x2 v = {lo, hi}; bf16x2_t b = __builtin_convertvector(v, bf16x2_t); return __builtin_bit_cast(unsigned, b); }
DI float bf2f(unsigned short u) { return __builtin_bit_cast(float, (unsigned)u << 16); }
DI float bflo(unsigned u) { return __builtin_bit_cast(float, u << 16); }
DI float bfhi(unsigned u) { return __builtin_bit_cast(float, u & 0xffff0000u); }
DI unsigned short f2bf(float f) { return (unsigned short)(pk2(f, 0.f) & 0xffffu); }
DI float wave_sum(float v) {
#pragma unroll
    for (int o = 1; o < 64; o <<= 1) v += __shfl_xor(v, o);
    return v;
}
DI float wave_sum_fast(float v) {
#define DPP_ADD_(ctrl) v += __builtin_bit_cast(float, __builtin_amdgcn_update_dpp(0, __builtin_bit_cast(int, v), ctrl, 0xf, 0xf, true));
    DPP_ADD_(0xB1) DPP_ADD_(0x4E) DPP_ADD_(0x141) DPP_ADD_(0x140)
#undef DPP_ADD_
    const int iv = __builtin_bit_cast(int, v);
    return (__builtin_bit_cast(float, __builtin_amdgcn_readlane(iv, 0)) + __builtin_bit_cast(float, __builtin_amdgcn_readlane(iv, 16))) + (__builtin_bit_cast(float, __builtin_amdgcn_readlane(iv, 32)) + __builtin_bit_cast(float, __builtin_amdgcn_readlane(iv, 48)));
}
DI float wave_max(float v) {
#pragma unroll
    for (int o = 1; o < 64; o <<= 1) v = fmaxf(v, __shfl_xor(v, o));
    return v;
}
DI void st16_wt(void* p, u32x4 v) { asm volatile("global_store_dwordx4 %0, %1, off sc1\n\ts_nop 1" :: "v"(p), "v"(v) : "memory"); }
DI void st8_wt(void* p, u32x2 v) { asm volatile("global_store_dwordx2 %0, %1, off sc1\n\ts_nop 1" :: "v"(p), "v"(v) : "memory"); }
DI int lane_now() { int l_; asm volatile("v_mbcnt_lo_u32_b32 %0, -1, 0\n\tv_mbcnt_hi_u32_b32 %0, -1, %0" : "=v"(l_)); return l_; }
#define MFMA32(a, b, c) __builtin_amdgcn_mfma_f32_32x32x16_bf16((a), (b), (c), 0, 0, 0)
#define LDS_WAIT() asm volatile("s_waitcnt lgkmcnt(0)" ::: "memory")
#define VM_WAIT() asm volatile("s_waitcnt vmcnt(0)" ::: "memory")
#define LDS_BARRIER() asm volatile("s_waitcnt lgkmcnt(0)\n\ts_barrier" ::: "memory")

constexpr int DM = 2048, SEQ = 16384, DBATCH = 32, DSEQ = 64, PAST = 4096;
constexpr int MP = SEQ, MS = DBATCH * DSEQ, M = MP + MS;
constexpr int NCHP = SEQ / 64, NCH = M / 64;
constexpr int DFF = 8192;
constexpr int AH = 32, AKV = 4, AHD = 64, AQKV = 2560, AWIN = 128;
constexpr int RH = 8, RDK = 256, RDV = 512, RIN = 12288, RVD = RH * RDV;
constexpr int WH = 32, WN = 64;
constexpr float NORM_EPS = 1e-5f;

namespace pg8 {
#define PG8_LAS __attribute__((address_space(3)))
#define PG8_GAS __attribute__((address_space(1)))
constexpr int BM = 256, BK = 64, HALF = 128, HTB = HALF * BK * 2  , STAGE_BYTES = 8 * HTB, NXCD = 8, WGM = 8;
__host__ __device__ __forceinline__ int lds_byte(int r, int c) { const int st = (r >> 4) * 2 + (c >> 5), rr = r & 15, cc = c & 31, ob = rr * 64 + cc * 2; return st * 1024 + (ob ^ (((ob >> 9) & 1) << 5)); }
__host__ __device__ __forceinline__ void stage_rc(int b, int& R, int& C) { const int st = b / 1024, sb = b % 1024, swz = sb ^ (((sb >> 9) & 1) << 5); R = (st >> 1) * 16 + swz / 64; C = (st & 1) * 32 + (swz % 64) / 2; }
__host__ __device__ __forceinline__ int perm32(int rho) { const int n = rho >> 4, i = rho & 15; return 8 * (i >> 2) + 4 * n + (i & 3); }

struct Unit { int pm, pn, z, i, ks; };
struct Gemm { const bf16_t* A; const bf16_t* Bt; int M, N, K; size_t zA, zB; };
constexpr int SK_LDS_OFF = 163840 - 512 + 320 + 96;

struct Order {
    int nM, nN, nz, per, G, c; long tot;
    __device__ __forceinline__ void init(int M, int N, int nz_, int G_, int c_) { nM = M / BM; nN = N / BM; nz = nz_; per = nM * nN; G = G_; c = c_; tot = (long)per * nz; }
    __device__ __forceinline__ bool split_ok() const { const int rem = per % G; return nz == 1 && rem > 0 && rem * 4 == G; }
    __device__ __forceinline__ void init_full_rounds(int M, int N, int G_, int c_) { init(M, N, 1, G_, c_); if (split_ok()) tot = (long)(per / G) * G; }
    __device__ __forceinline__ void map(long L, Unit& u) const {
        u.z = (int)(L / per); int wgid = (int)(L % per);
        { const int q = per / NXCD, r = per % NXCD, xcd = wgid % NXCD, off = wgid / NXCD; wgid = (xcd < r ? xcd * (q + 1) : r * (q + 1) + (xcd - r) * q) + off; }
        const int nig = WGM * nN, gid = wgid / nig, fm = gid * WGM, gsz = (nM - fm) < WGM ? (nM - fm) : WGM;
        u.pm = fm + ((wgid % nig) % gsz); u.pn = (wgid % nig) / gsz;
    }
    __device__ __forceinline__ bool next(int i, Unit& u) const {
        const long L = (long)i * G + c; if (L >= tot) return false;
        u.i = i; u.ks = 0; map(L, u); return true;
    }
};
struct OrderSK {
    Order o; int G, c;
    __device__ __forceinline__ void init(int M, int N, int G_, int c_) { o.init(M, N, 1, G_, c_); G = G_; c = c_; }
    __device__ __forceinline__ bool next(int i, Unit& u) const {
        if (i != 0 || !o.split_ok()) return false;
        const int rem = G >> 2; u.i = o.per / G; u.ks = c / rem; o.map((long)u.i * G + c % rem, u); return true;
    }
};
template <class Epi, bool ALIGN_EPI = true, bool SP2 = true, bool SPLITK = false, class Ord = Order>
__device__ __forceinline__ void gemm_phase(PG8_LAS unsigned char* lds, const Gemm g, const Ord& S, const Epi& E, int wave_id) {
    const int wid = wave_id, lane = lane_now(), tid = wid * 64 + lane, wr = wid >> 2, wc = wid & 3, fr = lane & 15, fq = lane >> 4;
    const int K = g.K; int nt = SPLITK ? K / BK / 4 : K / BK;
    if constexpr (SPLITK) asm volatile("" : "+s"(nt));
    unsigned voffA[2], voffB[2];
#pragma unroll
    for (int i = 0; i < 2; ++i) { int R, C; stage_rc(tid * 16 + i * 8192, R, C); const int Rb = Epi::PERM ? ((R & ~31) + perm32(R & 31)) : R;
        voffA[i] = (unsigned)(R * K + C) * 2u; voffB[i] = (unsigned)(Rb * K + C) * 2u; }
    const size_t kstep = (size_t)(BK * 2);
    const size_t hstep = (size_t)HALF * K * 2;
    const size_t tstep = 2 * hstep;
    const unsigned ldsw = (unsigned)wid * 1024u;
    const int aoff = lds_byte(wr * 64 + fr, fq * 8), boff = lds_byte(wc * 32 + fr, fq * 8);
#define PG8_SA(b, h) (((b) * 2 + (h)) * HTB)
#define PG8_SB(b, h) ((4 + (b) * 2 + (h)) * HTB)
#define PG8_STAGE(bufoff, gbase, voff) do { _Pragma("unroll") for (int _i = 0; _i < 2; ++_i) \
        __builtin_amdgcn_global_load_lds((const unsigned*)((const char*)(gbase) + (voff)[_i]), (PG8_LAS unsigned*)(lds + (bufoff) + ldsw + _i * 8192), 16, 0, 0); } while (0)
#define PG8_LDA(dst, b, h) do { _Pragma("unroll") for (int m = 0; m < 4; ++m) _Pragma("unroll") for (int k = 0; k < 2; ++k) dst[m][k] = *(const PG8_LAS bf16x8*)(lds + PG8_SA(b, h) + aoff + m * 2048 + k * 1024); } while (0)
#define PG8_LDB(dst, b, h) do { _Pragma("unroll") for (int n = 0; n < 2; ++n) _Pragma("unroll") for (int k = 0; k < 2; ++k) dst[n][k] = *(const PG8_LAS bf16x8*)(lds + PG8_SB(b, h) + boff + n * 2048 + k * 1024); } while (0)
#define PG8_MMA(ai, bj, At, Bt) do { __builtin_amdgcn_s_setprio(1); _Pragma("unroll") for (int m = 0; m < 4; ++m) _Pragma("unroll") for (int n = 0; n < 2; ++n) _Pragma("unroll") for (int k = 0; k < 2; ++k) \
        acc[ai][bj][m][n] = __builtin_amdgcn_mfma_f32_16x16x32_bf16(Bt[n][k], At[m][k], acc[ai][bj][m][n], 0, 0, 0); __builtin_amdgcn_s_setprio(0); } while (0)
#define PG8_WAIT_V(n) asm volatile("s_waitcnt vmcnt(" #n ")" ::: "memory")
#define PG8_WAIT_L(n) asm volatile("s_waitcnt lgkmcnt(" #n ")" ::: "memory")
#define PG8_BAR __builtin_amdgcn_s_barrier()
#define PG8_SCHED __builtin_amdgcn_sched_barrier(0)
    Unit cur, nxt; int ui = 0;
    if (!S.next(0, cur)) return;
    f32x4 acc[2][2][4][2];
#pragma unroll
    for (int a = 0; a < 2; ++a)
#pragma unroll
        for (int b = 0; b < 2; ++b)
#pragma unroll
            for (int m = 0; m < 4; ++m)
#pragma unroll
                for (int n = 0; n < 2; ++n) acc[a][b][m][n] = (f32x4){0.f, 0.f, 0.f, 0.f};
    bf16x8 At[4][2], B0[2][2], B1[2][2];
#define PG8_KOFF(u) (SPLITK ? (size_t)(u).ks * (size_t)nt * kstep : (size_t)0)
    const char* cA = (const char*)g.A + (size_t)cur.z * g.zA + (size_t)cur.pm * tstep + PG8_KOFF(cur); const char* cB = (const char*)g.Bt + (size_t)cur.z * g.zB + (size_t)cur.pn * tstep + PG8_KOFF(cur);
    if constexpr (SP2) {
        PG8_STAGE(PG8_SB(0, 0), cB, voffB); PG8_STAGE(PG8_SB(0, 1), cB + hstep, voffB); PG8_STAGE(PG8_SA(0, 0), cA, voffA); PG8_STAGE(PG8_SA(0, 1), cA + hstep, voffA);
        if (wr == 1) PG8_BAR;
        PG8_WAIT_V(2); PG8_BAR;
        PG8_STAGE(PG8_SB(1, 0), cB + kstep, voffB); PG8_STAGE(PG8_SA(1, 0), cA + kstep, voffA); PG8_STAGE(PG8_SB(1, 1), cB + hstep + kstep, voffB);
        PG8_WAIT_V(6); PG8_BAR;
    } else {
        PG8_STAGE(PG8_SB(0, 0), cB, voffB); PG8_STAGE(PG8_SA(0, 0), cA, voffA); PG8_STAGE(PG8_SB(0, 1), cB + hstep, voffB); PG8_STAGE(PG8_SA(0, 1), cA + hstep, voffA);
        if (wr == 1) PG8_BAR;
        PG8_WAIT_V(4); PG8_BAR;
        PG8_STAGE(PG8_SB(1, 0), cB + kstep, voffB); PG8_STAGE(PG8_SA(1, 0), cA + kstep, voffA); PG8_STAGE(PG8_SB(1, 1), cB + hstep + kstep, voffB);
        PG8_WAIT_V(6); PG8_BAR;
    }
    for (;;) {
        const bool has_next = S.next(ui + 1, nxt);
        const char* nA = has_next ? (const char*)g.A + (size_t)nxt.z * g.zA + (size_t)nxt.pm * tstep : cA; const char* nB = has_next ? (const char*)g.Bt + (size_t)nxt.z * g.zB + (size_t)nxt.pn * tstep : cB;
        for (int t = 0; t < nt; t += 2) {
            const bool last = (t == nt - 2);
            const char* a1 = cA + (size_t)(t + 1) * kstep;
            const char* a2 = last ? nA : cA + (size_t)(t + 2) * kstep; const char* b2 = last ? nB : cB + (size_t)(t + 2) * kstep;
            const char* a3 = a2 + kstep; const char* b3 = b2 + kstep;
            if constexpr (SP2) {
            PG8_LDB(B0, 0, 0); PG8_LDB(B1, 0, 1); PG8_SCHED; PG8_LDA(At, 0, 0); PG8_STAGE(PG8_SA(1, 1), a1 + hstep, voffA);
            PG8_WAIT_V(8); PG8_WAIT_L(0); PG8_BAR; PG8_MMA(0, 0, At, B0); PG8_MMA(0, 1, At, B1); PG8_BAR; PG8_SCHED;
            PG8_LDA(At, 0, 1); PG8_STAGE(PG8_SB(0, 0), b2, voffB); PG8_STAGE(PG8_SB(0, 1), b2 + hstep, voffB); PG8_STAGE(PG8_SA(0, 0), a2, voffA);
            PG8_WAIT_V(8); PG8_WAIT_L(0); PG8_BAR; PG8_MMA(1, 0, At, B0); PG8_MMA(1, 1, At, B1); PG8_BAR; PG8_SCHED;
            PG8_LDB(B0, 1, 0); PG8_LDB(B1, 1, 1); PG8_SCHED; PG8_LDA(At, 1, 0); PG8_STAGE(PG8_SA(0, 1), a2 + hstep, voffA);
            PG8_WAIT_V(8); PG8_WAIT_L(0); PG8_BAR; PG8_MMA(0, 0, At, B0); PG8_MMA(0, 1, At, B1); PG8_BAR; PG8_SCHED;
            PG8_LDA(At, 1, 1); PG8_STAGE(PG8_SB(1, 0), b3, voffB); PG8_STAGE(PG8_SB(1, 1), b3 + hstep, voffB); PG8_STAGE(PG8_SA(1, 0), a3, voffA);
            PG8_WAIT_V(8); PG8_WAIT_L(0); PG8_BAR; PG8_MMA(1, 0, At, B0); PG8_MMA(1, 1, At, B1); PG8_BAR; PG8_SCHED;
            } else {
            PG8_LDB(B0, 0, 0); PG8_SCHED; PG8_LDA(At, 0, 0); PG8_STAGE(PG8_SA(1, 1), a1 + hstep, voffA);
            PG8_WAIT_L(8); PG8_BAR; PG8_WAIT_L(0); PG8_MMA(0, 0, At, B0); PG8_BAR; PG8_SCHED;
            PG8_LDB(B1, 0, 1); PG8_STAGE(PG8_SB(0, 0), b2, voffB);
            PG8_BAR; PG8_WAIT_L(0); PG8_MMA(0, 1, At, B1); PG8_BAR;
            PG8_LDA(At, 0, 1); PG8_STAGE(PG8_SA(0, 0), a2, voffA);
            PG8_BAR; PG8_WAIT_L(0); PG8_MMA(1, 0, At, B0); PG8_BAR; PG8_SCHED;
            PG8_STAGE(PG8_SB(0, 1), b2 + hstep, voffB);
            PG8_WAIT_V(6); PG8_BAR; PG8_MMA(1, 1, At, B1); PG8_BAR;
            PG8_LDB(B0, 1, 0); PG8_SCHED; PG8_LDA(At, 1, 0); PG8_STAGE(PG8_SA(0, 1), a2 + hstep, voffA);
            PG8_WAIT_L(8); PG8_BAR; PG8_WAIT_L(0); PG8_MMA(0, 0, At, B0); PG8_BAR; PG8_SCHED;
            PG8_LDB(B1, 1, 1); PG8_STAGE(PG8_SB(1, 0), b3, voffB);
            PG8_BAR; PG8_WAIT_L(0); PG8_MMA(0, 1, At, B1); PG8_BAR;
            PG8_LDA(At, 1, 1); PG8_STAGE(PG8_SA(1, 0), a3, voffA);
            PG8_BAR; PG8_WAIT_L(0); PG8_MMA(1, 0, At, B0); PG8_BAR; PG8_SCHED;
            PG8_STAGE(PG8_SB(1, 1), b3 + hstep, voffB);
            PG8_WAIT_V(6); PG8_BAR; PG8_MMA(1, 1, At, B1); PG8_BAR;
            }
        }
        if constexpr (ALIGN_EPI) { if (wr == 0) PG8_BAR; }
        E(acc, cur, wr, wc, fr, fq);
        if (!has_next) break;
#pragma unroll
        for (int a = 0; a < 2; ++a)
#pragma unroll
            for (int b = 0; b < 2; ++b)
#pragma unroll
                for (int m = 0; m < 4; ++m)
#pragma unroll
                    for (int n = 0; n < 2; ++n) acc[a][b][m][n] = (f32x4){0.f, 0.f, 0.f, 0.f};
        cur = nxt; cA = nA; cB = nB; ++ui;
        if constexpr (ALIGN_EPI) { if (wr == 1) PG8_BAR; }
    }
    PG8_WAIT_V(0);
    if constexpr (!ALIGN_EPI) { if (wr == 0) PG8_BAR; }
    PG8_BAR;
#undef PG8_KOFF
#undef PG8_SA
#undef PG8_SB
#undef PG8_STAGE
#undef PG8_LDA
#undef PG8_LDB
#undef PG8_MMA
#undef PG8_WAIT_V
#undef PG8_WAIT_L
#undef PG8_BAR
#undef PG8_SCHED
}
}
namespace pg8 {
DI float act_apply(float x, int act) {
    if (act == 1) { const float r = fmaxf(x, 0.f); return r * r; }
    if (act == 2) { return 1.f - 2.f / (__expf(2.f * x) + 1.f); }
    if (act == 3) { return 1.f / (1.f + __expf(-x)); }
    return x;
}
constexpr int RSTAB_OFF = 131072, RSTAB_MAX = 16;
DI void fill_rs_table(LAS unsigned char* lds, const Order& S, const float* ps, int tid) {
    LAS float* T = (LAS float*)(lds + RSTAB_OFF); Unit u;
    for (int i = 0; i < RSTAB_MAX && S.next(i, u); ++i) { const int row = tid >> 1, hf = tid & 1; const float* p = ps + (size_t)(u.pm * BM + row) * 32 + 16 * hf;
        const f32x4 a = *(const f32x4*)p, b = *(const f32x4*)(p + 4), c = *(const f32x4*)(p + 8), d = *(const f32x4*)(p + 12);
        float sx = (((a.x + a.y) + (a.z + a.w)) + ((b.x + b.y) + (b.z + b.w))) + (((c.x + c.y) + (c.z + c.w)) + ((d.x + d.y) + (d.z + d.w)));
        sx += __shfl_xor(sx, 1); if (hf == 0) T[i * 256 + row] = 1.f / sqrtf(sx * (1.f / DM) + NORM_EPS); }
    asm volatile("s_waitcnt lgkmcnt(0)\n\ts_barrier" ::: "memory");
}
DI float rs_row(const LAS float* T, const Unit& u, int row) { return T[u.i * 256 + (row & 255)]; }
struct EpiAct {
    static constexpr bool PERM = true;
    bf16_t* O; int ldc; size_t zO; int acts; const LAS float* ss;
    DI void operator()(const f32x4 (&acc)[2][2][4][2], const Unit& u, int wr, int wc, int fr_, int fq) const {
        int fr = fr_; asm volatile("" : "+v"(fr));
        const int row0 = u.pm * BM + wr * 64 + fr, col0 = u.pn * BM + wc * 32 + 8 * fq, act = (acts >> (4 * u.z)) & 15;
        bf16_t* base = O + (size_t)u.z * zO;
#pragma unroll
        for (int ai = 0; ai < 2; ++ai)
#pragma unroll
            for (int m = 0; m < 4; ++m) { bf16_t* rowp = base + (size_t)(row0 + ai * HALF + m * 16) * ldc + col0; const float rs = ss ? rs_row(ss, u, row0 + ai * HALF + m * 16) : 1.f;
#pragma unroll
                for (int bj = 0; bj < 2; ++bj) { f32x4 v0 = acc[ai][bj][m][0] * rs, v1 = acc[ai][bj][m][1] * rs;
                    if (act) {
#pragma unroll
                        for (int j = 0; j < 4; ++j) { v0[j] = act_apply(v0[j], act); v1[j] = act_apply(v1[j], act); } }
                    u32x4 w; w.x = pk2(v0[0], v0[1]); w.y = pk2(v0[2], v0[3]); w.z = pk2(v1[0], v1[1]); w.w = pk2(v1[2], v1[3]);
                    *(u32x4*)(rowp + bj * HALF) = w; } }
    }
};
struct EpiRelu2 {
    static constexpr bool PERM = true;
    bf16_t* O; int ldc; const LAS float* ss;
    DI void operator()(const f32x4 (&acc)[2][2][4][2], const Unit& u, int wr, int wc, int fr_, int fq) const {
        int fr = fr_; asm volatile("" : "+v"(fr));
        const int row0 = u.pm * BM + wr * 64 + fr, col0 = u.pn * BM + wc * 32 + 8 * fq;
#pragma unroll
        for (int ai = 0; ai < 2; ++ai)
#pragma unroll
            for (int m = 0; m < 4; ++m) { bf16_t* rowp = O + (size_t)(row0 + ai * HALF + m * 16) * ldc + col0; const float rs = rs_row(ss, u, row0 + ai * HALF + m * 16);
#pragma unroll
                for (int bj = 0; bj < 2; ++bj) { f32x4 v0 = acc[ai][bj][m][0] * rs, v1 = acc[ai][bj][m][1] * rs;
#pragma unroll
                    for (int j = 0; j < 4; ++j) { const float a = fmaxf(v0[j], 0.f), b = fmaxf(v1[j], 0.f); v0[j] = a * a; v1[j] = b * b; }
                    u32x4 w; w.x = pk2(v0[0], v0[1]); w.y = pk2(v0[2], v0[3]); w.z = pk2(v1[0], v1[1]); w.w = pk2(v1[2], v1[3]);
                    *(u32x4*)(rowp + bj * HALF) = w; } }
    }
};
struct EpiResid {
    static constexpr bool PERM = true;
    const float* resP; const float* resS; bf16_t* XB; float* SS;
    DI void operator()(const f32x4 (&acc)[2][2][4][2], const Unit& u, int wr, int wc, int fr_, int fq) const {
        int fr = fr_; asm volatile("" : "+v"(fr));
        const int row0 = u.pm * BM + wr * 64 + fr, col0 = u.pn * BM + wc * 32 + 8 * fq;
        const bool pr = u.pm < MP / BM; const float* rb = pr ? resP : resS; const int rsub = pr ? 0 : MP;
#pragma unroll
        for (int ai = 0; ai < 2; ++ai)
#pragma unroll
            for (int m = 0; m < 4; ++m) { const int row = row0 + ai * HALF + m * 16; bf16_t* xp = XB + (size_t)row * DM + col0;
                float sq = 0.f;
#pragma unroll
                for (int bj = 0; bj < 2; ++bj) { f32x4 r0, r1;
                    if (resP) { const float* rp = rb + (size_t)(row - rsub) * DM + col0 + bj * HALF; r0 = *(const f32x4*)rp; r1 = *(const f32x4*)(rp + 4); }
                    else { const u32x4 xv = *(const u32x4*)(xp + bj * HALF); r0 = (f32x4){bflo(xv.x), bfhi(xv.x), bflo(xv.y), bfhi(xv.y)}; r1 = (f32x4){bflo(xv.z), bfhi(xv.z), bflo(xv.w), bfhi(xv.w)}; }
                    r0 = r0 + acc[ai][bj][m][0]; r1 = r1 + acc[ai][bj][m][1];
                    u32x4 wv; wv.x = pk2(r0[0], r0[1]); wv.y = pk2(r0[2], r0[3]); wv.z = pk2(r1[0], r1[1]); wv.w = pk2(r1[2], r1[3]); *(u32x4*)(xp + bj * HALF) = wv;
                    sq += (r0[0] * r0[0] + r0[1] * r0[1]) + (r0[2] * r0[2] + r0[3] * r0[3]) + (r1[0] * r1[0] + r1[1] * r1[1]) + (r1[2] * r1[2] + r1[3] * r1[3]); }
                sq += __shfl_xor(sq, 16); sq += __shfl_xor(sq, 32);
                if (fq == 0) SS[(size_t)row * 32 + u.pn * 4 + wc] = sq; }
    }
};
struct EpiSlab {
    static constexpr bool PERM = true;
    const LAS unsigned* skp; int slot;
    DI void operator()(const f32x4 (&acc)[2][2][4][2], const Unit& u, int wr, int wc, int fr, int fq) const {
        int tid2 = (wr * 4 + wc) * 64 + lane_now(); asm volatile("" : "+v"(tid2));
        const unsigned long long pb = ((unsigned long long)(unsigned)__builtin_amdgcn_readfirstlane((int)skp[1]) << 32) | (unsigned)__builtin_amdgcn_readfirstlane((int)skp[0]);
        GAS char* p = (GAS char*)pb + (size_t)slot * 262144; const unsigned voff = (unsigned)tid2 * 16u;
#pragma unroll
        for (int q = 0; q < 32; ++q) *(GAS f32x4*)(p + q * 8192 + voff) = acc[q >> 4][(q >> 3) & 1][(q >> 1) & 3][q & 1];
    }
};
DI void sk_reduce(unsigned char LAS* lds, float* slabs, unsigned* cnts, const Unit& u, int st, int ks, bf16_t* XB, float* SS, int wave_id) {
    const int lane = lane_now(), tid = wave_id * 64 + lane, wr = wave_id >> 2, wc = wave_id & 3, fr = lane & 15, fq = lane >> 4;
    if (tid == 0) {
        unsigned* cnt = cnts + st * 4;
        __builtin_amdgcn_fence(__ATOMIC_RELEASE, "agent"); asm volatile("s_waitcnt vmcnt(0)" ::: "memory");
        (void)__hip_atomic_fetch_add(cnt, 1u, __ATOMIC_RELAXED, __HIP_MEMORY_SCOPE_AGENT);
        unsigned sp = 0; while (__hip_atomic_load(cnt, __ATOMIC_RELAXED, __HIP_MEMORY_SCOPE_AGENT) < 4u && ++sp < (1u << 24)) __builtin_amdgcn_s_sleep(1);
        __builtin_amdgcn_fence(__ATOMIC_ACQUIRE, "agent"); asm volatile("s_waitcnt vmcnt(0)" ::: "memory");
    }
    __syncthreads();
    const GAS char* p = (const GAS char*)slabs + (size_t)st * (4 * 262144); const unsigned voff = (unsigned)tid * 16u;
    const int ai = ks >> 1, row0 = u.pm * BM + wr * 64 + fr + ai * HALF, col0 = u.pn * BM + wc * 32 + 8 * fq;
#pragma unroll
    for (int mm = 0; mm < 2; ++mm) { const int m = 2 * (ks & 1) + mm, row = row0 + m * 16; bf16_t* xp = XB + (size_t)row * DM + col0;
        f32x4 v[2][2][4]; u32x4 xv[2];
#pragma unroll
        for (int bj = 0; bj < 2; ++bj) { xv[bj] = *(const u32x4*)(xp + bj * HALF);
#pragma unroll
            for (int n = 0; n < 2; ++n)
#pragma unroll
                for (int sl = 0; sl < 4; ++sl) v[bj][n][sl] = *(const GAS f32x4*)(p + (size_t)sl * 262144 + (((ai * 2 + bj) * 4 + m) * 2 + n) * 8192 + voff); }
        float sq = 0.f;
#pragma unroll
        for (int bj = 0; bj < 2; ++bj) {
            f32x4 r0 = (f32x4){bflo(xv[bj].x), bfhi(xv[bj].x), bflo(xv[bj].y), bfhi(xv[bj].y)}, r1 = (f32x4){bflo(xv[bj].z), bfhi(xv[bj].z), bflo(xv[bj].w), bfhi(xv[bj].w)};
            r0 = r0 + (((v[bj][0][0] + v[bj][0][1]) + v[bj][0][2]) + v[bj][0][3]); r1 = r1 + (((v[bj][1][0] + v[bj][1][1]) + v[bj][1][2]) + v[bj][1][3]);
            u32x4 wv; wv.x = pk2(r0[0], r0[1]); wv.y = pk2(r0[2], r0[3]); wv.z = pk2(r1[0], r1[1]); wv.w = pk2(r1[2], r1[3]); *(u32x4*)(xp + bj * HALF) = wv;
            sq += (r0[0] * r0[0] + r0[1] * r0[1]) + (r0[2] * r0[2] + r0[3] * r0[3]) + (r1[0] * r1[0] + r1[1] * r1[1]) + (r1[2] * r1[2] + r1[3] * r1[3]); }
        sq += __shfl_xor(sq, 16); sq += __shfl_xor(sq, 32);
        if (fq == 0) SS[(size_t)row * 32 + u.pn * 4 + wc] = sq; }
}
DI int tok_pos(int row) { return row < MP ? row : PAST + (row & 63); }
DI void sincos_rev(int pos, float inv, float& c, float& s) {
    double r = (double)pos * (double)inv * 0.15915494309189535; r = r - __builtin_floor(r); const float f = (float)r;
    s = __builtin_amdgcn_sinf(f); c = __builtin_amdgcn_cosf(f);
}
struct EpiAttnQKV {
    static constexpr bool PERM = true;
    bf16_t* Qb; float* outf; size_t okP, okS; const LAS float* ss;
    DI void operator()(const f32x4 (&acc)[2][2][4][2], const Unit& u, int wr, int wc, int fr_, int fq) const {
        int fr = fr_; asm volatile("" : "+v"(fr));
        const int row0 = u.pm * BM + wr * 64 + fr, cl = wc * 32 + 8 * fq;
        const bool rot = (u.pn < 9) && ((wc & 1) == 0) && (fq < 2);
        float inv[8];
#pragma unroll
        for (int j = 0; j < 8; ++j) inv[j] = __builtin_amdgcn_exp2f(-(float)j * 2.3664461f);
        const float qs = (u.pn < 8) ? 0.18033688f : 1.f;
        const size_t ooff = (u.pn < 8) ? (size_t)0 : (u.pn == 8 ? (size_t)M * DM : (size_t)M * DM + (size_t)M * 256); bf16_t* ob = Qb + ooff; const int ldo = (u.pn < 8) ? DM : 256, ocol = (u.pn < 8) ? u.pn * BM + cl : cl;
        float* cP = outf + okP + (u.pn == 9 ? 65536 : 0); float* cS = outf + okS + (u.pn == 9 ? 2097152 : 0);
#pragma unroll
        for (int ai = 0; ai < 2; ++ai)
#pragma unroll
            for (int m = 0; m < 4; ++m) { const int row = row0 + ai * HALF + m * 16; const int pos = tok_pos(row);
                const float rs = rs_row(ss, u, row);
                f32x4 p0 = acc[ai][0][m][0] * rs, p1 = acc[ai][0][m][1] * rs, q0 = acc[ai][1][m][0] * rs, q1 = acc[ai][1][m][1] * rs;
                if (rot) {
#define ROPE_J(j, pv, qv, e) { float c_, s_; sincos_rev(pos, inv[j], c_, s_); const float ya = __shfl_xor(pv[e], 16), yb = __shfl_xor(qv[e], 16); \
                        pv[e] = (fq == 0) ? pv[e] * c_ - ya * s_ : pv[e] * c_ + ya * s_; qv[e] = (fq == 0) ? qv[e] * c_ - yb * s_ : qv[e] * c_ + yb * s_; }
                    ROPE_J(0, p0, q0, 0) ROPE_J(1, p0, q0, 1) ROPE_J(2, p0, q0, 2) ROPE_J(3, p0, q0, 3) ROPE_J(4, p1, q1, 0) ROPE_J(5, p1, q1, 1) ROPE_J(6, p1, q1, 2) ROPE_J(7, p1, q1, 3)
#undef ROPE_J
                }
                { u32x4 wv; wv.x = pk2(p0[0] * qs, p0[1] * qs); wv.y = pk2(p0[2] * qs, p0[3] * qs); wv.z = pk2(p1[0] * qs, p1[1] * qs); wv.w = pk2(p1[2] * qs, p1[3] * qs);
                  *(u32x4*)(ob + (size_t)row * ldo + ocol) = wv;
                  wv.x = pk2(q0[0] * qs, q0[1] * qs); wv.y = pk2(q0[2] * qs, q0[3] * qs); wv.z = pk2(q1[0] * qs, q1[1] * qs); wv.w = pk2(q1[2] * qs, q1[3] * qs);
                  *(u32x4*)(ob + (size_t)row * ldo + ocol + HALF) = wv; }
                if (u.pn >= 8) {
                    float* cp = nullptr;
                    if (row >= MP) cp = cS + ((size_t)((row - MP) >> 6) * AWIN + 64 + (row & 63)) * 256; else if (row >= MP - AWIN) cp = cP + (size_t)(row - (MP - AWIN)) * 256;
                    if (cp) { *(f32x4*)(cp + cl) = p0; *(f32x4*)(cp + cl + 4) = p1; *(f32x4*)(cp + cl + HALF) = q0; *(f32x4*)(cp + cl + HALF + 4) = q1; }
                } }
    }
};
struct EpiRetProj {
    static constexpr bool PERM = true;
    bf16_t* P; const LAS float* ss;
    DI void operator()(const f32x4 (&acc)[2][2][4][2], const Unit& u, int wr, int wc, int fr_, int fq) const {
        int fr = fr_; asm volatile("" : "+v"(fr));
        const int row0 = u.pm * BM + wr * 64 + fr, cl = wc * 32 + 8 * fq; const bool rot = u.pn < 16; const float sc = (u.pn >= 8 && u.pn < 16) ? 0.0625f : 1.f;
        float inv[8];
#pragma unroll
        for (int j = 0; j < 8; ++j) inv[j] = __builtin_amdgcn_exp2f(-(float)(cl + j) * 0.10381025f);
#pragma unroll
        for (int ai = 0; ai < 2; ++ai)
#pragma unroll
            for (int m = 0; m < 4; ++m) { const int row = row0 + ai * HALF + m * 16; const int pos = tok_pos(row);
                const float rs = rs_row(ss, u, row);
                f32x4 a0 = acc[ai][0][m][0] * rs, a1 = acc[ai][0][m][1] * rs, b0 = acc[ai][1][m][0] * rs, b1 = acc[ai][1][m][1] * rs;
                if (rot) {
                    float x1[8] = {a0[0], a0[1], a0[2], a0[3], a1[0], a1[1], a1[2], a1[3]}, x2[8] = {b0[0], b0[1], b0[2], b0[3], b1[0], b1[1], b1[2], b1[3]};
#pragma unroll
                    for (int j = 0; j < 8; ++j) { float c, s; sincos_rev(pos, inv[j], c, s); const float p = x1[j], q = x2[j]; x1[j] = (p * c - q * s) * sc; x2[j] = (q * c + p * s) * sc; }
                    a0 = (f32x4){x1[0], x1[1], x1[2], x1[3]}; a1 = (f32x4){x1[4], x1[5], x1[6], x1[7]}; b0 = (f32x4){x2[0], x2[1], x2[2], x2[3]}; b1 = (f32x4){x2[4], x2[5], x2[6], x2[7]};
                }
                bf16_t* rowp = P + (size_t)row * RIN + u.pn * BM + cl;
                u32x4 w; w.x = pk2(a0[0], a0[1]); w.y = pk2(a0[2], a0[3]); w.z = pk2(a1[0], a1[1]); w.w = pk2(a1[2], a1[3]); *(u32x4*)rowp = w;
                w.x = pk2(b0[0], b0[1]); w.y = pk2(b0[2], b0[3]); w.z = pk2(b1[0], b1[1]); w.w = pk2(b1[2], b1[3]); *(u32x4*)(rowp + HALF) = w; }
    }
};
struct EpiRwkv2 {
    static constexpr bool PERM = true;
    float* LW; bf16_t* Ab; const float* w0; const float* a0;
    DI void operator()(const f32x4 (&acc)[2][2][4][2], const Unit& u, int wr, int wc, int fr_, int fq) const {
        int fr = fr_; asm volatile("" : "+v"(fr));
        const int row0 = u.pm * BM + wr * 64 + fr, col0 = u.pn * BM + wc * 32 + 8 * fq;
        const float* bp = (u.z == 0) ? w0 : a0; bf16_t* ob = Ab + (u.z == 2 ? (size_t)M * DM : (size_t)0);
#pragma unroll
        for (int bj = 0; bj < 2; ++bj)
#pragma unroll
            for (int n = 0; n < 2; ++n) { const int col = col0 + bj * HALF + 4 * n;
                f32x4 bias = (f32x4){0.f, 0.f, 0.f, 0.f}; if (u.z < 2) bias = *(const f32x4*)(bp + col);
#pragma unroll
                for (int ai = 0; ai < 2; ++ai)
#pragma unroll
                    for (int m = 0; m < 4; ++m) { const int row = row0 + ai * HALF + m * 16; f32x4 x = acc[ai][bj][m][n] + bias;
                        if (u.z == 0) {
#pragma unroll
                            for (int j = 0; j < 4; ++j) { const float y = -x[j]; const float sp = fmaxf(y, 0.f) + __logf(1.f + __expf(-fabsf(y))); x[j] = -__expf(-sp - 0.5f); }
                            *(f32x4*)(LW + (size_t)row * DM + col) = x;
                        } else {
                            if (u.z == 1) {
#pragma unroll
                                for (int j = 0; j < 4; ++j) x[j] = 1.f / (1.f + __expf(-x[j])); }
                            u32x2 wv; wv.x = pk2(x[0], x[1]); wv.y = pk2(x[2], x[3]); *(u32x2*)(ob + (size_t)row * DM + col) = wv;
                        } }
                asm volatile("" ::: "memory"); }
    }
};
}
#define XB_TMO      128
#define XB_XCNT(j)  (256  + 64 * (j))
#define XB_XSUB(j)  (1280 + 64 * (j))
#define XB_XGEN(j)  (2304 + 64 * (j))
#define XB_TOP      3328
#define XB_TOPGEN   3392
#define XCD_BAR_WORDS 3456
#define XB_SPIN_CAP (1u << 18)

__device__ __forceinline__ unsigned xb_ld(unsigned* p)              { return __hip_atomic_load(p, __ATOMIC_RELAXED, __HIP_MEMORY_SCOPE_AGENT); }
__device__ __forceinline__ unsigned xb_add(unsigned* p, unsigned v) { return __hip_atomic_fetch_add(p, v, __ATOMIC_RELAXED, __HIP_MEMORY_SCOPE_AGENT); }
__device__ __forceinline__ unsigned xb_xcc_id() { return (unsigned)__builtin_amdgcn_s_getreg((3 << 11) | 20) & 0xFu; }
#define XB_SPIN(cond, bar) do { unsigned _sp = 0; while (cond) { __builtin_amdgcn_s_sleep(1); \
    if ((++_sp & 255u) == 0u) { if (xb_ld(&(bar)[XB_TMO])) break; if (_sp > XB_SPIN_CAP) { atomicAdd(&(bar)[XB_TMO], 1u); break; } } } } while (0)

struct XcdBarrier {
    unsigned* bar; unsigned x;
    volatile LAS unsigned* st;
};

__device__ __forceinline__ XcdBarrier xcd_barrier_post(unsigned* bar, volatile LAS unsigned* st, int wave_id) {
    XcdBarrier b; b.bar = bar; b.x = xb_xcc_id(); b.st = st;
    if (wave_id == 0 && lane_now() == 0) (void)xb_add(&bar[XB_XCNT(b.x)], 1u);
    return b;
}
__device__ __forceinline__ void xcd_barrier_complete(unsigned* bar, unsigned x, unsigned& nloc, unsigned& nx) {
    const unsigned G = gridDim.x * gridDim.y * gridDim.z;
    unsigned sum, cnt, mine, sp = 0u;
    for (;;) {
        sum = 0u; cnt = 0u; mine = 0u;
#pragma unroll
        for (unsigned j = 0; j < 16; ++j) { const unsigned c = xb_ld(&bar[XB_XCNT(j)]); sum += c; cnt += (c > 0u) ? 1u : 0u; mine = (j == x) ? c : mine; }
        if (sum == G) break;
        __builtin_amdgcn_s_sleep(1);
        if ((++sp & 255u) == 0u) { if (xb_ld(&bar[XB_TMO])) break; if (sp > XB_SPIN_CAP) { atomicAdd(&bar[XB_TMO], 1u); break; } }
    }
    nloc = mine > 0u ? mine : 1u; nx = cnt > 0u ? cnt : 1u;
}

__device__ __forceinline__ void xcd_barrier(const XcdBarrier& b, int wave_id) {
    asm volatile("s_waitcnt vmcnt(0)" ::: "memory");
    __syncthreads();
    if (wave_id == 0 && lane_now() == 0) {
        unsigned* bar = b.bar;
        __builtin_amdgcn_s_waitcnt(0);
        unsigned nloc = b.st[0], nx = b.st[1];
        if (nloc == 0u) { xcd_barrier_complete(bar, b.x, nloc, nx); b.st[0] = nloc; b.st[1] = nx; }
        const unsigned old = xb_add(&bar[XB_XSUB(b.x)], 1u);
        const unsigned gen = old / nloc;
        if (old + 1u == (gen + 1u) * nloc) {
            __builtin_amdgcn_fence(__ATOMIC_RELEASE, "agent");
            asm volatile("s_waitcnt vmcnt(0)" ::: "memory");
            const unsigned og = xb_add(&bar[XB_TOP], 1u);
            const unsigned tg = og / nx;
            if (og + 1u == (tg + 1u) * nx) xb_add(&bar[XB_TOPGEN], 1u);
            else XB_SPIN(xb_ld(&bar[XB_TOPGEN]) == tg, bar);
            __builtin_amdgcn_fence(__ATOMIC_ACQUIRE, "agent");
            xb_add(&bar[XB_XGEN(b.x)], 1u);
            asm volatile("s_waitcnt vmcnt(0)" ::: "memory");
        } else {
            XB_SPIN(xb_ld(&bar[XB_XGEN(b.x)]) == gen, bar);
            __builtin_amdgcn_fence(__ATOMIC_ACQUIRE, "agent");
            asm volatile("s_waitcnt vmcnt(0)" ::: "memory");
        }
    }
    __syncthreads();
}
struct WG { LAS unsigned char* lds; int tid, lane, wave, gw, ngw, G, bid; };

DI void convert_w(const WG& w, const float* W, int Kv, int Nv, bf16_t* WT, int Kp, int Np, const float* gain = nullptr, int b0 = 0, int nb = 0) {
    LAS float* T = (LAS float*)w.lds;
    const int nkt = Kp / 128, nnt = Np / 128, ntile = nkt * nnt; if (nb == 0) nb = w.G;
    if (w.bid < b0) return;
    for (int tile = w.bid - b0; tile < ntile; tile += nb) { const int k0 = (tile / nnt) * 128, n0 = (tile % nnt) * 128;
        int tid = w.tid; asm volatile("" : "+v"(tid)); const int lane = tid & 63;
        LDS_BARRIER();
#pragma unroll
        for (int i = 0; i < 8; ++i) { const int kk = 16 * w.wave + 2 * i + (lane >> 5), k = k0 + kk, n = n0 + 4 * (lane & 31);
            f32x4 v = (f32x4){0.f, 0.f, 0.f, 0.f}; if (k < Kv && n < Nv) { v = *(const f32x4*)(W + (size_t)k * Nv + n); if (gain) v = v * gain[k]; }
            LAS float* tp = T + kk * 129 + 4 * (lane & 31); tp[0] = v.x; tp[1] = v.y; tp[2] = v.z; tp[3] = v.w; }
        LDS_BARRIER();
#pragma unroll
        for (int i = 0; i < 4; ++i) { const int nn = 16 * w.wave + 4 * i + (lane >> 4), kj = 8 * (lane & 15); const LAS float* sp = T + kj * 129 + nn;
            u32x4 o; o.x = pk2(sp[0], sp[129]); o.y = pk2(sp[2 * 129], sp[3 * 129]); o.z = pk2(sp[4 * 129], sp[5 * 129]); o.w = pk2(sp[6 * 129], sp[7 * 129]);
            *(u32x4*)(WT + (size_t)(n0 + nn) * Kp + k0 + kj) = o; }
    }
}

DI void rows0(const WG& w, const float* xp, const float* xs, bf16_t* XB, float* SS) {
    for (int m = w.gw; m < M; m += w.ngw) {
        const float* xr = (m < MP) ? xp + (size_t)m * DM : xs + (size_t)(m - MP) * DM;
        f32x4 v[8]; float s = 0.f;
#pragma unroll
        for (int j = 0; j < 8; ++j) { v[j] = ((const f32x4*)xr)[w.lane + 64 * j]; s += (v[j].x * v[j].x + v[j].y * v[j].y) + (v[j].z * v[j].z + v[j].w * v[j].w); }
        s = wave_sum_fast(s); if (w.lane < 32) SS[(size_t)m * 32 + w.lane] = (w.lane == 0) ? s : 0.f;
#pragma unroll
        for (int j = 0; j < 8; ++j) { u32x2 o; o.x = pk2(v[j].x, v[j].y); o.y = pk2(v[j].z, v[j].w); ((u32x2*)(XB + (size_t)m * DM))[w.lane + 64 * j] = o; }
    }
}
DI float rs_of_row(const float* ps, int m, int lane) { const float v = (lane < 32) ? ps[(size_t)m * 32 + lane] : 0.f; return 1.f / sqrtf(wave_sum_fast(v) * (1.f / DM) + NORM_EPS); }
DI void norm_rows(const WG& w, const float* xp, const float* xs, const float* gain, bf16_t* H, float* shp, float* shs) {
    for (int m = w.gw; m < M; m += w.ngw) {
        const float* xr = (m < MP) ? xp + (size_t)m * DM : xs + (size_t)(m - MP) * DM;
        f32x4 v[8]; float s = 0.f;
#pragma unroll
        for (int j = 0; j < 8; ++j) { v[j] = ((const f32x4*)xr)[w.lane + 64 * j]; s += (v[j].x * v[j].x + v[j].y * v[j].y) + (v[j].z * v[j].z + v[j].w * v[j].w); }
        const float rs = 1.f / sqrtf(wave_sum_fast(s) * (1.f / DM) + NORM_EPS);
        float* sh = nullptr;
        if (shp && m == MP - 1) sh = shp; else if (shs && m >= MP && (m & 63) == 63) sh = shs + (size_t)((m - MP) >> 6) * DM;
#pragma unroll
        for (int j = 0; j < 8; ++j) { const f32x4 g = ((const f32x4*)gain)[w.lane + 64 * j]; const f32x4 y = v[j] * rs * g;
            u32x2 o; o.x = pk2(y.x, y.y); o.y = pk2(y.z, y.w); ((u32x2*)(H + (size_t)m * DM))[w.lane + 64 * j] = o;
            if (sh) ((f32x4*)sh)[w.lane + 64 * j] = y; }
    }
}
DI void final_norm(const WG& w, const bf16_t* XB, const float* SS, const float* gain, float* Y) {
    for (int m = w.gw; m < M; m += w.ngw) { const float rs = rs_of_row(SS, m, w.lane);
#pragma unroll
        for (int j = 0; j < 4; ++j) { const int c0 = 8 * (w.lane + 64 * j); const u32x4 xv = *(const u32x4*)(XB + (size_t)m * DM + c0);
            const f32x4 g0 = *(const f32x4*)(gain + c0), g1 = *(const f32x4*)(gain + c0 + 4);
            *(f32x4*)(Y + (size_t)m * DM + c0) = (f32x4){bflo(xv.x), bfhi(xv.x), bflo(xv.y), bfhi(xv.y)} * rs * g0; *(f32x4*)(Y + (size_t)m * DM + c0 + 4) = (f32x4){bflo(xv.z), bfhi(xv.z), bflo(xv.w), bfhi(xv.w)} * rs * g1; } }
}
DI void lerp_rows(const WG& w, const bf16_t* XB, const float* SS, const float* gain, const float* shift_state, const float* mu, bf16_t* XL, float* shp, float* shs) {
    constexpr int RPW = 36;
    for (int task = w.gw; task < 4 * (M / RPW); task += w.ngw) { const int cq = task & 3, m0 = (task >> 2) * RPW, c0 = 512 * cq + 8 * w.lane;
        float gg[8], mm[6][8], hp[8];
        { const f32x4 g0 = *(const f32x4*)(gain + c0), g1 = *(const f32x4*)(gain + c0 + 4); gg[0] = g0.x; gg[1] = g0.y; gg[2] = g0.z; gg[3] = g0.w; gg[4] = g1.x; gg[5] = g1.y; gg[6] = g1.z; gg[7] = g1.w; }
#pragma unroll
        for (int i = 0; i < 6; ++i) { const int mrow = (i == 1) ? 2 : (i == 2) ? 3 : (i == 3) ? 1 : i;
            const float* mp = mu + (size_t)mrow * DM + c0; const f32x4 a = *(const f32x4*)mp, b = *(const f32x4*)(mp + 4); mm[i][0] = a.x; mm[i][1] = a.y; mm[i][2] = a.z; mm[i][3] = a.w; mm[i][4] = b.x; mm[i][5] = b.y; mm[i][6] = b.z; mm[i][7] = b.w; }
        { const bool first0 = (m0 == 0) || (m0 >= MP && (m0 & 63) == 0);
            if (!first0) { const float rsp = rs_of_row(SS, m0 - 1, w.lane); const u32x4 pv = *(const u32x4*)(XB + (size_t)(m0 - 1) * DM + c0);
                hp[0] = bflo(pv.x); hp[1] = bfhi(pv.x); hp[2] = bflo(pv.y); hp[3] = bfhi(pv.y); hp[4] = bflo(pv.z); hp[5] = bfhi(pv.z); hp[6] = bflo(pv.w); hp[7] = bfhi(pv.w);
#pragma unroll
                for (int e = 0; e < 8; ++e) hp[e] *= rsp * gg[e]; }
            else {
#pragma unroll
                for (int e = 0; e < 8; ++e) hp[e] = 0.f; } }
#pragma unroll 2
        for (int rr = 0; rr < RPW; ++rr) { const int m = m0 + rr;
            const float rs = rs_of_row(SS, m, w.lane); const u32x4 hv = *(const u32x4*)(XB + (size_t)m * DM + c0);
            float h[8] = {bflo(hv.x), bfhi(hv.x), bflo(hv.y), bfhi(hv.y), bflo(hv.z), bfhi(hv.z), bflo(hv.w), bfhi(hv.w)};
#pragma unroll
            for (int e = 0; e < 8; ++e) h[e] *= rs * gg[e];
            if (m == 0) {
#pragma unroll
                for (int e = 0; e < 8; ++e) hp[e] = 0.f;
            } else if (m >= MP && (m & 63) == 0) { const float* sp = shift_state + (size_t)((m - MP) >> 6) * DM + c0; const f32x4 s0 = *(const f32x4*)sp, s1 = *(const f32x4*)(sp + 4);
                hp[0] = s0.x; hp[1] = s0.y; hp[2] = s0.z; hp[3] = s0.w; hp[4] = s1.x; hp[5] = s1.y; hp[6] = s1.z; hp[7] = s1.w; }
            float* sh = nullptr; if (m == MP - 1) sh = shp; else if (m >= MP && (m & 63) == 63) sh = shs + (size_t)((m - MP) >> 6) * DM;
            if (sh) { *(f32x4*)(sh + c0) = (f32x4){h[0], h[1], h[2], h[3]}; *(f32x4*)(sh + c0 + 4) = (f32x4){h[4], h[5], h[6], h[7]}; }
#pragma unroll
            for (int i = 0; i < 6; ++i) { float o[8];
#pragma unroll
                for (int e = 0; e < 8; ++e) o[e] = h[e] + (hp[e] - h[e]) * mm[i][e];
                u32x4 ov; ov.x = pk2(o[0], o[1]); ov.y = pk2(o[2], o[3]); ov.z = pk2(o[4], o[5]); ov.w = pk2(o[6], o[7]);
                *(u32x4*)(XL + ((size_t)i * M + m) * DM + c0) = ov; }
#pragma unroll
            for (int e = 0; e < 8; ++e) hp[e] = h[e];
        }
    }
}
constexpr int AT_KS = 72, AT_VS = 196;
constexpr int AT_V_OFF = 192 * AT_KS * 2;
DI u32x4 ld8_f32_as_bf16(const float* p) { const f32x4 a = *(const f32x4*)p, b = *(const f32x4*)(p + 4); u32x4 o; o.x = pk2(a.x, a.y); o.y = pk2(a.z, a.w); o.z = pk2(b.x, b.y); o.w = pk2(b.z, b.w); return o; }
DI bf16x8 pack8(const f32x16& x, int s) {
    u32x4 p; p.x = pk2(x[8 * s], x[8 * s + 1]); p.y = pk2(x[8 * s + 2], x[8 * s + 3]); p.z = pk2(x[8 * s + 4], x[8 * s + 5]); p.w = pk2(x[8 * s + 6], x[8 * s + 7]);
    return __builtin_bit_cast(bf16x8, p);
}
DI bf16x8 ld_perm_frag(const LAS bf16_t* p) {
    const s16x4 lo = *(const LAS s16x4*)p, hi = *(const LAS s16x4*)(p + 8); return __builtin_shufflevector(lo, hi, 0, 1, 2, 3, 4, 5, 6, 7);
}
DI f32x16 zero16() { f32x16 z; for (int i = 0; i < 16; ++i) z[i] = 0.f; return z; }

typedef short v4i16_t __attribute__((ext_vector_type(4)));
DI s16x4 ds_tr(const LAS unsigned char* p) { return __builtin_bit_cast(s16x4, __builtin_amdgcn_ds_read_tr16_b64_v4i16((LAS v4i16_t*)p)); }
constexpr int AT_VB = 9344;
DI void attn_load_kv(const bf16_t* Kb, const bf16_t* Vb, const float* ck, const float* cv, int c, int g, int tid, u32x4 (&pk)[3], u32x4 (&pv)[3]) {
#pragma unroll
    for (int i = 0; i < 3; ++i) { const int idx = tid + 512 * i, sl = idx >> 3, dc = idx & 7;
        u32x4 kv = {0u, 0u, 0u, 0u}, vv = {0u, 0u, 0u, 0u};
        if (c < NCHP) { const int tok = 64 * (c - 2) + sl; if (tok >= 0) { kv = *(const u32x4*)(Kb + (size_t)tok * 256 + g * 64 + dc * 8); vv = *(const u32x4*)(Vb + (size_t)tok * 256 + g * 64 + dc * 8); } }
        else { const int b = c - NCHP;
            if (sl < AWIN) { const size_t o = (((size_t)b * AWIN + sl) * AKV + g) * AHD + dc * 8; kv = ld8_f32_as_bf16(ck + o); vv = ld8_f32_as_bf16(cv + o); }
            else { const int tok = MP + 64 * b + (sl - AWIN); kv = *(const u32x4*)(Kb + (size_t)tok * 256 + g * 64 + dc * 8); vv = *(const u32x4*)(Vb + (size_t)tok * 256 + g * 64 + dc * 8); } }
        pk[i] = kv; pv[i] = vv; }
}
DI void attn_load_q(const bf16_t* Qb, int c, int qh, int hq, int r, int h, bf16x8 (&qf)[4]) {
#pragma unroll
    for (int sx = 0; sx < 4; ++sx) qf[sx] = *(const bf16x8*)(Qb + (size_t)(64 * c + 32 * qh + r) * DM + hq * 64 + 16 * sx + 8 * h);
}
DI void attn_phase(const WG& w, const bf16_t* Qb, const bf16_t* Kb, const bf16_t* Vb, const float* ck, const float* cv, const float* sinks, bf16_t* AO) {
    LAS bf16_t* Ks = (LAS bf16_t*)(w.lds); LAS unsigned char* Vl = w.lds + AT_V_OFF;
    const int NU = NCH * AKV;
    u32x4 pk[3], pv[3]; bf16x8 qn[4];
    if (w.bid < NU) { const int c = w.bid >> 2, g = w.bid & 3; attn_load_kv(Kb, Vb, ck, cv, c, g, w.tid, pk, pv); attn_load_q(Qb, c, 0, g * 8 + w.wave, w.lane & 31, w.lane >> 5, qn); }
#pragma unroll 1
    for (int u = w.bid; u < NU; u += w.G) {
        const int c = u >> 2, g = u & 3, un = u + w.G, cn = un >> 2, gn = un & 3;
        int tid = w.tid; asm volatile("" : "+v"(tid)); const int lane = tid & 63, r = lane & 31, h = lane >> 5;
        LDS_BARRIER();
#pragma unroll
        for (int i = 0; i < 3; ++i) { const int idx = tid + 512 * i, sl = idx >> 3, dc = idx & 7;
            *(LAS u32x4*)(Ks + sl * AT_KS + dc * 8) = pk[i];
            *(LAS u32x4*)(Vl + (dc >> 1) * AT_VB + 32 * sl + 128 * (sl >> 3) + (dc & 1) * 16) = pv[i]; }
        LDS_BARRIER();
        const int hq = g * 8 + w.wave; const float sink2 = sinks[hq] * 1.4426950408889634f;
        const int i0 = (c < NCHP) ? (c == 0 ? 4 : (c == 1 ? 2 : 0)) : 0;
        const LAS unsigned char* vbase = Vl + ((lane >> 4) & 1) * AT_VB + 128 * h + 32 * ((lane & 15) >> 2) + 8 * (lane & 3);
#pragma unroll 1
        for (int qh = 0; qh < 2; ++qh) {
            bf16x8 qf[4];
#pragma unroll
            for (int sx = 0; sx < 4; ++sx) qf[sx] = qn[sx];
            if (qh == 0) { attn_load_q(Qb, c, 1, hq, r, h, qn); if (un < NU) attn_load_kv(Kb, Vb, ck, cv, cn, gn, tid, pk, pv); }
            else if (un < NU) attn_load_q(Qb, cn, 0, gn * 8 + w.wave, r, h, qn);
            const int qrow = 64 * c + 32 * qh + r;
            float mx = sink2;
#pragma unroll
            for (int i = 0; i < 6; ++i) if (i >= i0) { f32x16 t = zero16();
#pragma unroll
                for (int sx = 0; sx < 4; ++sx) { const bf16x8 kf = *(const LAS bf16x8*)(Ks + (32 * i + r) * AT_KS + 16 * sx + 8 * h); t = MFMA32(kf, qf[sx], t); }
#pragma unroll
                for (int e = 0; e < 16; ++e) mx = fmaxf(mx, t[e]); }
            mx = fmaxf(mx, __shfl_xor(mx, 32));
            float sum = 0.f; bf16x8 pf[6][2];
#pragma unroll
            for (int i = 0; i < 6; ++i) if (i >= i0) { f32x16 t = zero16();
#pragma unroll
                for (int sx = 0; sx < 4; ++sx) { const bf16x8 kf = *(const LAS bf16x8*)(Ks + (32 * i + r) * AT_KS + 16 * sx + 8 * h); t = MFMA32(kf, qf[sx], t); }
#pragma unroll
                for (int e = 0; e < 16; ++e) { t[e] = __builtin_amdgcn_exp2f(t[e] - mx); sum += t[e]; }
                pf[i][0] = pack8(t, 0); pf[i][1] = pack8(t, 1); }
            sum += __shfl_xor(sum, 32);
            const float inv = 1.f / (sum + __builtin_amdgcn_exp2f(sink2 - mx));
            f32x16 ot[2]; ot[0] = zero16(); ot[1] = zero16();
#pragma unroll
            for (int i = 0; i < 6; ++i) if (i >= i0) {
#pragma unroll
                for (int s2 = 0; s2 < 2; ++s2) {
#pragma unroll
                    for (int dt = 0; dt < 2; ++dt) { const LAS unsigned char* vp = vbase + dt * (2 * AT_VB) + i * 1536 + s2 * 768; const s16x4 lo = ds_tr(vp), hi = ds_tr(vp + 384);
                        const bf16x8 vf = __builtin_shufflevector(lo, hi, 0, 1, 2, 3, 4, 5, 6, 7); ot[dt] = MFMA32(vf, pf[i][s2], ot[dt]); } } }
#pragma unroll
            for (int dt = 0; dt < 2; ++dt)
#pragma unroll
                for (int gq = 0; gq < 4; ++gq) { u32x2 o; o.x = pk2(ot[dt][4 * gq] * inv, ot[dt][4 * gq + 1] * inv); o.y = pk2(ot[dt][4 * gq + 2] * inv, ot[dt][4 * gq + 3] * inv);
                    *(u32x2*)(AO + (size_t)qrow * DM + hq * 64 + 32 * dt + 8 * gq + 4 * h) = o; }
        }
    }
}
DI void cache_shift(const WG& w, const float* ck, const float* cv, float* kS, float* vS) {
    const int n4 = DBATCH * 64 * 256 / 4;
    for (int i = w.bid * 512 + w.tid; i < n4; i += w.G * 512) { const int b = i / (64 * 64), rem = i % (64 * 64);
        ((f32x4*)kS)[(size_t)b * (128 * 64) + rem] = ((const f32x4*)ck)[(size_t)b * (128 * 64) + 64 * 64 + rem];
        ((f32x4*)vS)[(size_t)b * (128 * 64) + rem] = ((const f32x4*)cv)[(size_t)b * (128 * 64) + 64 * 64 + rem]; }
}

DI float ret_lg2(int hh) { return __log2f(1.f - __builtin_amdgcn_exp2f(-5.f - (float)hh)); }
constexpr int RI_KS = 264, RI_VS = 68, RI_V_OFF = 64 * RI_KS * 2;
DI void ret_intra_phase(const WG& w, const bf16_t* P, bf16_t* O) {
    LAS bf16_t* Ks = (LAS bf16_t*)(w.lds); LAS bf16_t* Vt = (LAS bf16_t*)(w.lds + RI_V_OFF);
    const int lane = w.lane, r = lane & 31, h = lane >> 5, tt = w.wave & 1, dvq = w.wave >> 1;
    for (int u = w.bid; u < NCH * RH; u += w.G) {
        const int c = u >> 3, hh = u & 7; const float lg2 = ret_lg2(hh);
        LDS_BARRIER();
#pragma unroll
        for (int i = 0; i < 4; ++i) { const int idx = w.tid + 512 * i, s = idx >> 5, dc = idx & 31;
            *(LAS u32x4*)(Ks + s * RI_KS + dc * 8) = *(const u32x4*)(P + (size_t)(64 * c + s) * RIN + 2048 + hh * 256 + dc * 8); }
#pragma unroll
        for (int i = 0; i < 8; ++i) { const int idx = w.tid + 512 * i, s = idx >> 6, dc = idx & 63;
            const u32x4 vv = *(const u32x4*)(P + (size_t)(64 * c + s) * RIN + 4096 + hh * 512 + dc * 8); const unsigned e[4] = {vv.x, vv.y, vv.z, vv.w};
#pragma unroll
            for (int j = 0; j < 4; ++j) { Vt[(dc * 8 + 2 * j) * RI_VS + s] = (bf16_t)(e[j] & 0xffffu); Vt[(dc * 8 + 2 * j + 1) * RI_VS + s] = (bf16_t)(e[j] >> 16); } }
        LDS_BARRIER();
        const int qrow = 64 * c + 32 * tt + r;
        f32x16 st[2]; st[0] = zero16(); st[1] = zero16();
#pragma unroll 4
        for (int ks = 0; ks < 16; ++ks) { const bf16x8 qf = *(const bf16x8*)(P + (size_t)qrow * RIN + hh * 256 + 16 * ks + 8 * h);
#pragma unroll
            for (int si = 0; si < 2; ++si) if (si <= tt) { const bf16x8 kf = *(const LAS bf16x8*)(Ks + (32 * si + r) * RI_KS + 16 * ks + 8 * h); st[si] = MFMA32(kf, qf, st[si]); } }
        const int t = 32 * tt + r;
#pragma unroll
        for (int si = 0; si < 2; ++si)
#pragma unroll
            for (int e = 0; e < 16; ++e) { const int s = 32 * si + (e & 3) + 8 * (e >> 2) + 4 * h; st[si][e] = (s <= t) ? st[si][e] * __builtin_amdgcn_exp2f(lg2 * (float)(t - s)) : 0.f; }
        f32x16 ot[4];
#pragma unroll
        for (int d = 0; d < 4; ++d) ot[d] = zero16();
#pragma unroll
        for (int si = 0; si < 2; ++si) if (si <= tt) {
#pragma unroll
            for (int s2 = 0; s2 < 2; ++s2) { const bf16x8 pf = pack8(st[si], s2);
#pragma unroll
                for (int d = 0; d < 4; ++d) { const bf16x8 vf = ld_perm_frag(Vt + (128 * dvq + 32 * d + r) * RI_VS + 32 * si + 16 * s2 + 4 * h); ot[d] = MFMA32(vf, pf, ot[d]); } } }
#pragma unroll
        for (int d = 0; d < 4; ++d)
#pragma unroll
            for (int gq = 0; gq < 4; ++gq) { u32x2 o; o.x = pk2(ot[d][4 * gq], ot[d][4 * gq + 1]); o.y = pk2(ot[d][4 * gq + 2], ot[d][4 * gq + 3]);
                *(u32x2*)(O + (size_t)qrow * RVD + hh * 512 + 128 * dvq + 32 * d + 8 * gq + 4 * h) = o; }
    }
}
constexpr int RC_QS = 264, RC_QX = 0, RC_KZ = 33792, RC_VT = 82944, RC_OS = 107520, RC_OSS = 20, RC_BLK = 3072, RC_PT = 148480, RC_PS = 72;
constexpr int RGRP = 8, RNG = NCHP / RGRP;
#define MFMA16(a, b, c) __builtin_amdgcn_mfma_f32_16x16x32_bf16((a), (b), (c), 0, 0, 0)
DI unsigned blk_row(unsigned r) { return 32u * r + 128u * (r >> 3); }
DI unsigned tr_base(unsigned lane) { const unsigned g = lane >> 4, q = (lane & 15) >> 2, p = lane & 3; return blk_row(8 * g + q) + 8 * p; }
DI bf16x8 tr_frag(const LAS unsigned char* base_lane, int c, int ks) {
    const s16x4 lo = ds_tr(base_lane + c * RC_BLK + ks * 1536), hi = ds_tr(base_lane + c * RC_BLK + ks * 1536 + 128); return __builtin_shufflevector(lo, hi, 0, 1, 2, 3, 4, 5, 6, 7);
}
DI u32x4 scale8(u32x4 v, float s) { u32x4 o; o.x = pk2(bflo(v.x) * s, bfhi(v.x) * s); o.y = pk2(bflo(v.y) * s, bfhi(v.y) * s); o.z = pk2(bflo(v.z) * s, bfhi(v.z) * s); o.w = pk2(bflo(v.w) * s, bfhi(v.w) * s); return o; }
template <bool LOAD, bool BF> DI void ret_state_io(LAS unsigned char* L, void* gpv  , f32x4 (&S)[16], int tid, int wave) {
    LAS float* T = (LAS float*)(L + RC_QX); const int lane = tid & 63, c16 = lane & 15, g = lane >> 4; float* gp = (float*)gpv; bf16_t* gb = (bf16_t*)gpv;
#pragma unroll
    for (int p = 0; p < 4; ++p) {
        LDS_BARRIER();
        if (LOAD) {
            if (BF) {
#pragma unroll
                for (int i = 0; i < 2; ++i) { const int idx = tid + 512 * i, row = idx >> 4, c8 = idx & 15; const u32x4 v = *(const u32x4*)(gb + (size_t)(64 * p + row) * RDV + 8 * c8); LAS float* tp = T + row * 132 + 8 * c8;
                    tp[0] = bflo(v.x); tp[1] = bfhi(v.x); tp[2] = bflo(v.y); tp[3] = bfhi(v.y); tp[4] = bflo(v.z); tp[5] = bfhi(v.z); tp[6] = bflo(v.w); tp[7] = bfhi(v.w); }
            } else {
#pragma unroll
                for (int i = 0; i < 4; ++i) { const int idx = tid + 512 * i, row = idx >> 5, c4 = idx & 31; const f32x4 v = *(const f32x4*)(gp + (size_t)(64 * p + row) * RDV + 4 * c4); LAS float* tp = T + row * 132 + 4 * c4; tp[0] = v.x; tp[1] = v.y; tp[2] = v.z; tp[3] = v.w; }
            }
            LDS_BARRIER();
#pragma unroll
            for (int kq = 0; kq < 4; ++kq)
#pragma unroll
                for (int i = 0; i < 4; ++i) { const float v = T[(16 * kq + 4 * g + i) * 132 + 16 * wave + c16];
                    S[4 * p + kq][i] = v; }
        } else {
#pragma unroll
            for (int kq = 0; kq < 4; ++kq)
#pragma unroll
                for (int i = 0; i < 4; ++i) { const float v = S[4 * p + kq][i]; T[(16 * kq + 4 * g + i) * 132 + 16 * wave + c16] = v; }
            LDS_BARRIER();
            if (BF) {
#pragma unroll
                for (int i = 0; i < 2; ++i) { const int idx = tid + 512 * i, row = idx >> 4, c8 = idx & 15; const LAS float* tp = T + row * 132 + 8 * c8;
                    u32x4 o; o.x = pk2(tp[0], tp[1]); o.y = pk2(tp[2], tp[3]); o.z = pk2(tp[4], tp[5]); o.w = pk2(tp[6], tp[7]); *(u32x4*)(gb + (size_t)(64 * p + row) * RDV + 8 * c8) = o; }
            } else {
#pragma unroll
                for (int i = 0; i < 4; ++i) { const int idx = tid + 512 * i, row = idx >> 5, c4 = idx & 31; const LAS float* tp = T + row * 132 + 4 * c4; *(f32x4*)(gp + (size_t)(64 * p + row) * RDV + 4 * c4) = (f32x4){tp[0], tp[1], tp[2], tp[3]}; }
            }
        }
    }
    LDS_BARRIER();
}
template <int MODE>
DI void ret_chain_phase(const WG& w, const bf16_t* P, bf16_t* O, const float* state_in, bf16_t* slots, float* outS, int dup) {
    LAS unsigned char* L = w.lds;
    const int ntask = (MODE == 0) ? RNG * 32 : RNG * 32 + DBATCH * 32;
    for (int task = w.bid; task < ntask; task += w.G) {
        const bool smp = task >= RNG * 32; const int ts = smp ? task - RNG * 32 : task, gb = ts >> 5, hh = (ts >> 2) & 7, j = ts & 3;
        const int c_lo = smp ? NCHP + gb : RGRP * gb, nch = smp ? 1 : RGRP;
        const size_t so = ((size_t)gb * RH + hh) * RDK * RDV;
        const int dvw = 128 * j + 16 * w.wave; const float lg2 = ret_lg2(hh), gam64 = __builtin_amdgcn_exp2f(lg2 * 64.f);
        int lane0 = w.lane; asm volatile("" : "+v"(lane0));
        f32x4 S[16];
        if (MODE == 1) { if (smp) ret_state_io<true, false>(L, (void*)(state_in + so + 128 * j), S, w.tid, w.wave); else ret_state_io<true, true>(L, (void*)(slots + so + 128 * j), S, w.tid, w.wave); }
        else {
#pragma unroll
            for (int kt = 0; kt < 16; ++kt) S[kt] = (f32x4){0.f, 0.f, 0.f, 0.f}; }
        u32x4 pq[4], pk[4], pv[2];
        {   const int tid = w.tid;
#pragma unroll
            for (int i = 0; i < 4; ++i) { const int idx = tid + 512 * i, t = idx >> 5, dc = idx & 31; const bf16_t* pr = P + (size_t)(64 * c_lo + t) * RIN + hh * 256 + dc * 8;
                if (MODE == 1) pq[i] = *(const u32x4*)pr; pk[i] = *(const u32x4*)(pr + 2048); }
#pragma unroll
            for (int i = 0; i < 2; ++i) { const int idx = tid + 512 * i, t = idx >> 4, dc = idx & 15; pv[i] = *(const u32x4*)(P + (size_t)(64 * c_lo + t) * RIN + 4096 + hh * 512 + 128 * j + dc * 8); } }
#pragma unroll 1
        for (int cc = 0; cc < nch; ++cc) { const int c = c_lo + cc;
            int tid = w.tid; asm volatile("" : "+v"(tid)); const int ln = tid & 63, c16 = ln & 15, g = ln >> 4;
            LDS_BARRIER();
#pragma unroll
            for (int i = 0; i < 4; ++i) { const int idx = tid + 512 * i, t = idx >> 5, dc = idx & 31;
                if (MODE == 1) *(LAS u32x4*)(L + RC_QX + (t * RC_QS + dc * 8) * 2) = scale8(pq[i], __builtin_amdgcn_exp2f(lg2 * (float)(t + 1)));
                *(LAS u32x4*)(L + RC_KZ + (dc >> 1) * RC_BLK + blk_row(t) + (dc & 1) * 16) = scale8(pk[i], __builtin_amdgcn_exp2f(lg2 * (float)(63 - t))); }
#pragma unroll
            for (int i = 0; i < 2; ++i) { const int idx = tid + 512 * i, t = idx >> 4, dc = idx & 15; *(LAS u32x4*)(L + RC_VT + (dc >> 1) * RC_BLK + blk_row(t) + (dc & 1) * 16) = pv[i]; }
            LDS_BARRIER();
            if (cc + 1 < nch) {
#pragma unroll
                for (int i = 0; i < 4; ++i) { const int idx = tid + 512 * i, t = idx >> 5, dc = idx & 31; const bf16_t* pr = P + (size_t)(64 * (c + 1) + t) * RIN + hh * 256 + dc * 8;
                    if (MODE == 1) pq[i] = *(const u32x4*)pr; pk[i] = *(const u32x4*)(pr + 2048); }
#pragma unroll
                for (int i = 0; i < 2; ++i) { const int idx = tid + 512 * i, t = idx >> 4, dc = idx & 15; pv[i] = *(const u32x4*)(P + (size_t)(64 * (c + 1) + t) * RIN + 4096 + hh * 512 + 128 * j + dc * 8); } }
            const LAS unsigned char* kb = L + RC_KZ + tr_base(ln); const LAS unsigned char* vb = L + RC_VT + tr_base(ln) + w.wave * RC_BLK;
            const bf16x8 vf0 = tr_frag(vb, 0, 0), vf1 = tr_frag(vb, 0, 1);
            if (MODE == 1) {
                const LAS bf16_t* Qx = (const LAS bf16_t*)(L + RC_QX); LAS bf16_t* PT = (LAS bf16_t*)(L + RC_PT);
                const float gm64 = __builtin_amdgcn_exp2f(-64.f * lg2);
#pragma unroll
                for (int q2 = 0; q2 < 2; ++q2) { const int tile = w.wave + 8 * q2, tt = tile >> 2, st = tile & 3; f32x4 d = (f32x4){0.f, 0.f, 0.f, 0.f};
                    if (st <= tt) {
#pragma unroll
                        for (int ks = 0; ks < 8; ++ks) { const bf16x8 af = *(const LAS bf16x8*)(Qx + (16 * tt + c16) * RC_QS + 32 * ks + 8 * g);
                            const bf16x8 bfr = *(const LAS bf16x8*)(L + RC_KZ + (2 * ks + (g >> 1)) * RC_BLK + blk_row(16 * st + c16) + 16 * (g & 1)); d = MFMA16(af, bfr, d); } }
#pragma unroll
                    for (int i = 0; i < 4; ++i) { const int t = 16 * tt + 4 * g + i, sx = 16 * st + c16; PT[t * RC_PS + sx] = f2bf((sx <= t) ? d[i] * gm64 : 0.f); } }
                f32x4 o[4];
#pragma unroll
                for (int tt = 0; tt < 4; ++tt) o[tt] = (f32x4){0.f, 0.f, 0.f, 0.f};
#pragma unroll
                for (int kp = 0; kp < 8; ++kp) { u32x4 sp; sp.x = pk2(S[2 * kp][0], S[2 * kp][1]); sp.y = pk2(S[2 * kp][2], S[2 * kp][3]); sp.z = pk2(S[2 * kp + 1][0], S[2 * kp + 1][1]); sp.w = pk2(S[2 * kp + 1][2], S[2 * kp + 1][3]);
                    const bf16x8 sf = __builtin_bit_cast(bf16x8, sp);
#pragma unroll
                    for (int tt = 0; tt < 4; ++tt) { const LAS bf16_t* qp = Qx + (16 * tt + c16) * RC_QS + 32 * kp + 4 * g; const s16x4 lo = *(const LAS s16x4*)qp, hi = *(const LAS s16x4*)(qp + 16);
                        const bf16x8 af = __builtin_shufflevector(lo, hi, 0, 1, 2, 3, 4, 5, 6, 7); o[tt] = MFMA16(af, sf, o[tt]); } if (kp & 1) asm volatile("" ::: "memory"); }
                LDS_BARRIER();
#pragma unroll
                for (int tt = 0; tt < 4; ++tt) { const bf16x8 p0 = *(const LAS bf16x8*)(PT + (16 * tt + c16) * RC_PS + 8 * g), p1 = *(const LAS bf16x8*)(PT + (16 * tt + c16) * RC_PS + 32 + 8 * g);
                    o[tt] = MFMA16(p0, vf0, o[tt]); o[tt] = MFMA16(p1, vf1, o[tt]); }
                LAS float* os = (LAS float*)(L + RC_OS + w.wave * (64 * RC_OSS * 4));
#pragma unroll
                for (int tt = 0; tt < 4; ++tt)
#pragma unroll
                    for (int i = 0; i < 4; ++i) os[(16 * tt + 4 * g + i) * RC_OSS + c16] = o[tt][i];
                const f32x4 r0 = *(const LAS f32x4*)(os + ln * RC_OSS), r1 = *(const LAS f32x4*)(os + ln * RC_OSS + 4), r2 = *(const LAS f32x4*)(os + ln * RC_OSS + 8), r3 = *(const LAS f32x4*)(os + ln * RC_OSS + 12);
                u32x4 n0, n1; n0.x = pk2(r0.x, r0.y); n0.y = pk2(r0.z, r0.w); n0.z = pk2(r1.x, r1.y); n0.w = pk2(r1.z, r1.w); n1.x = pk2(r2.x, r2.y); n1.y = pk2(r2.z, r2.w); n1.z = pk2(r3.x, r3.y); n1.w = pk2(r3.z, r3.w);
                bf16_t* orow = O + (size_t)(64 * c + ln) * RVD + hh * 512 + dvw;
                if (!dup) { *(u32x4*)orow = n0; *(u32x4*)(orow + 8) = n1; }
            }
            if (MODE == 0 || smp || cc + 1 < nch) {
#pragma unroll
                for (int kt = 0; kt < 16; ++kt) { S[kt] = S[kt] * gam64;
                    const bf16x8 k0 = tr_frag(kb, kt, 0), k1 = tr_frag(kb, kt, 1);
                    S[kt] = MFMA16(k0, vf0, S[kt]); S[kt] = MFMA16(k1, vf1, S[kt]); if ((kt & 3) == 3) asm volatile("" ::: "memory"); }
            }
        }
        if (MODE == 0) ret_state_io<false, true>(L, (void*)(slots + so + 128 * j), S, w.tid, w.wave); else if (smp) ret_state_io<false, false>(L, (void*)(outS + so + 128 * j), S, w.tid, w.wave);
    }
}
DI void ret_prefix_phase(const WG& w, bf16_t* slots, float* outP) {
    constexpr int N8 = RH * RDK * RDV / 8;
    for (int e = w.bid * 512 + w.tid; e < N8; e += w.G * 512) { const int hh = e / (RDK * RDV / 8); const float g512 = __builtin_amdgcn_exp2f(ret_lg2(hh) * (float)(64 * RGRP));
        float carry[8];
#pragma unroll
        for (int q = 0; q < 8; ++q) carry[q] = 0.f;
#pragma unroll 8
        for (int g = 0; g < RNG; ++g) { u32x4* p = (u32x4*)slots + (size_t)g * N8 + e; const u32x4 t = *p;
            u32x4 o; o.x = pk2(carry[0], carry[1]); o.y = pk2(carry[2], carry[3]); o.z = pk2(carry[4], carry[5]); o.w = pk2(carry[6], carry[7]); *p = o;
            const float tv[8] = {bflo(t.x), bfhi(t.x), bflo(t.y), bfhi(t.y), bflo(t.z), bfhi(t.z), bflo(t.w), bfhi(t.w)};
#pragma unroll
            for (int q = 0; q < 8; ++q) carry[q] = carry[q] * g512 + tv[q]; }
        ((f32x4*)outP)[2 * e] = (f32x4){carry[0], carry[1], carry[2], carry[3]}; ((f32x4*)outP)[2 * e + 1] = (f32x4){carry[4], carry[5], carry[6], carry[7]}; }
}
DI void ret_gn_phase(const WG& w, const bf16_t* P, bf16_t* O, const float* gnw, bf16_t* Odst) {
    for (int idx0 = w.gw * 4; idx0 < M * RH; idx0 += w.ngw * 4) {
        u32x4 ov[4], gv[4];
#pragma unroll
        for (int q = 0; q < 4; ++q) { const int idx = idx0 + q, m = idx >> 3, hh = idx & 7; ov[q] = *(const u32x4*)(O + (size_t)m * RVD + hh * 512 + 8 * w.lane); gv[q] = *(const u32x4*)(P + (size_t)m * RIN + 8192 + hh * 512 + 8 * w.lane); }
#pragma unroll
        for (int q = 0; q < 4; ++q) { const int idx = idx0 + q, m = idx >> 3, hh = idx & 7;
            float x[8] = {bflo(ov[q].x), bfhi(ov[q].x), bflo(ov[q].y), bfhi(ov[q].y), bflo(ov[q].z), bfhi(ov[q].z), bflo(ov[q].w), bfhi(ov[q].w)};
            const float gt[8] = {bflo(gv[q].x), bfhi(gv[q].x), bflo(gv[q].y), bfhi(gv[q].y), bflo(gv[q].z), bfhi(gv[q].z), bflo(gv[q].w), bfhi(gv[q].w)};
            float s = 0.f;
#pragma unroll
            for (int e = 0; e < 8; ++e) s += x[e];
            const float mean = wave_sum_fast(s) * (1.f / 512.f); float s2 = 0.f;
#pragma unroll
            for (int e = 0; e < 8; ++e) { x[e] -= mean; s2 += x[e] * x[e]; }
            const float rs = 1.f / sqrtf(wave_sum_fast(s2) * (1.f / 512.f) + 1e-5f);
            const float* gp = gnw + hh * 512 + 8 * w.lane; const f32x4 g0 = *(const f32x4*)gp, g1 = *(const f32x4*)(gp + 4); const float gw8[8] = {g0.x, g0.y, g0.z, g0.w, g1.x, g1.y, g1.z, g1.w};
#pragma unroll
            for (int e = 0; e < 8; ++e) x[e] = x[e] * rs * gw8[e] * (gt[e] / (1.f + __expf(-gt[e])));
            u32x4 o; o.x = pk2(x[0], x[1]); o.y = pk2(x[2], x[3]); o.z = pk2(x[4], x[5]); o.w = pk2(x[6], x[7]); *(u32x4*)(Odst + (size_t)m * RVD + hh * 512 + 8 * w.lane) = o; }
    }
}
constexpr int REC_WT = 0, REC_BHT = 8192, REC_RT = 16384, REC_ARB = 24576, REC_VT = 32768, REC_VK = 40960, REC_AKV = 49152, REC_PL = 57344, REC = 57600;
constexpr int WSEG = 32, WNSEG = NCHP / WSEG;
constexpr size_t SEGBUF = (size_t)WSEG * WH * REC;
constexpr int PP_S = 72;
constexpr int PP_AT = 0, PP_RT = 9216, PP_BT = 18432, PP_KT = 27648, PP_KH = 36864, PP_VT = 46080, PP_AAK = 55296, PP_ARK = 64512, PP_AAB = 73728, PP_X2 = 90112, PP_PART = 106496, PP_X1 = 110592, PP_ARB = 126976, PP_BHT = 136192, PP_MT = 145408;
DI int pswap(int k) { return (k & ~12) | ((k & 4) << 1) | ((k & 8) >> 1); }

DI void copy_tile_pswap(const LAS bf16_t* T, unsigned char* dst, int task) {
    const int row = task >> 2, m = task & 3; const LAS u32x4* sp = (const LAS u32x4*)(T + row * PP_S + 16 * m); const u32x4 a = sp[0], b = sp[1];
    u32x4 o0, o1; o0.x = a.x; o0.y = a.y; o0.z = b.x; o0.w = b.y; o1.x = a.z; o1.y = a.w; o1.z = b.z; o1.w = b.w;
    u32x4* dp = (u32x4*)(dst + row * 128 + 32 * m); dp[0] = o0; dp[1] = o1;
}
DI void copy_tile_pswap_f32(const LAS float* T, unsigned char* dst, int task) {
    const int row = task >> 2, m = task & 3; const LAS f32x4* sp = (const LAS f32x4*)(T + row * 64 + 16 * m); const f32x4 a0 = sp[0], a1 = sp[1], b0 = sp[2], b1 = sp[3];
    u32x4 o0, o1; o0.x = pk2(a0.x, a0.y); o0.y = pk2(a0.z, a0.w); o0.z = pk2(b0.x, b0.y); o0.w = pk2(b0.z, b0.w); o1.x = pk2(a1.x, a1.y); o1.y = pk2(a1.z, a1.w); o1.z = pk2(b1.x, b1.y); o1.w = pk2(b1.z, b1.w);
    u32x4* dp = (u32x4*)(dst + row * 128 + 32 * m); dp[0] = o0; dp[1] = o1;
}
struct RwkvIn { const bf16_t *Rb, *Kb, *Vb, *Ab, *Gb; const float* LW; const float *k_k, *k_a, *r_k, *ln_w, *ln_b; float* bonus; bf16_t* Ob; };

struct PrepRaw { unsigned short rb[8], kb[8], vb[8], ab[8]; float lw[8]; };
DI void prep_load(const WG& w, const RwkvIn& in, int c, int hd, PrepRaw& q) {
    int lane = w.lane; asm volatile("" : "+v"(lane));
#pragma unroll
    for (int i = 0; i < 8; ++i) { const size_t off = (size_t)(64 * c + 8 * w.wave + i) * DM + hd * 64 + lane; q.rb[i] = in.Rb[off]; q.kb[i] = in.Kb[off]; q.vb[i] = in.Vb[off]; q.ab[i] = in.Ab[off]; q.lw[i] = in.LW[off]; }
}
DI void rwkv_prep_pair(const WG& w, const RwkvIn& in, int c, int hd, unsigned char* rec, const PrepRaw& raw, gu32* qctr, volatile LAS unsigned* qw) {
    LAS bf16_t* AT = (LAS bf16_t*)(w.lds + PP_AT); LAS bf16_t* RT2 = (LAS bf16_t*)(w.lds + PP_RT); LAS bf16_t* BT = (LAS bf16_t*)(w.lds + PP_BT); LAS bf16_t* KT = (LAS bf16_t*)(w.lds + PP_KT);
    LAS bf16_t* KHt = (LAS bf16_t*)(w.lds + PP_KH); LAS bf16_t* VtL = (LAS bf16_t*)(w.lds + PP_VT); LAS bf16_t* AAK = (LAS bf16_t*)(w.lds + PP_AAK); LAS bf16_t* ARK = (LAS bf16_t*)(w.lds + PP_ARK);
    LAS float* AAB = (LAS float*)(w.lds + PP_AAB); LAS float* X2 = (LAS float*)(w.lds + PP_X2); LAS float* PART = (LAS float*)(w.lds + PP_PART); LAS float* X1 = (LAS float*)(w.lds + PP_X1); LAS bf16_t* ARBT = (LAS bf16_t*)(w.lds + PP_ARB); LAS bf16_t* BHT_T = (LAS bf16_t*)(w.lds + PP_BHT);
    int lane_ = w.lane; asm volatile("" : "+v"(lane_));
    const int lane = lane_, tg = w.wave, col = hd * 64 + lane, r = lane & 31, h = lane >> 5;
    LDS_BARRIER();
    {
        const float kkc = in.k_k[col], kac = in.k_a[col], rkc = in.r_k[col];
        float rr[8], kp[8], aa[8], lw[8], kk[8], cl[8], bsum[8]; unsigned short vb[8], kb[8];
        float run = 0.f;
#pragma unroll
        for (int i = 0; i < 8; ++i) { rr[i] = bf2f(raw.rb[i]); kb[i] = raw.kb[i]; vb[i] = raw.vb[i]; aa[i] = bf2f(raw.ab[i]); lw[i] = raw.lw[i]; }
#pragma unroll
        for (int i = 0; i < 8; ++i) { const float kr = bf2f(kb[i]);
            const float kkr = kr * kkc; const float ss = wave_sum_fast(kkr * kkr); kk[i] = kkr / fmaxf(sqrtf(ss), 1e-12f); kp[i] = kr * (1.f + (aa[i] - 1.f) * kac);
            bsum[i] = wave_sum_fast(rr[i] * kp[i] * rkc);
            run += lw[i]; cl[i] = run; }
        if (lane < 8) { float bv = bsum[0];
#pragma unroll
            for (int i = 1; i < 8; ++i) bv = (lane == i) ? bsum[i] : bv;
            in.bonus[(size_t)(64 * c + 8 * tg + lane) * WH + hd] = bv; }
        PART[tg * 64 + lane] = run;
        LDS_BARRIER();
        float pre = 0.f, tot = 0.f;
#pragma unroll
        for (int t2 = 0; t2 < 8; ++t2) { const float p = PART[t2 * 64 + lane]; tot += p; if (t2 < tg) pre += p; }
        unsigned short khs[8], bhs[8];
#pragma unroll
        for (int i = 0; i < 8; ++i) { const int t = 8 * tg + i; const float cs = pre + cl[i], csp = cs - lw[i];
            const float e_cs = __expf(cs), e_ncs = __expf(-cs), e_csp = __expf(csp), e_l = __expf(tot - cs); const float b = kk[i] * aa[i];
            const unsigned short rt = f2bf(rr[i] * e_cs);
            AT[t * PP_S + lane] = f2bf(-kk[i] * e_csp); RT2[t * PP_S + lane] = rt; BT[t * PP_S + lane] = f2bf(b * e_ncs); KT[t * PP_S + lane] = f2bf(kp[i] * e_ncs);
            khs[i] = f2bf(kp[i] * e_l); bhs[i] = f2bf(b * e_l); }
        u32x4 kq, vq; kq.x = khs[0] | ((unsigned)khs[1] << 16); kq.y = khs[2] | ((unsigned)khs[3] << 16); kq.z = khs[4] | ((unsigned)khs[5] << 16); kq.w = khs[6] | ((unsigned)khs[7] << 16);
        vq.x = vb[0] | ((unsigned)vb[1] << 16); vq.y = vb[2] | ((unsigned)vb[3] << 16); vq.z = vb[4] | ((unsigned)vb[5] << 16); vq.w = vb[6] | ((unsigned)vb[7] << 16);
        *(LAS u32x4*)(KHt + lane * PP_S + 8 * tg) = kq; *(LAS u32x4*)(VtL + lane * PP_S + 8 * tg) = vq;
        { u32x4 bq; bq.x = bhs[0] | ((unsigned)bhs[1] << 16); bq.y = bhs[2] | ((unsigned)bhs[3] << 16); bq.z = bhs[4] | ((unsigned)bhs[5] << 16); bq.w = bhs[6] | ((unsigned)bhs[7] << 16);
          *(LAS u32x4*)(BHT_T + lane * PP_S + 8 * tg) = bq; }
        if (tg == 0) ((float*)(rec + REC_PL))[lane] = __expf(tot);
    }
    LDS_BARRIER();
    {
        const int pi = tg >> 1, tt = tg & 1; const LAS bf16_t* X = (pi < 2) ? AT : RT2; const LAS bf16_t* Y = (pi & 1) ? KT : BT;
#pragma unroll
        for (int si = 0; si < 2; ++si) { f32x16 d = zero16();
            if (si <= tt) {
#pragma unroll
                for (int ks = 0; ks < 4; ++ks) { const bf16x8 xa = *(const LAS bf16x8*)(X + (32 * tt + r) * PP_S + 16 * ks + 8 * h), yb = *(const LAS bf16x8*)(Y + (32 * si + r) * PP_S + 16 * ks + 8 * h);
                    d = (pi == 0) ? MFMA32(yb, xa, d) : MFMA32(xa, yb, d); } }
            if (pi == 0) {
#pragma unroll
                for (int e = 0; e < 16; ++e) { const int sx = 32 * si + (e & 3) + 8 * (e >> 2) + 4 * h, t = 32 * tt + r; AAB[sx * 64 + t] = (sx < t) ? d[e] : 0.f; }
            } else { const int sx = 32 * si + r;
#pragma unroll
                for (int e = 0; e < 16; ++e) { const int t = 32 * tt + (e & 3) + 8 * (e >> 2) + 4 * h; const bool keep = (pi < 2) ? (sx < t) : (sx <= t); const float val = keep ? d[e] : 0.f;
                    if (pi == 1) AAK[t * PP_S + sx] = f2bf(val); else if (pi == 3) ARK[t * PP_S + sx] = f2bf(val); else ARBT[t * PP_S + sx] = f2bf(val); } } }
    }
    LDS_BARRIER();
    if (tg == 7 && lane == 0) qw[0] = __hip_atomic_fetch_add(qctr, 1u, __ATOMIC_RELAXED, __HIP_MEMORY_SCOPE_AGENT);
    for (int id = tg; id < 12; id += 8) { const int prod = id >> 2, it = (id >> 1) & 1, vt = id & 1; const LAS bf16_t* Am = (prod == 0) ? AAK : (prod == 1 ? ARK : KHt);
        f32x16 d = zero16();
#pragma unroll
        for (int ks = 0; ks < 4; ++ks) { const bf16x8 a = *(const LAS bf16x8*)(Am + (32 * it + r) * PP_S + 16 * ks + 8 * h), b = *(const LAS bf16x8*)(VtL + (32 * vt + r) * PP_S + 16 * ks + 8 * h); d = MFMA32(a, b, d); }
        if (prod == 0) {
#pragma unroll
            for (int e = 0; e < 16; ++e) X2[(32 * it + (e & 3) + 8 * (e >> 2) + 4 * h) * 64 + 32 * vt + r] = d[e];
        } else { u32x4* dst = (u32x4*)(rec + (prod == 1 ? REC_AKV : REC_VK) + ((it * 2 + vt) * 64 + lane) * 32);
            u32x4 o0, o1; o0.x = pk2(d[0], d[1]); o0.y = pk2(d[2], d[3]); o0.z = pk2(d[4], d[5]); o0.w = pk2(d[6], d[7]); o1.x = pk2(d[8], d[9]); o1.y = pk2(d[10], d[11]); o1.z = pk2(d[12], d[13]); o1.w = pk2(d[14], d[15]);
            dst[0] = o0; dst[1] = o1; } }
    LAS bf16_t* MT = (LAS bf16_t*)(w.lds + PP_MT);
    if (tg >= 4) {
        const int b = tg - 4; float y[16]; const bool live = b > (lane >> 4);
        const LAS f32x4* np = (const LAS f32x4*)(AAB + lane * 64 + 16 * b); const f32x4 n0 = np[0], n1 = np[1], n2 = np[2], n3 = np[3];
        const float nv[16] = {n0.x, n0.y, n0.z, n0.w, n1.x, n1.y, n1.z, n1.w, n2.x, n2.y, n2.z, n2.w, n3.x, n3.y, n3.z, n3.w};
#pragma unroll
        for (int i2 = 0; i2 < 16; ++i2) y[i2] = live ? nv[i2] : 0.f;
#pragma unroll
        for (int i2 = 0; i2 < 15; ++i2) { const LAS f32x4* ap = (const LAS f32x4*)(AAB + (16 * b + i2) * 64 + 16 * b); const f32x4 a0 = ap[0], a1 = ap[1], a2 = ap[2], a3 = ap[3];
            const float av[16] = {a0.x, a0.y, a0.z, a0.w, a1.x, a1.y, a1.z, a1.w, a2.x, a2.y, a2.z, a2.w, a3.x, a3.y, a3.z, a3.w};
#pragma unroll
            for (int i3 = i2 + 1; i3 < 16; ++i3) y[i3] += av[i3] * y[i2]; }
#pragma unroll
        for (int i2 = 0; i2 < 16; ++i2) MT[(16 * b + i2) * PP_S + lane] = f2bf(y[i2]);
    }
    LDS_BARRIER();
    LAS bf16_t* YT0 = BT; LAS bf16_t* YT1 = KHt;
    {
        const int b = tg & 3, colw = (tg >> 2) * 64 + lane; float y[16];
#pragma unroll
        for (int i2 = 0; i2 < 16; ++i2) y[i2] = (colw < 64) ? bf2f(AT[(16 * b + i2) * PP_S + colw]) : X2[(16 * b + i2) * 64 + colw - 64];
#pragma unroll
        for (int i2 = 0; i2 < 15; ++i2) { const LAS f32x4* ap = (const LAS f32x4*)(AAB + (16 * b + i2) * 64 + 16 * b); const f32x4 a0 = ap[0], a1 = ap[1], a2 = ap[2], a3 = ap[3];
            const float av[16] = {a0.x, a0.y, a0.z, a0.w, a1.x, a1.y, a1.z, a1.w, a2.x, a2.y, a2.z, a2.w, a3.x, a3.y, a3.z, a3.w};
#pragma unroll
            for (int i3 = i2 + 1; i3 < 16; ++i3) y[i3] += av[i3] * y[i2]; }
        LAS float* yf = (colw < 64) ? X1 + colw : X2 + (colw - 64);
#pragma unroll
        for (int i2 = 0; i2 < 16; ++i2) yf[(16 * b + i2) * 64] = y[i2];
        u32x4 o0, o1; o0.x = pk2(y[0], y[1]); o0.y = pk2(y[2], y[3]); o0.z = pk2(y[4], y[5]); o0.w = pk2(y[6], y[7]); o1.x = pk2(y[8], y[9]); o1.y = pk2(y[10], y[11]); o1.z = pk2(y[12], y[13]); o1.w = pk2(y[14], y[15]);
        LAS u32x4* yp = (LAS u32x4*)(YT0 + colw * PP_S + 16 * b); yp[0] = o0; yp[1] = o1;
    }
    LDS_BARRIER();
    {
        const int rt = tg & 1, ct = tg >> 1; LAS float* Yf = (ct < 2) ? X1 + 32 * ct : X2 + 32 * (ct - 2);
        f32x16 yacc;
#pragma unroll
        for (int e2 = 0; e2 < 16; ++e2) yacc[e2] = Yf[(32 * rt + (e2 & 3) + 8 * (e2 >> 2) + 4 * h) * 64 + r];
        bf16x8 mf[4];
#pragma unroll
        for (int ks = 0; ks < 4; ++ks) mf[ks] = *(const LAS bf16x8*)(MT + (32 * rt + r) * PP_S + 16 * ks + 8 * h);
#pragma unroll
        for (int st = 0; st < 3; ++st) { const LAS bf16_t* src = (st & 1) ? YT1 : YT0; LAS bf16_t* dstt = (st & 1) ? YT0 : YT1;
            f32x16 acc = yacc;
#pragma unroll
            for (int ks = 0; ks < 4; ++ks) { const bf16x8 bfr = *(const LAS bf16x8*)(src + (32 * ct + r) * PP_S + 16 * ks + 8 * h); acc = MFMA32(mf[ks], bfr, acc); }
            if (st < 2) {
#pragma unroll
                for (int gq = 0; gq < 4; ++gq) { u32x2 o; o.x = pk2(acc[4 * gq], acc[4 * gq + 1]); o.y = pk2(acc[4 * gq + 2], acc[4 * gq + 3]); *(LAS u32x2*)(dstt + (32 * ct + r) * PP_S + 32 * rt + 8 * gq + 4 * h) = o; }
                LDS_BARRIER();
            } else if (ct < 2) {
#pragma unroll
                for (int e2 = 0; e2 < 16; ++e2) Yf[(32 * rt + (e2 & 3) + 8 * (e2 >> 2) + 4 * h) * 64 + r] = acc[e2];
            } else { u32x4* dst = (u32x4*)(rec + REC_VT + ((rt * 2 + (ct - 2)) * 64 + lane) * 32); u32x4 o0, o1;
                o0.x = pk2(acc[0], acc[1]); o0.y = pk2(acc[2], acc[3]); o0.z = pk2(acc[4], acc[5]); o0.w = pk2(acc[6], acc[7]); o1.x = pk2(acc[8], acc[9]); o1.y = pk2(acc[10], acc[11]); o1.z = pk2(acc[12], acc[13]); o1.w = pk2(acc[14], acc[15]);
                dst[0] = o0; dst[1] = o1; }
        }
    }
    LDS_BARRIER();
    for (int task = w.tid; task < 1024; task += 512) { const int which = task >> 8, tk = task & 255;
        if (which == 0) copy_tile_pswap(RT2, rec + REC_RT, tk); else if (which == 1) copy_tile_pswap(ARBT, rec + REC_ARB, tk); else if (which == 2) copy_tile_pswap(BHT_T, rec + REC_BHT, tk); else copy_tile_pswap_f32(X1, rec + REC_WT, tk); }
}
DI f32x16 ld_acc_init(const unsigned char* p) { const u32x4 a = ((const u32x4*)p)[0], b = ((const u32x4*)p)[1]; f32x16 o;
    o[0] = bflo(a.x); o[1] = bfhi(a.x); o[2] = bflo(a.y); o[3] = bfhi(a.y); o[4] = bflo(a.z); o[5] = bfhi(a.z); o[6] = bflo(a.w); o[7] = bfhi(a.w);
    o[8] = bflo(b.x); o[9] = bfhi(b.x); o[10] = bflo(b.y); o[11] = bfhi(b.y); o[12] = bflo(b.z); o[13] = bfhi(b.z); o[14] = bflo(b.w); o[15] = bfhi(b.w); return o; }
DI void rwkv_scan_task(int lane, const unsigned char* recs, size_t rec_stride, int nch, int hd, int vh, int row0, const float* s_in, float* s_out, bf16_t* Ob, int dup) {
    const int r = lane & 31, h = lane >> 5, v = 32 * vh + r;
    f32x16 sT[2];
#pragma unroll
    for (int kt = 0; kt < 2; ++kt)
#pragma unroll
        for (int e = 0; e < 16; ++e) sT[kt][e] = s_in ? s_in[v * 64 + 32 * kt + (e & 3) + 8 * (e >> 2) + 4 * h] : 0.f;
#pragma unroll 1
    for (int cc = 0; cc < nch; ++cc) { const unsigned char* rec = recs + (size_t)cc * rec_stride;
        const bf16_t* WTp = (const bf16_t*)(rec + REC_WT); const bf16_t* BHp = (const bf16_t*)(rec + REC_BHT); const bf16_t* RTp = (const bf16_t*)(rec + REC_RT); const bf16_t* ARp = (const bf16_t*)(rec + REC_ARB);
        bf16x8 Sf[2][2], Uf[2][2];
#pragma unroll
        for (int kt = 0; kt < 2; ++kt) { Sf[kt][0] = pack8(sT[kt], 0); Sf[kt][1] = pack8(sT[kt], 1); }
#pragma unroll
        for (int rt = 0; rt < 2; ++rt) { f32x16 u = ld_acc_init(rec + REC_VT + ((rt * 2 + vh) * 64 + lane) * 32);
#pragma unroll
            for (int kt = 0; kt < 2; ++kt)
#pragma unroll
                for (int s2 = 0; s2 < 2; ++s2) { const bf16x8 a = *(const bf16x8*)(WTp + (32 * rt + r) * 64 + 32 * kt + 16 * s2 + 8 * h); u = MFMA32(a, Sf[kt][s2], u); }
            Uf[rt][0] = pack8(u, 0); Uf[rt][1] = pack8(u, 1); }
        f32x16 n[2];
#pragma unroll
        for (int kt = 0; kt < 2; ++kt) { n[kt] = ld_acc_init(rec + REC_VK + ((kt * 2 + vh) * 64 + lane) * 32);
#pragma unroll
            for (int rt = 0; rt < 2; ++rt)
#pragma unroll
                for (int s2 = 0; s2 < 2; ++s2) { const bf16x8 a = *(const bf16x8*)(BHp + (32 * kt + r) * 64 + 32 * rt + 16 * s2 + 8 * h); n[kt] = MFMA32(a, Uf[rt][s2], n[kt]); } }
#pragma unroll
        for (int rt = 0; rt < 2; ++rt) { f32x16 o = ld_acc_init(rec + REC_AKV + ((rt * 2 + vh) * 64 + lane) * 32);
#pragma unroll
            for (int kt = 0; kt < 2; ++kt)
#pragma unroll
                for (int s2 = 0; s2 < 2; ++s2) { const bf16x8 a = *(const bf16x8*)(RTp + (32 * rt + r) * 64 + 32 * kt + 16 * s2 + 8 * h); o = MFMA32(a, Sf[kt][s2], o); }
#pragma unroll
            for (int r2 = 0; r2 < 2; ++r2)
#pragma unroll
                for (int s2 = 0; s2 < 2; ++s2) { const bf16x8 a = *(const bf16x8*)(ARp + (32 * rt + r) * 64 + 32 * r2 + 16 * s2 + 8 * h); o = MFMA32(a, Uf[r2][s2], o); }
#pragma unroll
            for (int e = 0; e < 16; ++e) { const unsigned short ov = f2bf(o[e]); if (!dup) Ob[(size_t)(row0 + 64 * cc + 32 * rt + (e & 3) + 8 * (e >> 2) + 4 * h) * DM + hd * 64 + v] = ov; } }
        const float* pl = (const float*)(rec + REC_PL);
#pragma unroll
        for (int kt = 0; kt < 2; ++kt)
#pragma unroll
            for (int gq = 0; gq < 4; ++gq) { const f32x4 p4 = *(const f32x4*)(pl + 32 * kt + 8 * gq + 4 * h);
#pragma unroll
                for (int i = 0; i < 4; ++i) sT[kt][4 * gq + i] = p4[i] * sT[kt][4 * gq + i] + n[kt][4 * gq + i]; }
    }
#pragma unroll
    for (int kt = 0; kt < 2; ++kt)
#pragma unroll
        for (int e = 0; e < 16; ++e) { if (!dup) s_out[v * 64 + 32 * kt + (e & 3) + 8 * (e >> 2) + 4 * h] = sT[kt][e]; }
}
constexpr int SA_SLOT = 25600  , SA_VT = 16384, SA_VK = 20480, SA_PL = 24576, SX_OFF = 4 * SA_SLOT;
DI void sc_issue(const unsigned char* recs, size_t rec_stride, int nch, int cj, LAS unsigned char* L, int wave, int lane, int vh) {
    const int ca = cj < nch ? cj : nch - 1; const unsigned char* ra = recs + (size_t)ca * rec_stride; LAS unsigned char* sa = L + (cj & 3) * SA_SLOT;
    const int row8 = lane >> 3, c16 = (lane & 7) ^ (row8 & 7);
#pragma unroll
    for (int i = 0; i < 5; ++i) { const int j = (wave - 3) + 5 * i; const unsigned char* src; LAS unsigned char* dst;
        if (j < 16) { const int m = j >> 3, blk = j & 7; src = ra + m * 8192 + (8 * blk + row8) * 128 + c16 * 16; dst = sa + m * 8192 + blk * 1024; }
        else if (j < 24) { const int jj = j - 16, a = jj >> 2, piece = jj & 3; src = ra + REC_VT + a * 8192 + ((piece >> 1) * 2 + vh) * 2048 + (piece & 1) * 1024 + lane * 16; dst = sa + SA_VT + a * 4096 + piece * 1024; }
        else { src = ra + REC_PL + (lane & 15) * 16; dst = sa + SA_PL; }
        __builtin_amdgcn_global_load_lds((const unsigned*)src, (LAS unsigned*)dst, 16, 0, 0); }
}
DI f32x16 unpack_acc(u32x4 a, u32x4 b) { f32x16 o;
    o[0] = bflo(a.x); o[1] = bfhi(a.x); o[2] = bflo(a.y); o[3] = bfhi(a.y); o[4] = bflo(a.z); o[5] = bfhi(a.z); o[6] = bflo(a.w); o[7] = bfhi(a.w);
    o[8] = bflo(b.x); o[9] = bfhi(b.x); o[10] = bflo(b.y); o[11] = bfhi(b.y); o[12] = bflo(b.z); o[13] = bfhi(b.z); o[14] = bflo(b.w); o[15] = bfhi(b.w); return o; }
DI f32x16 ld_acc_init_lds(const LAS unsigned char* p) { return unpack_acc(((const LAS u32x4*)p)[0], ((const LAS u32x4*)p)[1]); }
DI bf16x8 sc_frag(const LAS unsigned char* mat, int row, int cidx) { return *(const LAS bf16x8*)(mat + row * 128 + ((cidx ^ (row & 7)) << 4)); }
DI void rwkv_scan_prompt(const WG& w, const unsigned char* recs, size_t rec_stride, int nch, int hd, int vh, int row0, const float* s_in, float* s_out, bf16_t* Ob, int dup) {
    const int lane = w.lane, wave = w.wave, r = lane & 31, h = lane >> 5, v = 32 * vh + r;
    LAS unsigned char* L = w.lds;
    if (wave == 0) {
        f32x16 sT[2];
#pragma unroll
        for (int kt = 0; kt < 2; ++kt)
#pragma unroll
            for (int e = 0; e < 16; ++e) sT[kt][e] = s_in ? s_in[v * 64 + 32 * kt + (e & 3) + 8 * (e >> 2) + 4 * h] : 0.f;
#pragma unroll
        for (int kt = 0; kt < 2; ++kt)
#pragma unroll
            for (int e = 0; e < 16; ++e) asm volatile("" : "+v"(sT[kt][e]));
        LDS_BARRIER();
#pragma unroll 1
        for (int cc = 0; cc < nch + 2; ++cc) {
            if (cc < nch && dup != 3) { const LAS unsigned char* sa = L + (cc & 3) * SA_SLOT; LAS unsigned char* ex = L + SX_OFF + (cc % 3) * 8192;
                bf16x8 Sf[4], Uf[4];
#pragma unroll
                for (int q = 0; q < 4; ++q) { Sf[q] = pack8(sT[q >> 1], q & 1); *(LAS bf16x8*)(ex + q * 1024 + lane * 16) = Sf[q]; }
                {   bf16x8 fa[2][4]; f32x16 u[2];
#pragma unroll
                    for (int rt = 0; rt < 2; ++rt) { u[rt] = ld_acc_init_lds(sa + SA_VT + rt * 2048 + lane * 32);
#pragma unroll
                        for (int q = 0; q < 4; ++q) fa[rt][q] = sc_frag(sa, 32 * rt + r, 2 * q + h); }
                    __builtin_amdgcn_sched_barrier(0);
#pragma unroll
                    for (int q = 0; q < 4; ++q)
#pragma unroll
                        for (int rt = 0; rt < 2; ++rt) u[rt] = MFMA32(fa[rt][q], Sf[q], u[rt]);
#pragma unroll
                    for (int q = 0; q < 4; ++q) { Uf[q] = pack8(u[q >> 1], q & 1); *(LAS bf16x8*)(ex + 4096 + q * 1024 + lane * 16) = Uf[q]; } }
                f32x16 n[2];
                {   bf16x8 fa[2][4];
#pragma unroll
                    for (int kt = 0; kt < 2; ++kt) { n[kt] = ld_acc_init_lds(sa + SA_VK + kt * 2048 + lane * 32);
#pragma unroll
                        for (int q = 0; q < 4; ++q) fa[kt][q] = sc_frag(sa + 8192, 32 * kt + r, 2 * q + h); }
                    __builtin_amdgcn_sched_barrier(0);
#pragma unroll
                    for (int q = 0; q < 4; ++q)
#pragma unroll
                        for (int kt = 0; kt < 2; ++kt) n[kt] = MFMA32(fa[kt][q], Uf[q], n[kt]); }
                const LAS float* pl = (const LAS float*)(sa + SA_PL);
#pragma unroll
                for (int kt = 0; kt < 2; ++kt)
#pragma unroll
                    for (int gq = 0; gq < 4; ++gq) { const f32x4 p4 = *(const LAS f32x4*)(pl + 32 * kt + 8 * gq + 4 * h);
#pragma unroll
                        for (int i = 0; i < 4; ++i) sT[kt][4 * gq + i] = p4[i] * sT[kt][4 * gq + i] + n[kt][4 * gq + i]; }
            }
            LDS_BARRIER();
        }
        LDS_BARRIER();
#pragma unroll
        for (int kt = 0; kt < 2; ++kt)
#pragma unroll
            for (int e = 0; e < 16; ++e) { if (!dup) s_out[v * 64 + 32 * kt + (e & 3) + 8 * (e >> 2) + 4 * h] = sT[kt][e]; }
    } else if (wave < 3) {
        bf16x8 gr[2][4], gu[2][4]; u32x4 ga[2][2];
        LDS_BARRIER();
#pragma unroll 1
        for (int cc = 0; cc < nch + 2; ++cc) {
            if ((((cc ^ wave) & 1) != 0) && dup != 3) { const int c2 = cc - 2;
                if (c2 >= 0) { const LAS unsigned char* ex = L + SX_OFF + (c2 % 3) * 8192;
                    bf16x8 Sf[4], Uf[4];
#pragma unroll
                    for (int q = 0; q < 4; ++q) { Sf[q] = *(const LAS bf16x8*)(ex + q * 1024 + lane * 16); Uf[q] = *(const LAS bf16x8*)(ex + 4096 + q * 1024 + lane * 16); }
                    f32x16 o[2];
#pragma unroll
                    for (int rt = 0; rt < 2; ++rt) o[rt] = unpack_acc(ga[rt][0], ga[rt][1]);
#pragma unroll
                    for (int q = 0; q < 4; ++q)
#pragma unroll
                        for (int rt = 0; rt < 2; ++rt) o[rt] = MFMA32(gr[rt][q], Sf[q], o[rt]);
#pragma unroll
                    for (int q = 0; q < 4; ++q)
#pragma unroll
                        for (int rt = 0; rt < 2; ++rt) o[rt] = MFMA32(gu[rt][q], Uf[q], o[rt]);
                    bf16_t* op = Ob + (size_t)(row0 + 64 * c2 + 4 * h) * DM + hd * 64 + v;
#pragma unroll
                    for (int rt = 0; rt < 2; ++rt)
#pragma unroll
                        for (int e = 0; e < 16; ++e) { const unsigned short ov = f2bf(o[rt][e]); if (!dup) op[(size_t)(32 * rt + (e & 3) + 8 * (e >> 2)) * DM] = ov; }
                }
                if (cc < nch) { const unsigned char* rec = recs + (size_t)cc * rec_stride;
#pragma unroll
                    for (int rt = 0; rt < 2; ++rt) { const u32x4* ap = (const u32x4*)(rec + REC_AKV + ((rt * 2 + vh) * 64 + lane) * 32); ga[rt][0] = ap[0]; ga[rt][1] = ap[1];
#pragma unroll
                        for (int q = 0; q < 4; ++q) { gr[rt][q] = *(const bf16x8*)(rec + REC_RT + ((32 * rt + r) * 64 + 16 * q + 8 * h) * 2); gu[rt][q] = *(const bf16x8*)(rec + REC_ARB + ((32 * rt + r) * 64 + 16 * q + 8 * h) * 2); } } }
            }
            LDS_BARRIER();
        }
        LDS_BARRIER();
    } else {
        sc_issue(recs, rec_stride, nch, 0, L, wave, lane, vh); sc_issue(recs, rec_stride, nch, 1, L, wave, lane, vh); sc_issue(recs, rec_stride, nch, 2, L, wave, lane, vh); asm volatile("s_waitcnt vmcnt(10)" ::: "memory");
        LDS_BARRIER();
#pragma unroll 1
        for (int cc = 0; cc < nch + 2; ++cc) { sc_issue(recs, rec_stride, nch, cc + 3, L, wave, lane, vh); if (dup != 2) asm volatile("s_waitcnt vmcnt(10)" ::: "memory");
            LDS_BARRIER(); }
        asm volatile("s_waitcnt vmcnt(0)" ::: "memory");
        LDS_BARRIER();
    }
}
DI float sum8_dpp(float v) {
#define DPP_ADD_(ctrl) v += __builtin_bit_cast(float, __builtin_amdgcn_update_dpp(0, __builtin_bit_cast(int, v), ctrl, 0xf, 0xf, true));
    DPP_ADD_(0xB1) DPP_ADD_(0x4E) DPP_ADD_(0x141)
#undef DPP_ADD_
    return v;
}
constexpr int FIN_RPW = 36, FIN_RG_A = (MP - 64 * WSEG) / FIN_RPW  , FIN_RG_B = (MP + FIN_RPW - 1) / FIN_RPW  ;
template <bool EARLY> DI void rwkv_final_phase(const WG& w, const RwkvIn& in, bf16_t* Odst, int gw, int ngw) {
    constexpr int RPW = FIN_RPW, NRG = M / RPW, NE = FIN_RG_A + (NRG - FIN_RG_B), NL = FIN_RG_B - FIN_RG_A;
    for (int task = gw; task < 4 * (EARLY ? NE : NL); task += ngw) { const int cq = task & 3, ix = task >> 2, rg = EARLY ? (ix < FIN_RG_A ? ix : ix - FIN_RG_A + FIN_RG_B) : ix + FIN_RG_A, m0 = rg * RPW, c0 = 512 * cq + 8 * w.lane, hd = c0 >> 6;
        const f32x4 w0 = *(const f32x4*)(in.ln_w + c0), w1 = *(const f32x4*)(in.ln_w + c0 + 4), b0 = *(const f32x4*)(in.ln_b + c0), b1 = *(const f32x4*)(in.ln_b + c0 + 4);
        const float lw8[8] = {w0.x, w0.y, w0.z, w0.w, w1.x, w1.y, w1.z, w1.w}, lb8[8] = {b0.x, b0.y, b0.z, b0.w, b1.x, b1.y, b1.z, b1.w};
#pragma unroll 4
        for (int rr = 0; rr < RPW; ++rr) { const int m = m0 + rr; const size_t off = (size_t)m * DM + c0;
            const u32x4 ov = *(const u32x4*)(in.Ob + off), vv = *(const u32x4*)(in.Vb + off), gv = *(const u32x4*)(in.Gb + off);
            const float bon = in.bonus[(size_t)m * WH + hd];
            float o[8] = {bflo(ov.x), bfhi(ov.x), bflo(ov.y), bfhi(ov.y), bflo(ov.z), bfhi(ov.z), bflo(ov.w), bfhi(ov.w)};
            const float vf[8] = {bflo(vv.x), bfhi(vv.x), bflo(vv.y), bfhi(vv.y), bflo(vv.z), bfhi(vv.z), bflo(vv.w), bfhi(vv.w)};
            const float gf[8] = {bflo(gv.x), bfhi(gv.x), bflo(gv.y), bfhi(gv.y), bflo(gv.z), bfhi(gv.z), bflo(gv.w), bfhi(gv.w)};
            float s1 = 0.f;
#pragma unroll
            for (int e = 0; e < 8; ++e) s1 += o[e];
            const float mean = sum8_dpp(s1) * (1.f / 64.f); float s2 = 0.f;
#pragma unroll
            for (int e = 0; e < 8; ++e) { o[e] -= mean; s2 += o[e] * o[e]; }
            const float rs = 1.f / sqrtf(sum8_dpp(s2) * (1.f / 64.f) + 64e-5f);
#pragma unroll
            for (int e = 0; e < 8; ++e) o[e] = (o[e] * rs * lw8[e] + lb8[e] + bon * vf[e]) * gf[e];
            u32x4 r; r.x = pk2(o[0], o[1]); r.y = pk2(o[2], o[3]); r.z = pk2(o[4], o[5]); r.w = pk2(o[6], o[7]); *(u32x4*)(Odst + off) = r; }
    }
}
DI void rwkv_phi(const WG& w, const RwkvIn& in, int k, unsigned char* seg0, unsigned char* seg1, unsigned char* sbuf, const float* st_in, float* outP, float* outS, int dup, gu32* qctr, volatile LAS unsigned* qw) {
    if (k >= 1 && w.bid < 64) {
        const int sg = k - 1, hd = w.bid >> 1, vh = w.bid & 1; const unsigned char* sb = (sg & 1) ? seg1 : seg0; float* st = outP + (size_t)hd * 4096;
        rwkv_scan_prompt(w, sb + (size_t)hd * REC, (size_t)WH * REC, WSEG, hd, vh, 64 * WSEG * sg, sg == 0 ? nullptr : st, st, in.Ob, dup);
    }
    {
        const int nseg = (k < WNSEG) ? WSEG * WH : 0, nsmp = (k == 1 || k == 2) ? 512 : 0, lo = (k - 1) * 512, ntot = nseg + nsmp;
        unsigned char* sb = (k & 1) ? seg1 : seg0;
#define PAIR_OF(q, cvar, hvar, rvar) { if ((q) < nseg) { cvar = WSEG * k + ((q) >> 5); hvar = (q) & 31; rvar = sb + (size_t)(q) * REC; } else { const int p_ = lo + (q) - nseg; cvar = NCHP + (p_ >> 5); hvar = p_ & 31; rvar = sbuf + (size_t)p_ * REC; } }
#define Q_FETCH(var) { if (w.tid == 0) qw[0] = __hip_atomic_fetch_add(qctr, 1u, __ATOMIC_RELAXED, __HIP_MEMORY_SCOPE_AGENT); LDS_BARRIER(); var = (int)qw[0]; LDS_BARRIER(); }
        if (ntot > 0) {
            PrepRaw cur, nxt; int q, qn; Q_FETCH(q) Q_FETCH(qn)
            if (q < ntot) { int c0, h0; unsigned char* r0; PAIR_OF(q, c0, h0, r0) (void)r0; prep_load(w, in, c0, h0, cur); }
#pragma unroll 1
            while (q < ntot) { int cc_, hh_; unsigned char* rr_; PAIR_OF(q, cc_, hh_, rr_)
                if (qn < ntot) { int c1, h1; unsigned char* r1; PAIR_OF(qn, c1, h1, r1) (void)r1; prep_load(w, in, c1, h1, nxt); }
                rwkv_prep_pair(w, in, cc_, hh_, rr_, cur, qctr, qw);
                const int q2 = (int)qw[0];
                cur = nxt; q = qn; qn = q2; }
        }
#undef Q_FETCH
#undef PAIR_OF
    }
    if (k == 3) { const int nb = w.G, b0 = w.bid;
        for (int id = b0 * 8 + w.wave; id < DBATCH * WH * 2; id += nb * 8) { const int p = id >> 1, vh = id & 1, b = p >> 5, hd = p & 31;
            rwkv_scan_task(w.lane, sbuf + (size_t)p * REC, 0, 1, hd, vh, MP + 64 * b, st_in + (size_t)p * 4096, outS + (size_t)p * 4096, in.Ob, dup); } }
    if (k == WNSEG && w.bid >= 64 && !dup) rwkv_final_phase<true>(w, in, in.Ob, (w.bid - 64) * 8 + w.wave, (w.G - 64) * 8);
}
constexpr size_t MiB = (size_t)1 << 20;
constexpr size_t WS_CTL = 0, CTL_ZERO_BYTES = 1 * MiB;
constexpr size_t WS_WUP = 1 * MiB, WS_WDN = 33 * MiB, WS_WMIX = 65 * MiB, WS_H = 129 * MiB, WS_BIG = 201 * MiB, WS_SS = WS_BIG + 777 * MiB, WS_END = WS_SS + 23 * MiB;
constexpr size_t U72 = 72 * MiB;
constexpr int CW_BAR = 4096, CW_QUEUE = 16384, CW_SPLIT = 65536;
constexpr int LDS_BYTES = 163840, LDSCTL_OFF = LDS_BYTES - 512, MISC_OFF = LDSCTL_OFF + 320;
constexpr int NPHASE = 36;

constexpr size_t O_Y = 0, O_KP = (size_t)M * DM, O_VP = O_KP + 65536, O_KS = O_VP + 65536, O_VS = O_KS + 2097152, O_RP = O_VS + 2097152, O_RS = O_RP + 1048576,
                 O_WP = O_RS + 33554432, O_WS = O_WP + 131072, O_SHP = O_WS + 4194304, O_SHS = O_SHP + 2048, O_END = O_SHS + 65536;

struct Args { const float* in[34]; float* out; unsigned char* ws; int ph_lo, ph_hi, dup, pad; };

DI void up_convert(const WG& w, const Args& a, int layer, int b0, int nb) { convert_w(w, a.in[32] + (size_t)layer * DM * DFF, DM, DFF, (bf16_t*)(a.ws + WS_WUP), DM, DFF, a.in[8] + (size_t)layer * DM, b0, nb); }
DI void dn_convert(const WG& w, const Args& a, int layer, int b0, int nb) { convert_w(w, a.in[33] + (size_t)layer * DFF * DM, DFF, DM, (bf16_t*)(a.ws + WS_WDN), DFF, DM, nullptr, b0, nb); }
DI void attn_convert(const WG& w, const Args& a, int j, int layer, int b0, int nb) {
    convert_w(w, a.in[10] + (size_t)j * DM * AQKV, DM, AQKV, (bf16_t*)(a.ws + WS_WMIX), DM, AQKV, a.in[7] + (size_t)layer * DM, b0, nb);
    convert_w(w, a.in[12] + (size_t)j * DM * DM, DM, DM, (bf16_t*)(a.ws + WS_WMIX + 10 * MiB), DM, DM, nullptr, b0, nb);
}
DI void ret_convert(const WG& w, const Args& a, int b0, int nb) {
    convert_w(w, a.in[13], DM, RIN, (bf16_t*)(a.ws + WS_WMIX), DM, RIN, a.in[7] + 1 * DM, b0, nb); convert_w(w, a.in[15], RVD, DM, (bf16_t*)(a.ws + WS_WMIX + 48 * MiB), RVD, DM, nullptr, b0, nb);
}
DI void rwkv_convert(const WG& w, const Args& a, int b0, int nb) {
    unsigned char* WMIX = a.ws + WS_WMIX;
#pragma unroll 1
    for (int z = 0; z < 3; ++z) convert_w(w, a.in[17] + (size_t)z * DM * DM, DM, DM, (bf16_t*)(WMIX + (size_t)z * 8 * MiB), DM, DM, nullptr, b0, nb);
    convert_w(w, a.in[18], DM, DM, (bf16_t*)(WMIX + 24 * MiB), DM, DM, nullptr, b0, nb);
    convert_w(w, a.in[20], DM, 96, (bf16_t*)(WMIX + 32 * MiB), DM, 256, nullptr, b0, nb); convert_w(w, a.in[23], DM, 96, (bf16_t*)(WMIX + 33 * MiB), DM, 256, nullptr, b0, nb); convert_w(w, a.in[25], DM, 256, (bf16_t*)(WMIX + 34 * MiB), DM, 256, nullptr, b0, nb);
    convert_w(w, a.in[21], 96, DM, (bf16_t*)(WMIX + 35 * MiB), 256, DM, nullptr, b0, nb); convert_w(w, a.in[24], 96, DM, (bf16_t*)(WMIX + 36 * MiB), 256, DM, nullptr, b0, nb); convert_w(w, a.in[26], 256, DM, (bf16_t*)(WMIX + 37 * MiB), 256, DM, nullptr, b0, nb);
}

__global__ void __launch_bounds__(512, 2) fwd_kernel(Args args) {
    extern __shared__ __attribute__((aligned(16))) unsigned char lds_raw[];
    WG w; w.lds = (LAS unsigned char*)lds_raw; w.tid = threadIdx.x; w.lane = w.tid & 63; w.wave = __builtin_amdgcn_readfirstlane(w.tid >> 6);
    w.G = gridDim.x; w.bid = blockIdx.x; w.gw = w.bid * 8 + w.wave; w.ngw = w.G * 8;
    volatile LAS unsigned* MISC = (volatile LAS unsigned*)(w.lds + MISC_OFF);
    for (int u = w.tid; u < (LDS_BYTES - LDSCTL_OFF) / 4; u += 512) ((LAS unsigned*)(w.lds + LDSCTL_OFF))[u] = 0u;
    __syncthreads();
    unsigned char* ws = args.ws; gu32* ctl = (gu32*)(ws + WS_CTL);
    XcdBarrier bar; bar.bar = (unsigned*)(ctl + CW_BAR); bar.x = 0; bar.st = nullptr;
#if !MK_PER_PHASE
    bar = xcd_barrier_post((unsigned*)(ctl + CW_BAR), MISC + 8, w.wave);
#endif
    const int lo = args.ph_lo, hi = args.ph_hi;
    bf16_t* XBO = args.dup ? (bf16_t*)(ws + WS_BIG + 432 * MiB) : (bf16_t*)(ws + WS_H); const size_t ssd = args.dup ? ((WS_BIG + 504 * MiB) - WS_SS) / 4 : 0;
    bf16_t* XB = (bf16_t*)(ws + WS_H);
    float* SS = (float*)(ws + WS_SS);
    bf16_t* WUP = (bf16_t*)(ws + WS_WUP); bf16_t* WDN = (bf16_t*)(ws + WS_WDN); unsigned char* WMIX = ws + WS_WMIX; unsigned char* BIG = ws + WS_BIG;
    const float* norm_mix = args.in[7];
    int ph = 0;
#if MK_PER_PHASE
#define SEAM() do { } while (0)
#else
#define SEAM() xcd_barrier(bar, w.wave)
#endif
#define PH_BEGIN if (ph >= lo && ph < hi) { { const int l_ = lane_now(); w.lane = l_; w.tid = w.wave * 64 + l_; }
#define PH_END   if (ph + 1 < hi) SEAM(); } ++ph;
#define GEMM_LDS ((PG8_LAS unsigned char*)w.lds)
#define SSQ(s) (SS + (size_t)(s) * M * 32)
#define RSTAB ((const LAS float*)(w.lds + pg8::RSTAB_OFF))
#define SK_SLAB ((float*)(BIG + 300 * MiB))
#define SK_CNT ((unsigned*)(ctl + CW_SPLIT + (size_t)(ph * 16 + (args.dup & 15)) * 256))
#define SK_SETUP if (w.tid == 0) { volatile LAS unsigned long long* skp_ = (volatile LAS unsigned long long*)(w.lds + pg8::SK_LDS_OFF); skp_[0] = (unsigned long long)SK_SLAB; }
#define GEMM_RESID_SK(Aexpr, Wexpr, Kdim, ssq_) { pg8::Gemm g{Aexpr, Wexpr, M, DM, Kdim, 0, 0}; pg8::Order S; S.init_full_rounds(M, DM, w.G, w.bid); pg8::EpiResid E{nullptr, nullptr, XBO, ssq_}; pg8::gemm_phase<pg8::EpiResid>(GEMM_LDS, g, S, E, w.wave); \
        pg8::OrderSK S2; S2.init(M, DM, w.G, w.bid); pg8::Unit u2; if (S2.next(0, u2)) { SK_SETUP const int st_ = w.bid % (w.G >> 2), ks_ = w.bid / (w.G >> 2); pg8::EpiSlab E2{(const LAS unsigned*)(w.lds + pg8::SK_LDS_OFF), st_ * 4 + ks_}; \
            pg8::gemm_phase<pg8::EpiSlab, true, true, true, pg8::OrderSK>(GEMM_LDS, g, S2, E2, w.wave); pg8::sk_reduce(w.lds, SK_SLAB, SK_CNT, u2, st_, ks_, XBO, ssq_, w.wave); } }
#define TAIL_B0 64
#define MLP_PHASES(s_in, tail_stmt) \
    PH_BEGIN { pg8::Gemm g{XB, WUP, M, DFF, DM, 0, 0}; pg8::Order S; S.init(M, DFF, 1, w.G, w.bid); pg8::fill_rs_table(w.lds, S, SSQ(s_in), w.tid); pg8::EpiRelu2 E{(bf16_t*)BIG, DFF, RSTAB}; pg8::gemm_phase<pg8::EpiRelu2>(GEMM_LDS, g, S, E, w.wave); } PH_END \
    PH_BEGIN { GEMM_RESID_SK((bf16_t*)BIG, WDN, DFF, SSQ((s_in) + 1) + ssd) tail_stmt } PH_END
#define ATTN_PHASES(j, resP_, resS_, s_in, tail_stmt) { \
    bf16_t* Qb = (bf16_t*)BIG; bf16_t* Kb = (bf16_t*)(BIG + 72 * MiB); bf16_t* Vb = (bf16_t*)(BIG + 81 * MiB); bf16_t* AO = (bf16_t*)(BIG + 90 * MiB); \
    const float* ck = args.in[2] + (size_t)(j) * 1048576; const float* cv = args.in[3] + (size_t)(j) * 1048576; \
    float* kS = args.out + O_KS + (size_t)(j) * 1048576; float* vS = args.out + O_VS + (size_t)(j) * 1048576; \
    PH_BEGIN { pg8::Gemm g{XB, (bf16_t*)WMIX, M, AQKV, DM, 0, 0}; pg8::Order S; S.init(M, AQKV, 1, w.G, w.bid); pg8::fill_rs_table(w.lds, S, SSQ(s_in), w.tid); pg8::EpiAttnQKV E{Qb, args.out, O_KP + (size_t)(j) * 32768, O_KS + (size_t)(j) * 1048576, RSTAB}; pg8::gemm_phase<pg8::EpiAttnQKV>(GEMM_LDS, g, S, E, w.wave); } PH_END \
    PH_BEGIN attn_phase(w, Qb, Kb, Vb, ck, cv, args.in[11] + (j) * AH, AO); cache_shift(w, ck, cv, kS, vS); PH_END \
    PH_BEGIN { pg8::Gemm g{AO, (bf16_t*)(WMIX + 10 * MiB), M, DM, DM, 0, 0}; pg8::Order S; S.init(M, DM, 1, w.G, w.bid); pg8::EpiResid E{resP_, resS_, XBO, SSQ((s_in) + 1) + ssd}; pg8::gemm_phase<pg8::EpiResid>(GEMM_LDS, g, S, E, w.wave); tail_stmt } PH_END }

    PH_BEGIN rows0(w, args.in[0], args.in[1], XB, SSQ(0)); attn_convert(w, args, 0, 0, 0, 0); up_convert(w, args, 0, 0, 0); PH_END
    ATTN_PHASES(0, args.in[0], args.in[1], 0, dn_convert(w, args, 0, TAIL_B0, w.G - TAIL_B0);)
    MLP_PHASES(1, ret_convert(w, args, TAIL_B0, w.G - TAIL_B0); up_convert(w, args, 1, TAIL_B0, w.G - TAIL_B0);)
    {
        bf16_t* P = (bf16_t*)BIG; bf16_t* RO = (bf16_t*)(BIG + 432 * MiB);
        PH_BEGIN { pg8::Gemm g{XB, (bf16_t*)WMIX, M, RIN, DM, 0, 0}; pg8::Order S; S.init(M, RIN, 1, w.G, w.bid); pg8::fill_rs_table(w.lds, S, SSQ(2), w.tid); pg8::EpiRetProj E{P, RSTAB}; pg8::gemm_phase<pg8::EpiRetProj>(GEMM_LDS, g, S, E, w.wave); } PH_END
        bf16_t* slots = (bf16_t*)(BIG + 576 * MiB);
        PH_BEGIN ret_chain_phase<0>(w, P, RO, args.in[4], slots, args.out + O_RS, 0); PH_END
        PH_BEGIN ret_prefix_phase(w, slots, args.out + O_RP); PH_END
        PH_BEGIN ret_chain_phase<1>(w, P, RO, args.in[4], slots, args.out + O_RS, args.dup); PH_END
        PH_BEGIN ret_gn_phase(w, P, RO, args.in[14], args.dup ? (bf16_t*)(BIG + 576 * MiB) : RO); PH_END
        PH_BEGIN { GEMM_RESID_SK(RO, (bf16_t*)(WMIX + 48 * MiB), RVD, SSQ(3) + ssd) dn_convert(w, args, 1, TAIL_B0, w.G - TAIL_B0); } PH_END
    }
    MLP_PHASES(3, rwkv_convert(w, args, TAIL_B0, w.G - TAIL_B0); up_convert(w, args, 2, TAIL_B0, w.G - TAIL_B0);)
    {
        bf16_t* XL = (bf16_t*)BIG; bf16_t* Rb = (bf16_t*)(BIG + 432 * MiB); bf16_t* L1 = (bf16_t*)(BIG + 648 * MiB);
        float* LW = (float*)BIG; bf16_t* Ab = (bf16_t*)(BIG + 144 * MiB); bf16_t* Gb = (bf16_t*)(BIG + 216 * MiB);
        unsigned char* seg0 = BIG + 288 * MiB; unsigned char* seg1 = BIG + 345 * MiB; float* bonus = (float*)(BIG + 402 * MiB); unsigned char* sbuf = BIG + 648 * MiB;
        bf16_t* Ob = (bf16_t*)(BIG + 705 * MiB);
        RwkvIn rin{Rb, Rb + (size_t)M * DM, Rb + (size_t)2 * M * DM, Ab, Gb, LW, args.in[27], args.in[28], args.in[29], args.in[30], args.in[31], bonus, Ob};
        PH_BEGIN lerp_rows(w, XB, SSQ(4), norm_mix + 2 * DM, args.in[6], args.in[16], XL, args.out + O_SHP, args.out + O_SHS); PH_END
        PH_BEGIN { { pg8::Gemm g{XL, (bf16_t*)WMIX, M, DM, DM, U72, 8 * MiB}; pg8::Order S; S.init(M, DM, 3, w.G, w.bid); pg8::EpiAct E{Rb, DM, (size_t)M * DM, 0, (const LAS float*)nullptr}; pg8::gemm_phase<pg8::EpiAct>(GEMM_LDS, g, S, E, w.wave); }
                   { pg8::Gemm g{XL + (size_t)3 * M * DM, (bf16_t*)(WMIX + 32 * MiB), M, 256, DM, U72, 1 * MiB}; pg8::Order S; S.init(M, 256, 3, w.G, w.bid); pg8::EpiAct E{L1, 256, (size_t)M * 256, 2 | (0 << 4) | (3 << 8), (const LAS float*)nullptr}; pg8::gemm_phase<pg8::EpiAct>(GEMM_LDS, g, S, E, w.wave); } } PH_END
        PH_BEGIN { int k2 = 256; asm volatile("" : "+s"(k2));     pg8::Gemm g{L1, (bf16_t*)(WMIX + 35 * MiB), M, DM, k2, (size_t)M * 256 * 2, 1 * MiB}; pg8::Order S; S.init(M, DM, 3, w.G, w.bid); pg8::EpiRwkv2 E{LW, Ab, args.in[19], args.in[22]}; pg8::gemm_phase<pg8::EpiRwkv2>(GEMM_LDS, g, S, E, w.wave); } PH_END
#pragma unroll 1
        for (int k = 0; k < 9; ++k) { PH_BEGIN rwkv_phi(w, rin, k, seg0, seg1, sbuf, args.in[5], args.out + O_WP, args.out + O_WS, args.dup, ctl + CW_QUEUE + 64 * (k + 16 * (args.dup & 15)), MISC + 16); PH_END }
        PH_BEGIN rwkv_final_phase<false>(w, rin, args.dup ? (bf16_t*)(BIG + 576 * MiB) : Ob, w.gw, w.ngw); PH_END
        PH_BEGIN { pg8::Gemm g{Ob, (bf16_t*)(WMIX + 24 * MiB), M, DM, DM, 0, 0}; pg8::Order S; S.init(M, DM, 1, w.G, w.bid); pg8::EpiResid E{nullptr, nullptr, XBO, SSQ(5) + ssd}; pg8::gemm_phase<pg8::EpiResid>(GEMM_LDS, g, S, E, w.wave); dn_convert(w, args, 2, TAIL_B0, w.G - TAIL_B0); } PH_END
    }
    MLP_PHASES(5, attn_convert(w, args, 1, 3, TAIL_B0, w.G - TAIL_B0); up_convert(w, args, 3, TAIL_B0, w.G - TAIL_B0);)
    ATTN_PHASES(1, (const float*)nullptr, (const float*)nullptr, 6, dn_convert(w, args, 3, TAIL_B0, w.G - TAIL_B0);)
    PH_BEGIN { pg8::Gemm g{XB, WUP, M, DFF, DM, 0, 0}; pg8::Order S; S.init(M, DFF, 1, w.G, w.bid); pg8::fill_rs_table(w.lds, S, SSQ(7), w.tid); pg8::EpiRelu2 E{(bf16_t*)BIG, DFF, RSTAB}; pg8::gemm_phase<pg8::EpiRelu2>(GEMM_LDS, g, S, E, w.wave); } PH_END
    PH_BEGIN { GEMM_RESID_SK((bf16_t*)BIG, WDN, DFF, SSQ(8) + ssd) } PH_END
    PH_BEGIN final_norm(w, XB, SSQ(8), args.in[9], args.out); PH_END
}

extern "C" void kernel_launch(void* const* d_in, const int* in_sizes, int n_in, void* d_out, int out_size, void* d_ws, size_t ws_size, hipStream_t stream) {
    static int grid = 0;
    if (grid == 0) {
        if (n_in != 34 || (size_t)out_size != O_END || ws_size < WS_END) { fprintf(stderr, "kernel_launch: unexpected shapes: n_in %d out %d ws %zu (need %zu)\n", n_in, out_size, ws_size, (size_t)WS_END); grid = -1; return; }
        int dev = 0, cus = 0;
        if (hipGetDevice(&dev) != hipSuccess || hipDeviceGetAttribute(&cus, hipDeviceAttributeMultiprocessorCount, dev) != hipSuccess) { grid = -1; return; }
        if (hipFuncSetAttribute((const void*)fwd_kernel, hipFuncAttributeMaxDynamicSharedMemorySize, LDS_BYTES) != hipSuccess) { fprintf(stderr, "kernel_launch: hipFuncSetAttribute failed\n"); grid = -1; return; }
        int per_cu = 0;
        if (hipOccupancyMaxActiveBlocksPerMultiprocessor(&per_cu, (const void*)fwd_kernel, 512, LDS_BYTES) != hipSuccess || per_cu < 1) { fprintf(stderr, "kernel_launch: occupancy query reports %d\n", per_cu); }
        (void)hipGetLastError();
        grid = cus;
    }
    if (grid < 0) return;
    (void)hipMemsetAsync((char*)d_ws + WS_CTL, 0, CTL_ZERO_BYTES, stream);
    Args a{};
    for (int i = 0; i < 34; ++i) a.in[i] = (const float*)d_in[i];
    a.out = (float*)d_out; a.ws = (unsigned char*)d_ws;
#if MK_PER_PHASE
    static const unsigned char REP[NPHASE] = { 1 };
    for (int p = 0; p < NPHASE; ++p) for (int r = 0; r < REP[p]; ++r) { a.ph_lo = p; a.ph_hi = p + 1; a.dup = (r == 0) ? 0 : 1; hipLaunchKernelGGL(fwd_kernel, dim3(grid), dim3(512), LDS_BYTES, stream, a); }
#else
    a.ph_lo = 0; a.ph_hi = NPHASE;
    hipLaunchKernelGGL(fwd_kernel, dim3(grid), dim3(512), LDS_BYTES, stream, a);
#endif
}
```

```cpp
#include <hip/hip_runtime.h>
#include <cstdio>
#include <cstdint>

#ifndef MK_PER_PHASE
#define MK_PER_PHASE 0
#endif

#define GAS __attribute__((address_space(1)))
#define LAS __attribute__((address_space(3)))
#define DI __device__ __forceinline__
typedef unsigned short bf16_t;
typedef short bf16x8 __attribute__((ext_vector_type(8)));
typedef short s16x4 __attribute__((ext_vector_type(4)));
typedef float f32x2 __attribute__((ext_vector_type(2)));
typedef float f32x4 __attribute__((ext_vector_type(4)));
typedef float f32x16 __attribute__((ext_vector_type(16)));
typedef unsigned u32x2 __attribute__((ext_vector_type(2)));
typedef unsigned u32x4 __attribute__((ext_vector_type(4)));
typedef __bf16 bf16x2_t __attribute__((ext_vector_type(2)));
typedef GAS unsigned gu32;

DI unsigned pk2(float lo, float hi) { f32x2 v = {lo, hi}; bf16x2_t b = __builtin_convertvector(v, bf16x2_t); return __builtin_bit_cast(unsigned, b); }
DI float bf2f(unsigned short u) { return __builtin_bit_cast(float, (unsigned)u << 16); }
DI float bflo(unsigned u) { return __builtin_bit_cast(float, u << 16); }
DI float bfhi(unsigned u) { return __builtin_bit_cast(float, u & 0xffff0000u); }
DI unsigned short f2bf(float f) { return (unsigned short)(pk2(f, 0.f) & 0xffffu); }
DI float wave_sum(float v) {
#pragma unroll
    for (int o = 1; o < 64; o <<= 1) v += __shfl_xor(v, o);
    return v;
}
DI float wave_sum_fast(float v) {
#define DPP_ADD_(ctrl) v += __builtin_bit_cast(float, __builtin_amdgcn_update_dpp(0, __builtin_bit_cast(int, v), ctrl, 0xf, 0xf, true));
    DPP_ADD_(0xB1) DPP_ADD_(0x4E) DPP_ADD_(0x141) DPP_ADD_(0x140)
#undef DPP_ADD_
    const int iv = __builtin_bit_cast(int, v);
    return (__builtin_bit_cast(float, __builtin_amdgcn_readlane(iv, 0)) + __builtin_bit_cast(float, __builtin_amdgcn_readlane(iv, 16))) + (__builtin_bit_cast(float, __builtin_amdgcn_readlane(iv, 32)) + __builtin_bit_cast(float, __builtin_amdgcn_readlane(iv, 48)));
}
DI float wave_max(float v) {
#pragma unroll
    for (int o = 1; o < 64; o <<= 1) v = fmaxf(v, __shfl_xor(v, o));
    return v;
}
DI void st16_wt(void* p, u32x4 v) { asm volatile("global_store_dwordx4 %0, %1, off sc1\n\ts_nop 1" :: "v"(p), "v"(v) : "memory"); }
DI void st8_wt(void* p, u32x2 v) { asm volatile("global_store_dwordx2 %0, %1, off sc1\n\ts_nop 1" :: "v"(p), "v"(v) : "memory"); }
DI int lane_now() { int l_; asm volatile("v_mbcnt_lo_u32_b32 %0, -1, 0\n\tv_mbcnt_hi_u32_b32 %0, -1, %0" : "=v"(l_)); return l_; }
#define MFMA32(a, b, c) __builtin_amdgcn_mfma_f32_32x32x16_bf16((a), (b), (c), 0, 0, 0)
#define LDS_WAIT() asm volatile("s_waitcnt lgkmcnt(0)" ::: "memory")
#define VM_WAIT() asm volatile("s_waitcnt vmcnt(0)" ::: "memory")
#define LDS_BARRIER() asm volatile("s_waitcnt lgkmcnt(0)\n\ts_barrier" ::: "memory")

constexpr int DM = 2048, SEQ = 16384, DBATCH = 32, DSEQ = 64, PAST = 4096;
constexpr int MP = SEQ, MS = DBATCH * DSEQ, M = MP + MS;
constexpr int NCHP = SEQ / 64, NCH = M / 64;
constexpr int DFF = 8192;
constexpr int AH = 32, AKV = 4, AHD = 64, AQKV = 2560, AWIN = 128;
constexpr int RH = 8, RDK = 256, RDV = 512, RIN = 12288, RVD = RH * RDV;
constexpr int WH = 32, WN = 64;
constexpr float NORM_EPS = 1e-5f;

namespace pg8 {
#define PG8_LAS __attribute__((address_space(3)))
#define PG8_GAS __attribute__((address_space(1)))
constexpr int BM = 256, BK = 64, HALF = 128, HTB = HALF * BK * 2  , STAGE_BYTES = 8 * HTB, NXCD = 8, WGM = 8;
__host__ __device__ __forceinline__ int lds_byte(int r, int c) { const int st = (r >> 4) * 2 + (c >> 5), rr = r & 15, cc = c & 31, ob = rr * 64 + cc * 2; return st * 1024 + (ob ^ (((ob >> 9) & 1) << 5)); }
__host__ __device__ __forceinline__ void stage_rc(int b, int& R, int& C) { const int st = b / 1024, sb = b % 1024, swz = sb ^ (((sb >> 9) & 1) << 5); R = (st >> 1) * 16 + swz / 64; C = (st & 1) * 32 + (swz % 64) / 2; }
__host__ __device__ __forceinline__ int perm32(int rho) { const int n = rho >> 4, i = rho & 15; return 8 * (i >> 2) + 4 * n + (i & 3); }

struct Unit { int pm, pn, z, i, ks, k0, nk; };
struct Gemm { const bf16_t* A; const bf16_t* Bt; int M, N, K; size_t zA, zB; };
constexpr int SK_LDS_OFF = 163840 - 512 + 320 + 96;

struct Order {
    int nM, nN, nz, per, G, c; long tot;
    __device__ __forceinline__ void init(int M, int N, int nz_, int G_, int c_) { nM = M / BM; nN = N / BM; nz = nz_; per = nM * nN; G = G_; c = c_; tot = (long)per * nz; }
    __device__ __forceinline__ bool split_ok() const { const int rem = per % G; return nz == 1 && rem > 0 && rem * 4 == G; }
    __device__ __forceinline__ void init_full_rounds(int M, int N, int G_, int c_) { init(M, N, 1, G_, c_); if (split_ok()) tot = (long)(per / G) * G; }
    __device__ __forceinline__ void map(long L, Unit& u) const {
        u.z = (int)(L / per); int wgid = (int)(L % per);
        { const int q = per / NXCD, r = per % NXCD, xcd = wgid % NXCD, off = wgid / NXCD; wgid = (xcd < r ? xcd * (q + 1) : r * (q + 1) + (xcd - r) * q) + off; }
        const int nig = WGM * nN, gid = wgid / nig, fm = gid * WGM, gsz = (nM - fm) < WGM ? (nM - fm) : WGM;
        u.pm = fm + ((wgid % nig) % gsz); u.pn = (wgid % nig) / gsz;
    }
    __device__ __forceinline__ bool next(int i, Unit& u) const {
        const long L = (long)i * G + c; if (L >= tot) return false;
        u.i = i; u.ks = 0; map(L, u); return true;
    }
};
struct OrderSK {
    Order o; int G, c, nsl;
    __device__ __forceinline__ void init(int M, int N, int G_, int c_, int nsl_) { o.init(M, N, 1, G_, c_); G = G_; c = c_; nsl = nsl_; }
    __device__ __forceinline__ bool next(int i, Unit& u, int nt_all) const {
        const int rem = G >> 2;
        if (i != 0 || !o.split_ok() || c >= rem * nsl) return false;
        u.i = o.per / G; u.ks = c / rem; o.map((long)u.i * G + c % rem, u);
        const int it = nt_all >> 1, b0 = (it * u.ks + nsl - 1) / nsl, b1 = (it * (u.ks + 1) + nsl - 1) / nsl; u.k0 = 2 * b0; u.nk = 2 * (b1 - b0); return true;
    }
    __device__ __forceinline__ bool next(int i, Unit& u) const { return false; }
};
template <class Epi, bool ALIGN_EPI = true, bool SP2 = true, bool SPLITK = false, class Ord = Order>
__device__ __forceinline__ void gemm_phase(PG8_LAS unsigned char* lds, const Gemm g, const Ord& S, const Epi& E, int wave_id) {
    const int wid = wave_id, lane = lane_now(), tid = wid * 64 + lane, wr = wid >> 2, wc = wid & 3, fr = lane & 15, fq = lane >> 4;
    const int K = g.K; int nt = K / BK;
    unsigned voffA[2], voffB[2];
#pragma unroll
    for (int i = 0; i < 2; ++i) { int R, C; stage_rc(tid * 16 + i * 8192, R, C); const int Rb = Epi::PERM ? ((R & ~31) + perm32(R & 31)) : R;
        voffA[i] = (unsigned)(R * K + C) * 2u; voffB[i] = (unsigned)(Rb * K + C) * 2u; }
    const size_t kstep = (size_t)(BK * 2);
    const size_t hstep = (size_t)HALF * K * 2;
    const size_t tstep = 2 * hstep;
    const unsigned ldsw = (unsigned)wid * 1024u;
    const int aoff = lds_byte(wr * 64 + fr, fq * 8), boff = lds_byte(wc * 32 + fr, fq * 8);
#define PG8_SA(b, h) (((b) * 2 + (h)) * HTB)
#define PG8_SB(b, h) ((4 + (b) * 2 + (h)) * HTB)
#define PG8_STAGE(bufoff, gbase, voff) do { _Pragma("unroll") for (int _i = 0; _i < 2; ++_i) \
        __builtin_amdgcn_global_load_lds((const unsigned*)((const char*)(gbase) + (voff)[_i]), (PG8_LAS unsigned*)(lds + (bufoff) + ldsw + _i * 8192), 16, 0, 0); } while (0)
#define PG8_LDA(dst, b, h) do { _Pragma("unroll") for (int m = 0; m < 4; ++m) _Pragma("unroll") for (int k = 0; k < 2; ++k) dst[m][k] = *(const PG8_LAS bf16x8*)(lds + PG8_SA(b, h) + aoff + m * 2048 + k * 1024); } while (0)
#define PG8_LDB(dst, b, h) do { _Pragma("unroll") for (int n = 0; n < 2; ++n) _Pragma("unroll") for (int k = 0; k < 2; ++k) dst[n][k] = *(const PG8_LAS bf16x8*)(lds + PG8_SB(b, h) + boff + n * 2048 + k * 1024); } while (0)
#define PG8_MMA(ai, bj, At, Bt) do { __builtin_amdgcn_s_setprio(1); _Pragma("unroll") for (int m = 0; m < 4; ++m) _Pragma("unroll") for (int n = 0; n < 2; ++n) _Pragma("unroll") for (int k = 0; k < 2; ++k) \
        acc[ai][bj][m][n] = __builtin_amdgcn_mfma_f32_16x16x32_bf16(Bt[n][k], At[m][k], acc[ai][bj][m][n], 0, 0, 0); __builtin_amdgcn_s_setprio(0); } while (0)
#define PG8_WAIT_V(n) asm volatile("s_waitcnt vmcnt(" #n ")" ::: "memory")
#define PG8_WAIT_L(n) asm volatile("s_waitcnt lgkmcnt(" #n ")" ::: "memory")
#define PG8_BAR __builtin_amdgcn_s_barrier()
#define PG8_SCHED __builtin_amdgcn_sched_barrier(0)
    Unit cur, nxt; int ui = 0;
    if constexpr (SPLITK) { if (!S.next(0, cur, nt)) return; nt = cur.nk; asm volatile("" : "+s"(nt)); }
    else { if (!S.next(0, cur)) return; }
    f32x4 acc[2][2][4][2];
#pragma unroll
    for (int a = 0; a < 2; ++a)
#pragma unroll
        for (int b = 0; b < 2; ++b)
#pragma unroll
            for (int m = 0; m < 4; ++m)
#pragma unroll
                for (int n = 0; n < 2; ++n) acc[a][b][m][n] = (f32x4){0.f, 0.f, 0.f, 0.f};
    bf16x8 At[4][2], B0[2][2], B1[2][2];
#define PG8_KOFF(u) (SPLITK ? (size_t)(u).k0 * kstep : (size_t)0)
    const char* cA = (const char*)g.A + (size_t)cur.z * g.zA + (size_t)cur.pm * tstep + PG8_KOFF(cur); const char* cB = (const char*)g.Bt + (size_t)cur.z * g.zB + (size_t)cur.pn * tstep + PG8_KOFF(cur);
    if constexpr (SP2) {
        PG8_STAGE(PG8_SB(0, 0), cB, voffB); PG8_STAGE(PG8_SB(0, 1), cB + hstep, voffB); PG8_STAGE(PG8_SA(0, 0), cA, voffA); PG8_STAGE(PG8_SA(0, 1), cA + hstep, voffA);
        if (wr == 1) PG8_BAR;
        PG8_WAIT_V(2); PG8_BAR;
        PG8_STAGE(PG8_SB(1, 0), cB + kstep, voffB); PG8_STAGE(PG8_SA(1, 0), cA + kstep, voffA); PG8_STAGE(PG8_SB(1, 1), cB + hstep + kstep, voffB);
        PG8_WAIT_V(6); PG8_BAR;
    } else {
        PG8_STAGE(PG8_SB(0, 0), cB, voffB); PG8_STAGE(PG8_SA(0, 0), cA, voffA); PG8_STAGE(PG8_SB(0, 1), cB + hstep, voffB); PG8_STAGE(PG8_SA(0, 1), cA + hstep, voffA);
        if (wr == 1) PG8_BAR;
        PG8_WAIT_V(4); PG8_BAR;
        PG8_STAGE(PG8_SB(1, 0), cB + kstep, voffB); PG8_STAGE(PG8_SA(1, 0), cA + kstep, voffA); PG8_STAGE(PG8_SB(1, 1), cB + hstep + kstep, voffB);
        PG8_WAIT_V(6); PG8_BAR;
    }
    for (;;) {
        const bool has_next = S.next(ui + 1, nxt);
        const char* nA = has_next ? (const char*)g.A + (size_t)nxt.z * g.zA + (size_t)nxt.pm * tstep : cA; const char* nB = has_next ? (const char*)g.Bt + (size_t)nxt.z * g.zB + (size_t)nxt.pn * tstep : cB;
        for (int t = 0; t < nt; t += 2) {
            const bool last = (t == nt - 2);
            const char* a1 = cA + (size_t)(t + 1) * kstep;
            const char* a2 = last ? nA : cA + (size_t)(t + 2) * kstep; const char* b2 = last ? nB : cB + (size_t)(t + 2) * kstep;
            const char* a3 = a2 + kstep; const char* b3 = b2 + kstep;
            if constexpr (SP2) {
            PG8_LDB(B0, 0, 0); PG8_LDB(B1, 0, 1); PG8_SCHED; PG8_LDA(At, 0, 0); PG8_STAGE(PG8_SA(1, 1), a1 + hstep, voffA);
            PG8_WAIT_V(8); PG8_WAIT_L(0); PG8_BAR; PG8_MMA(0, 0, At, B0); PG8_MMA(0, 1, At, B1); PG8_BAR; PG8_SCHED;
            PG8_LDA(At, 0, 1); PG8_STAGE(PG8_SB(0, 0), b2, voffB); PG8_STAGE(PG8_SB(0, 1), b2 + hstep, voffB); PG8_STAGE(PG8_SA(0, 0), a2, voffA);
            PG8_WAIT_V(8); PG8_WAIT_L(0); PG8_BAR; PG8_MMA(1, 0, At, B0); PG8_MMA(1, 1, At, B1); PG8_BAR; PG8_SCHED;
            PG8_LDB(B0, 1, 0); PG8_LDB(B1, 1, 1); PG8_SCHED; PG8_LDA(At, 1, 0); PG8_STAGE(PG8_SA(0, 1), a2 + hstep, voffA);
            PG8_WAIT_V(8); PG8_WAIT_L(0); PG8_BAR; PG8_MMA(0, 0, At, B0); PG8_MMA(0, 1, At, B1); PG8_BAR; PG8_SCHED;
            PG8_LDA(At, 1, 1); PG8_STAGE(PG8_SB(1, 0), b3, voffB); PG8_STAGE(PG8_SB(1, 1), b3 + hstep, voffB); PG8_STAGE(PG8_SA(1, 0), a3, voffA);
            PG8_WAIT_V(8); PG8_WAIT_L(0); PG8_BAR; PG8_MMA(1, 0, At, B0); PG8_MMA(1, 1, At, B1); PG8_BAR; PG8_SCHED;
            } else {
            PG8_LDB(B0, 0, 0); PG8_SCHED; PG8_LDA(At, 0, 0); PG8_STAGE(PG8_SA(1, 1), a1 + hstep, voffA);
            PG8_WAIT_L(8); PG8_BAR; PG8_WAIT_L(0); PG8_MMA(0, 0, At, B0); PG8_BAR; PG8_SCHED;
            PG8_LDB(B1, 0, 1); PG8_STAGE(PG8_SB(0, 0), b2, voffB);
            PG8_BAR; PG8_WAIT_L(0); PG8_MMA(0, 1, At, B1); PG8_BAR;
            PG8_LDA(At, 0, 1); PG8_STAGE(PG8_SA(0, 0), a2, voffA);
            PG8_BAR; PG8_WAIT_L(0); PG8_MMA(1, 0, At, B0); PG8_BAR; PG8_SCHED;
            PG8_STAGE(PG8_SB(0, 1), b2 + hstep, voffB);
            PG8_WAIT_V(6); PG8_BAR; PG8_MMA(1, 1, At, B1); PG8_BAR;
            PG8_LDB(B0, 1, 0); PG8_SCHED; PG8_LDA(At, 1, 0); PG8_STAGE(PG8_SA(0, 1), a2 + hstep, voffA);
            PG8_WAIT_L(8); PG8_BAR; PG8_WAIT_L(0); PG8_MMA(0, 0, At, B0); PG8_BAR; PG8_SCHED;
            PG8_LDB(B1, 1, 1); PG8_STAGE(PG8_SB(1, 0), b3, voffB);
            PG8_BAR; PG8_WAIT_L(0); PG8_MMA(0, 1, At, B1); PG8_BAR;
            PG8_LDA(At, 1, 1); PG8_STAGE(PG8_SA(1, 0), a3, voffA);
            PG8_BAR; PG8_WAIT_L(0); PG8_MMA(1, 0, At, B0); PG8_BAR; PG8_SCHED;
            PG8_STAGE(PG8_SB(1, 1), b3 + hstep, voffB);
            PG8_WAIT_V(6); PG8_BAR; PG8_MMA(1, 1, At, B1); PG8_BAR;
            }
        }
        if constexpr (ALIGN_EPI) { if (wr == 0) PG8_BAR; }
        E(acc, cur, wr, wc, fr, fq);
        if (!has_next) break;
#pragma unroll
        for (int a = 0; a < 2; ++a)
#pragma unroll
            for (int b = 0; b < 2; ++b)
#pragma unroll
                for (int m = 0; m < 4; ++m)
#pragma unroll
                    for (int n = 0; n < 2; ++n) acc[a][b][m][n] = (f32x4){0.f, 0.f, 0.f, 0.f};
        cur = nxt; cA = nA; cB = nB; ++ui;
        if constexpr (ALIGN_EPI) { if (wr == 1) PG8_BAR; }
    }
    PG8_WAIT_V(0);
    if constexpr (!ALIGN_EPI) { if (wr == 0) PG8_BAR; }
    PG8_BAR;
#undef PG8_KOFF
#undef PG8_SA
#undef PG8_SB
#undef PG8_STAGE
#undef PG8_LDA
#undef PG8_LDB
#undef PG8_MMA
#undef PG8_WAIT_V
#undef PG8_WAIT_L
#undef PG8_BAR
#undef PG8_SCHED
}
}
namespace pg8 {
DI float act_apply(float x, int act) {
    if (act == 1) { const float r = fmaxf(x, 0.f); return r * r; }
    if (act == 2) { return 1.f - 2.f / (__expf(2.f * x) + 1.f); }
    if (act == 3) { return 1.f / (1.f + __expf(-x)); }
    return x;
}
constexpr int RSTAB_OFF = 131072, RSTAB_MAX = 16;
DI void fill_rs_table(LAS unsigned char* lds, const Order& S, const float* ps, int tid) {
    LAS float* T = (LAS float*)(lds + RSTAB_OFF); Unit u;
    for (int i = 0; i < RSTAB_MAX && S.next(i, u); ++i) { const int row = tid >> 1, hf = tid & 1; const float* p = ps + (size_t)(u.pm * BM + row) * 32 + 16 * hf;
        const f32x4 a = *(const f32x4*)p, b = *(const f32x4*)(p + 4), c = *(const f32x4*)(p + 8), d = *(const f32x4*)(p + 12);
        float sx = (((a.x + a.y) + (a.z + a.w)) + ((b.x + b.y) + (b.z + b.w))) + (((c.x + c.y) + (c.z + c.w)) + ((d.x + d.y) + (d.z + d.w)));
        sx += __shfl_xor(sx, 1); if (hf == 0) T[i * 256 + row] = 1.f / sqrtf(sx * (1.f / DM) + NORM_EPS); }
    asm volatile("s_waitcnt lgkmcnt(0)\n\ts_barrier" ::: "memory");
}
DI float rs_row(const LAS float* T, const Unit& u, int row) { return T[u.i * 256 + (row & 255)]; }
struct EpiAct {
    static constexpr bool PERM = true;
    bf16_t* O; int ldc; size_t zO; int acts; const LAS float* ss;
    DI void operator()(const f32x4 (&acc)[2][2][4][2], const Unit& u, int wr, int wc, int fr_, int fq) const {
        int fr = fr_; asm volatile("" : "+v"(fr));
        const int row0 = u.pm * BM + wr * 64 + fr, col0 = u.pn * BM + wc * 32 + 8 * fq, act = (acts >> (4 * u.z)) & 15;
        bf16_t* base = O + (size_t)u.z * zO;
#pragma unroll
        for (int ai = 0; ai < 2; ++ai)
#pragma unroll
            for (int m = 0; m < 4; ++m) { bf16_t* rowp = base + (size_t)(row0 + ai * HALF + m * 16) * ldc + col0; const float rs = ss ? rs_row(ss, u, row0 + ai * HALF + m * 16) : 1.f;
#pragma unroll
                for (int bj = 0; bj < 2; ++bj) { f32x4 v0 = acc[ai][bj][m][0] * rs, v1 = acc[ai][bj][m][1] * rs;
                    if (act) {
#pragma unroll
                        for (int j = 0; j < 4; ++j) { v0[j] = act_apply(v0[j], act); v1[j] = act_apply(v1[j], act); } }
                    u32x4 w; w.x = pk2(v0[0], v0[1]); w.y = pk2(v0[2], v0[3]); w.z = pk2(v1[0], v1[1]); w.w = pk2(v1[2], v1[3]);
                    *(u32x4*)(rowp + bj * HALF) = w; } }
    }
};
struct EpiRelu2 {
    static constexpr bool PERM = true;
    bf16_t* O; int ldc; const LAS float* ss;
    DI void operator()(const f32x4 (&acc)[2][2][4][2], const Unit& u, int wr, int wc, int fr_, int fq) const {
        int fr = fr_; asm volatile("" : "+v"(fr));
        const int row0 = u.pm * BM + wr * 64 + fr, col0 = u.pn * BM + wc * 32 + 8 * fq;
#pragma unroll
        for (int ai = 0; ai < 2; ++ai)
#pragma unroll
            for (int m = 0; m < 4; ++m) { bf16_t* rowp = O + (size_t)(row0 + ai * HALF + m * 16) * ldc + col0; const float rs = rs_row(ss, u, row0 + ai * HALF + m * 16);
#pragma unroll
                for (int bj = 0; bj < 2; ++bj) { f32x4 v0 = acc[ai][bj][m][0] * rs, v1 = acc[ai][bj][m][1] * rs;
#pragma unroll
                    for (int j = 0; j < 4; ++j) { const float a = fmaxf(v0[j], 0.f), b = fmaxf(v1[j], 0.f); v0[j] = a * a; v1[j] = b * b; }
                    u32x4 w; w.x = pk2(v0[0], v0[1]); w.y = pk2(v0[2], v0[3]); w.z = pk2(v1[0], v1[1]); w.w = pk2(v1[2], v1[3]);
                    *(u32x4*)(rowp + bj * HALF) = w; } }
    }
};
struct EpiResid {
    static constexpr bool PERM = true;
    const float* resP; const float* resS; bf16_t* XB; float* SS;
    DI void operator()(const f32x4 (&acc)[2][2][4][2], const Unit& u, int wr, int wc, int fr_, int fq) const {
        int fr = fr_; asm volatile("" : "+v"(fr));
        const int row0 = u.pm * BM + wr * 64 + fr, col0 = u.pn * BM + wc * 32 + 8 * fq;
        const bool pr = u.pm < MP / BM; const float* rb = pr ? resP : resS; const int rsub = pr ? 0 : MP;
#pragma unroll
        for (int ai = 0; ai < 2; ++ai)
#pragma unroll
            for (int m = 0; m < 4; ++m) { const int row = row0 + ai * HALF + m * 16; bf16_t* xp = XB + (size_t)row * DM + col0;
                float sq = 0.f;
#pragma unroll
                for (int bj = 0; bj < 2; ++bj) { f32x4 r0, r1;
                    if (resP) { const float* rp = rb + (size_t)(row - rsub) * DM + col0 + bj * HALF; r0 = *(const f32x4*)rp; r1 = *(const f32x4*)(rp + 4); }
                    else { const u32x4 xv = *(const u32x4*)(xp + bj * HALF); r0 = (f32x4){bflo(xv.x), bfhi(xv.x), bflo(xv.y), bfhi(xv.y)}; r1 = (f32x4){bflo(xv.z), bfhi(xv.z), bflo(xv.w), bfhi(xv.w)}; }
                    r0 = r0 + acc[ai][bj][m][0]; r1 = r1 + acc[ai][bj][m][1];
                    u32x4 wv; wv.x = pk2(r0[0], r0[1]); wv.y = pk2(r0[2], r0[3]); wv.z = pk2(r1[0], r1[1]); wv.w = pk2(r1[2], r1[3]); *(u32x4*)(xp + bj * HALF) = wv;
                    sq += (r0[0] * r0[0] + r0[1] * r0[1]) + (r0[2] * r0[2] + r0[3] * r0[3]) + (r1[0] * r1[0] + r1[1] * r1[1]) + (r1[2] * r1[2] + r1[3] * r1[3]); }
                sq += __shfl_xor(sq, 16); sq += __shfl_xor(sq, 32);
                if (fq == 0) SS[(size_t)row * 32 + u.pn * 4 + wc] = sq; }
    }
};
struct EpiSlab {
    static constexpr bool PERM = true;
    const LAS unsigned* skp; int slot;
    DI void operator()(const f32x4 (&acc)[2][2][4][2], const Unit& u, int wr, int wc, int fr, int fq) const {
        int tid2 = (wr * 4 + wc) * 64 + lane_now(); asm volatile("" : "+v"(tid2));
        const unsigned long long pb = ((unsigned long long)(unsigned)__builtin_amdgcn_readfirstlane((int)skp[1]) << 32) | (unsigned)__builtin_amdgcn_readfirstlane((int)skp[0]);
        GAS char* p = (GAS char*)pb + (size_t)slot * 262144; const unsigned voff = (unsigned)tid2 * 16u;
#pragma unroll
        for (int q = 0; q < 32; ++q) *(GAS f32x4*)(p + q * 8192 + voff) = acc[q >> 4][(q >> 3) & 1][(q >> 1) & 3][q & 1];
    }
};
DI void sk_reduce(unsigned char LAS* lds, float* slabs, unsigned* cnts, const Unit& u, int st, int ks, int nsl, bf16_t* XB, float* SS, int wave_id) {
    const int lane = lane_now(), tid = wave_id * 64 + lane, wr = wave_id >> 2, wc = wave_id & 3, fr = lane & 15, fq = lane >> 4;
    if (tid == 0) {
        unsigned* cnt = cnts + st * 4;
        __builtin_amdgcn_fence(__ATOMIC_RELEASE, "agent"); asm volatile("s_waitcnt vmcnt(0)" ::: "memory");
        (void)__hip_atomic_fetch_add(cnt, 1u, __ATOMIC_RELAXED, __HIP_MEMORY_SCOPE_AGENT);
        unsigned sp = 0; while (__hip_atomic_load(cnt, __ATOMIC_RELAXED, __HIP_MEMORY_SCOPE_AGENT) < (unsigned)nsl && ++sp < (1u << 24)) __builtin_amdgcn_s_sleep(1);
        __builtin_amdgcn_fence(__ATOMIC_ACQUIRE, "agent"); asm volatile("s_waitcnt vmcnt(0)" ::: "memory");
    }
    __syncthreads();
    const GAS char* p = (const GAS char*)slabs + (size_t)st * (4 * 262144); const unsigned voff = (unsigned)tid * 16u;
    const int rowb = u.pm * BM + wr * 64 + fr, col0 = u.pn * BM + wc * 32 + 8 * fq;
#pragma unroll 1
    for (int cm = ks; cm < 8; cm += nsl) { const int ai = cm >> 2, m = cm & 3, row = rowb + ai * HALF + m * 16; bf16_t* xp = XB + (size_t)row * DM + col0;
        f32x4 v[2][2][4]; u32x4 xv[2];
#pragma unroll
        for (int bj = 0; bj < 2; ++bj) { xv[bj] = *(const u32x4*)(xp + bj * HALF);
#pragma unroll
            for (int n = 0; n < 2; ++n)
#pragma unroll
                for (int sl = 0; sl < 4; ++sl) v[bj][n][sl] = (sl < nsl) ? *(const GAS f32x4*)(p + (size_t)sl * 262144 + (((ai * 2 + bj) * 4 + m) * 2 + n) * 8192 + voff) : (f32x4){0.f, 0.f, 0.f, 0.f}; }
        float sq = 0.f;
#pragma unroll
        for (int bj = 0; bj < 2; ++bj) {
            f32x4 r0 = (f32x4){bflo(xv[bj].x), bfhi(xv[bj].x), bflo(xv[bj].y), bfhi(xv[bj].y)}, r1 = (f32x4){bflo(xv[bj].z), bfhi(xv[bj].z), bflo(xv[bj].w), bfhi(xv[bj].w)};
            r0 = r0 + (((v[bj][0][0] + v[bj][0][1]) + v[bj][0][2]) + v[bj][0][3]); r1 = r1 + (((v[bj][1][0] + v[bj][1][1]) + v[bj][1][2]) + v[bj][1][3]);
            u32x4 wv; wv.x = pk2(r0[0], r0[1]); wv.y = pk2(r0[2], r0[3]); wv.z = pk2(r1[0], r1[1]); wv.w = pk2(r1[2], r1[3]); *(u32x4*)(xp + bj * HALF) = wv;
            sq += (r0[0] * r0[0] + r0[1] * r0[1]) + (r0[2] * r0[2] + r0[3] * r0[3]) + (r1[0] * r1[0] + r1[1] * r1[1]) + (r1[2] * r1[2] + r1[3] * r1[3]); }
        sq += __shfl_xor(sq, 16); sq += __shfl_xor(sq, 32);
        if (fq == 0) SS[(size_t)row * 32 + u.pn * 4 + wc] = sq; }
}
DI int tok_pos(int row) { return row < MP ? row : PAST + (row & 63); }
DI void sincos_rev(int pos, float inv, float& c, float& s) {
    double r = (double)pos * (double)inv * 0.15915494309189535; r = r - __builtin_floor(r); const float f = (float)r;
    s = __builtin_amdgcn_sinf(f); c = __builtin_amdgcn_cosf(f);
}
struct EpiAttnQKV {
    static constexpr bool PERM = true;
    bf16_t* Qb; float* outf; size_t okP, okS; const LAS float* ss;
    DI void operator()(const f32x4 (&acc)[2][2][4][2], const Unit& u, int wr, int wc, int fr_, int fq) const {
        int fr = fr_; asm volatile("" : "+v"(fr));
        const int row0 = u.pm * BM + wr * 64 + fr, cl = wc * 32 + 8 * fq;
        const bool rot = (u.pn < 9) && ((wc & 1) == 0) && (fq < 2);
        float inv[8];
#pragma unroll
        for (int j = 0; j < 8; ++j) inv[j] = __builtin_amdgcn_exp2f(-(float)j * 2.3664461f);
        const float qs = (u.pn < 8) ? 0.18033688f : 1.f;
        const size_t ooff = (u.pn < 8) ? (size_t)0 : (u.pn == 8 ? (size_t)M * DM : (size_t)M * DM + (size_t)M * 256); bf16_t* ob = Qb + ooff; const int ldo = (u.pn < 8) ? DM : 256, ocol = (u.pn < 8) ? u.pn * BM + cl : cl;
        float* cP = outf + okP + (u.pn == 9 ? 65536 : 0); float* cS = outf + okS + (u.pn == 9 ? 2097152 : 0);
#pragma unroll
        for (int ai = 0; ai < 2; ++ai)
#pragma unroll
            for (int m = 0; m < 4; ++m) { const int row = row0 + ai * HALF + m * 16; const int pos = tok_pos(row);
                const float rs = rs_row(ss, u, row);
                f32x4 p0 = acc[ai][0][m][0] * rs, p1 = acc[ai][0][m][1] * rs, q0 = acc[ai][1][m][0] * rs, q1 = acc[ai][1][m][1] * rs;
                if (rot) {
#define ROPE_J(j, pv, qv, e) { float c_, s_; sincos_rev(pos, inv[j], c_, s_); const float ya = __shfl_xor(pv[e], 16), yb = __shfl_xor(qv[e], 16); \
                        pv[e] = (fq == 0) ? pv[e] * c_ - ya * s_ : pv[e] * c_ + ya * s_; qv[e] = (fq == 0) ? qv[e] * c_ - yb * s_ : qv[e] * c_ + yb * s_; }
                    ROPE_J(0, p0, q0, 0) ROPE_J(1, p0, q0, 1) ROPE_J(2, p0, q0, 2) ROPE_J(3, p0, q0, 3) ROPE_J(4, p1, q1, 0) ROPE_J(5, p1, q1, 1) ROPE_J(6, p1, q1, 2) ROPE_J(7, p1, q1, 3)
#undef ROPE_J
                }
                { u32x4 wv; wv.x = pk2(p0[0] * qs, p0[1] * qs); wv.y = pk2(p0[2] * qs, p0[3] * qs); wv.z = pk2(p1[0] * qs, p1[1] * qs); wv.w = pk2(p1[2] * qs, p1[3] * qs);
                  *(u32x4*)(ob + (size_t)row * ldo + ocol) = wv;
                  wv.x = pk2(q0[0] * qs, q0[1] * qs); wv.y = pk2(q0[2] * qs, q0[3] * qs); wv.z = pk2(q1[0] * qs, q1[1] * qs); wv.w = pk2(q1[2] * qs, q1[3] * qs);
                  *(u32x4*)(ob + (size_t)row * ldo + ocol + HALF) = wv; }
                if (u.pn >= 8) {
                    float* cp = nullptr;
                    if (row >= MP) cp = cS + ((size_t)((row - MP) >> 6) * AWIN + 64 + (row & 63)) * 256; else if (row >= MP - AWIN) cp = cP + (size_t)(row - (MP - AWIN)) * 256;
                    if (cp) { *(f32x4*)(cp + cl) = p0; *(f32x4*)(cp + cl + 4) = p1; *(f32x4*)(cp + cl + HALF) = q0; *(f32x4*)(cp + cl + HALF + 4) = q1; }
                } }
    }
};
struct EpiRetProj {
    static constexpr bool PERM = true;
    bf16_t* P; const LAS float* ss;
    DI void operator()(const f32x4 (&acc)[2][2][4][2], const Unit& u, int wr, int wc, int fr_, int fq) const {
        int fr = fr_; asm volatile("" : "+v"(fr));
        const int row0 = u.pm * BM + wr * 64 + fr, cl = wc * 32 + 8 * fq; const bool rot = u.pn < 16; const float sc = (u.pn >= 8 && u.pn < 16) ? 0.0625f : 1.f;
        float inv[8];
#pragma unroll
        for (int j = 0; j < 8; ++j) inv[j] = __builtin_amdgcn_exp2f(-(float)(cl + j) * 0.10381025f);
#pragma unroll
        for (int ai = 0; ai < 2; ++ai)
#pragma unroll
            for (int m = 0; m < 4; ++m) { const int row = row0 + ai * HALF + m * 16; const int pos = tok_pos(row);
                const float rs = rs_row(ss, u, row);
                f32x4 a0 = acc[ai][0][m][0] * rs, a1 = acc[ai][0][m][1] * rs, b0 = acc[ai][1][m][0] * rs, b1 = acc[ai][1][m][1] * rs;
                if (rot) {
                    float x1[8] = {a0[0], a0[1], a0[2], a0[3], a1[0], a1[1], a1[2], a1[3]}, x2[8] = {b0[0], b0[1], b0[2], b0[3], b1[0], b1[1], b1[2], b1[3]};
#pragma unroll
                    for (int j = 0; j < 8; ++j) { float c, s; sincos_rev(pos, inv[j], c, s); const float p = x1[j], q = x2[j]; x1[j] = (p * c - q * s) * sc; x2[j] = (q * c + p * s) * sc; }
                    a0 = (f32x4){x1[0], x1[1], x1[2], x1[3]}; a1 = (f32x4){x1[4], x1[5], x1[6], x1[7]}; b0 = (f32x4){x2[0], x2[1], x2[2], x2[3]}; b1 = (f32x4){x2[4], x2[5], x2[6], x2[7]};
                }
                bf16_t* rowp = P + (size_t)row * RIN + u.pn * BM + cl;
                u32x4 w; w.x = pk2(a0[0], a0[1]); w.y = pk2(a0[2], a0[3]); w.z = pk2(a1[0], a1[1]); w.w = pk2(a1[2], a1[3]); *(u32x4*)rowp = w;
                w.x = pk2(b0[0], b0[1]); w.y = pk2(b0[2], b0[3]); w.z = pk2(b1[0], b1[1]); w.w = pk2(b1[2], b1[3]); *(u32x4*)(rowp + HALF) = w; }
    }
};
struct EpiRwkv2 {
    static constexpr bool PERM = true;
    float* LW; bf16_t* Ab; const float* w0; const float* a0;
    DI void operator()(const f32x4 (&acc)[2][2][4][2], const Unit& u, int wr, int wc, int fr_, int fq) const {
        int fr = fr_; asm volatile("" : "+v"(fr));
        const int row0 = u.pm * BM + wr * 64 + fr, col0 = u.pn * BM + wc * 32 + 8 * fq;
        const float* bp = (u.z == 0) ? w0 : a0; bf16_t* ob = Ab + (u.z == 2 ? (size_t)M * DM : (size_t)0);
#pragma unroll
        for (int bj = 0; bj < 2; ++bj)
#pragma unroll
            for (int n = 0; n < 2; ++n) { const int col = col0 + bj * HALF + 4 * n;
                f32x4 bias = (f32x4){0.f, 0.f, 0.f, 0.f}; if (u.z < 2) bias = *(const f32x4*)(bp + col);
#pragma unroll
                for (int ai = 0; ai < 2; ++ai)
#pragma unroll
                    for (int m = 0; m < 4; ++m) { const int row = row0 + ai * HALF + m * 16; f32x4 x = acc[ai][bj][m][n] + bias;
                        if (u.z == 0) {
#pragma unroll
                            for (int j = 0; j < 4; ++j) { const float y = -x[j]; const float sp = fmaxf(y, 0.f) + __logf(1.f + __expf(-fabsf(y))); x[j] = -__expf(-sp - 0.5f); }
                            *(f32x4*)(LW + (size_t)row * DM + col) = x;
                        } else {
                            if (u.z == 1) {
#pragma unroll
                                for (int j = 0; j < 4; ++j) x[j] = 1.f / (1.f + __expf(-x[j])); }
                            u32x2 wv; wv.x = pk2(x[0], x[1]); wv.y = pk2(x[2], x[3]); *(u32x2*)(ob + (size_t)row * DM + col) = wv;
                        } }
                asm volatile("" ::: "memory"); }
    }
};
}
#define XB_TMO      128
#define XB_XCNT(j)  (256  + 64 * (j))
#define XB_XSUB(j)  (1280 + 64 * (j))
#define XB_XGEN(j)  (2304 + 64 * (j))
#define XB_TOP      3328
#define XB_TOPGEN   3392
#define XCD_BAR_WORDS 3456
#define XB_SPIN_CAP (1u << 18)

__device__ __forceinline__ unsigned xb_ld(unsigned* p)              { return __hip_atomic_load(p, __ATOMIC_RELAXED, __HIP_MEMORY_SCOPE_AGENT); }
__device__ __forceinline__ unsigned xb_add(unsigned* p, unsigned v) { return __hip_atomic_fetch_add(p, v, __ATOMIC_RELAXED, __HIP_MEMORY_SCOPE_AGENT); }
__device__ __forceinline__ unsigned xb_xcc_id() { return (unsigned)__builtin_amdgcn_s_getreg((3 << 11) | 20) & 0xFu; }
#define XB_SPIN(cond, bar) do { unsigned _sp = 0; while (cond) { __builtin_amdgcn_s_sleep(1); \
    if ((++_sp & 255u) == 0u) { if (xb_ld(&(bar)[XB_TMO])) break; if (_sp > XB_SPIN_CAP) { atomicAdd(&(bar)[XB_TMO], 1u); break; } } } } while (0)

struct XcdBarrier {
    unsigned* bar; unsigned x;
    volatile LAS unsigned* st;
};

__device__ __forceinline__ XcdBarrier xcd_barrier_post(unsigned* bar, volatile LAS unsigned* st, int wave_id) {
    XcdBarrier b; b.bar = bar; b.x = xb_xcc_id(); b.st = st;
    if (wave_id == 0 && lane_now() == 0) (void)xb_add(&bar[XB_XCNT(b.x)], 1u);
    return b;
}
__device__ __forceinline__ void xcd_barrier_complete(unsigned* bar, unsigned x, unsigned& nloc, unsigned& nx) {
    const unsigned G = gridDim.x * gridDim.y * gridDim.z;
    unsigned sum, cnt, mine, sp = 0u;
    for (;;) {
        sum = 0u; cnt = 0u; mine = 0u;
#pragma unroll
        for (unsigned j = 0; j < 16; ++j) { const unsigned c = xb_ld(&bar[XB_XCNT(j)]); sum += c; cnt += (c > 0u) ? 1u : 0u; mine = (j == x) ? c : mine; }
        if (sum == G) break;
        __builtin_amdgcn_s_sleep(1);
        if ((++sp & 255u) == 0u) { if (xb_ld(&bar[XB_TMO])) break; if (sp > XB_SPIN_CAP) { atomicAdd(&bar[XB_TMO], 1u); break; } }
    }
    nloc = mine > 0u ? mine : 1u; nx = cnt > 0u ? cnt : 1u;
}

__device__ __forceinline__ void xcd_barrier(const XcdBarrier& b, int wave_id) {
    asm volatile("s_waitcnt vmcnt(0)" ::: "memory");
    __syncthreads();
    if (wave_id == 0 && lane_now() == 0) {
        unsigned* bar = b.bar;
        __builtin_amdgcn_s_waitcnt(0);
        unsigned nloc = b.st[0], nx = b.st[1];
        if (nloc == 0u) { xcd_barrier_complete(bar, b.x, nloc, nx); b.st[0] = nloc; b.st[1] = nx; }
        const unsigned old = xb_add(&bar[XB_XSUB(b.x)], 1u);
        const unsigned gen = old / nloc;
        if (old + 1u == (gen + 1u) * nloc) {
            __builtin_amdgcn_fence(__ATOMIC_RELEASE, "agent");
            asm volatile("s_waitcnt vmcnt(0)" ::: "memory");
            const unsigned og = xb_add(&bar[XB_TOP], 1u);
            const unsigned tg = og / nx;
            if (og + 1u == (tg + 1u) * nx) xb_add(&bar[XB_TOPGEN], 1u);
            else XB_SPIN(xb_ld(&bar[XB_TOPGEN]) == tg, bar);
            __builtin_amdgcn_fence(__ATOMIC_ACQUIRE, "agent");
            xb_add(&bar[XB_XGEN(b.x)], 1u);
            asm volatile("s_waitcnt vmcnt(0)" ::: "memory");
        } else {
            XB_SPIN(xb_ld(&bar[XB_XGEN(b.x)]) == gen, bar);
            __builtin_amdgcn_fence(__ATOMIC_ACQUIRE, "agent");
            asm volatile("s_waitcnt vmcnt(0)" ::: "memory");
        }
    }
    __syncthreads();
}
struct WG { LAS unsigned char* lds; int tid, lane, wave, gw, ngw, G, bid; };

DI void convert_w(const WG& w, const float* W, int Kv, int Nv, bf16_t* WT, int Kp, int Np, const float* gain = nullptr, int b0 = 0, int nb = 0) {
    const int nkt = Kp / 128, nnt = Np / 128, ntile = nkt * nnt; if (nb == 0) nb = w.G;
    if (w.bid < b0) return;
    int tile = w.bid - b0; if (tile >= ntile) return;
    int tid = w.tid; asm volatile("" : "+v"(tid)); const int lane = tid & 63, wv = tid >> 6;
    f32x4 r0[8], r1[8], r2[8], r3[8]; float g0[8], g1[8], g2[8], g3[8]; int it = 0;
#define CW_LOAD(dst, gd, tl) { const int k0_ = ((tl) / nnt) * 128, n0_ = ((tl) % nnt) * 128; _Pragma("unroll") for (int i = 0; i < 8; ++i) { const int k = k0_ + 16 * wv + 2 * i + (lane >> 5), n = n0_ + 4 * (lane & 31); \
        f32x4 x_ = (f32x4){0.f, 0.f, 0.f, 0.f}; float g_ = 1.f; if (k < Kv && n < Nv) { x_ = *(const f32x4*)(W + (size_t)k * Nv + n); if (gain) g_ = gain[k]; } dst[i] = x_; gd[i] = g_; } }
#define CW_STEP(cur, gc, pf, gp) { const int k0 = (tile / nnt) * 128, n0 = (tile % nnt) * 128; LAS float* T = (LAS float*)w.lds + (it & 1) * (128 * 129 + 64); const int tp_ = tile + 3 * nb; \
        if (tp_ < ntile) CW_LOAD(pf, gp, tp_) \
        _Pragma("unroll") for (int i = 0; i < 8; ++i) { const int kk = 16 * wv + 2 * i + (lane >> 5); LAS float* tp = T + kk * 129 + 4 * (lane & 31); tp[0] = cur[i].x * gc[i]; tp[1] = cur[i].y * gc[i]; tp[2] = cur[i].z * gc[i]; tp[3] = cur[i].w * gc[i]; } \
        LDS_BARRIER(); \
        _Pragma("unroll") for (int i = 0; i < 4; ++i) { const int nn = 16 * wv + 4 * i + (lane >> 4), kj = 8 * (lane & 15); const LAS float* sp = T + kj * 129 + nn; \
            u32x4 o; o.x = pk2(sp[0], sp[129]); o.y = pk2(sp[2 * 129], sp[3 * 129]); o.z = pk2(sp[4 * 129], sp[5 * 129]); o.w = pk2(sp[6 * 129], sp[7 * 129]); \
            *(u32x4*)(WT + (size_t)(n0 + nn) * Kp + k0 + kj) = o; } \
        ++it; tile += nb; }
    CW_LOAD(r0, g0, tile)
    if (tile + nb < ntile) CW_LOAD(r1, g1, tile + nb)
    if (tile + 2 * nb < ntile) CW_LOAD(r2, g2, tile + 2 * nb)
    LDS_BARRIER();
    for (;;) {
        CW_STEP(r0, g0, r3, g3) if (tile >= ntile) break;
        CW_STEP(r1, g1, r0, g0) if (tile >= ntile) break;
        CW_STEP(r2, g2, r1, g1) if (tile >= ntile) break;
        CW_STEP(r3, g3, r2, g2) if (tile >= ntile) break;
    }
#undef CW_LOAD
#undef CW_STEP
    LDS_BARRIER();
}

DI void rows0(const WG& w, const float* xp, const float* xs, bf16_t* XB, float* SS) {
    for (int m = w.gw; m < M; m += w.ngw) {
        const float* xr = (m < MP) ? xp + (size_t)m * DM : xs + (size_t)(m - MP) * DM;
        f32x4 v[8]; float s = 0.f;
#pragma unroll
        for (int j = 0; j < 8; ++j) { v[j] = ((const f32x4*)xr)[w.lane + 64 * j]; s += (v[j].x * v[j].x + v[j].y * v[j].y) + (v[j].z * v[j].z + v[j].w * v[j].w); }
        s = wave_sum_fast(s); if (w.lane < 32) SS[(size_t)m * 32 + w.lane] = (w.lane == 0) ? s : 0.f;
#pragma unroll
        for (int j = 0; j < 8; ++j) { u32x2 o; o.x = pk2(v[j].x, v[j].y); o.y = pk2(v[j].z, v[j].w); ((u32x2*)(XB + (size_t)m * DM))[w.lane + 64 * j] = o; }
    }
}
DI float rs_of_row(const float* ps, int m, int lane) { const float v = (lane < 32) ? ps[(size_t)m * 32 + lane] : 0.f; return 1.f / sqrtf(wave_sum_fast(v) * (1.f / DM) + NORM_EPS); }
DI void norm_rows(const WG& w, const float* xp, const float* xs, const float* gain, bf16_t* H, float* shp, float* shs) {
    for (int m = w.gw; m < M; m += w.ngw) {
        const float* xr = (m < MP) ? xp + (size_t)m * DM : xs + (size_t)(m - MP) * DM;
        f32x4 v[8]; float s = 0.f;
#pragma unroll
        for (int j = 0; j < 8; ++j) { v[j] = ((const f32x4*)xr)[w.lane + 64 * j]; s += (v[j].x * v[j].x + v[j].y * v[j].y) + (v[j].z * v[j].z + v[j].w * v[j].w); }
        const float rs = 1.f / sqrtf(wave_sum_fast(s) * (1.f / DM) + NORM_EPS);
        float* sh = nullptr;
        if (shp && m == MP - 1) sh = shp; else if (shs && m >= MP && (m & 63) == 63) sh = shs + (size_t)((m - MP) >> 6) * DM;
#pragma unroll
        for (int j = 0; j < 8; ++j) { const f32x4 g = ((const f32x4*)gain)[w.lane + 64 * j]; const f32x4 y = v[j] * rs * g;
            u32x2 o; o.x = pk2(y.x, y.y); o.y = pk2(y.z, y.w); ((u32x2*)(H + (size_t)m * DM))[w.lane + 64 * j] = o;
            if (sh) ((f32x4*)sh)[w.lane + 64 * j] = y; }
    }
}
DI void final_norm(const WG& w, const bf16_t* XB, const float* SS, const float* gain, float* Y) {
    for (int m = w.gw; m < M; m += w.ngw) { const float rs = rs_of_row(SS, m, w.lane);
#pragma unroll
        for (int j = 0; j < 4; ++j) { const int c0 = 8 * (w.lane + 64 * j); const u32x4 xv = *(const u32x4*)(XB + (size_t)m * DM + c0);
            const f32x4 g0 = *(const f32x4*)(gain + c0), g1 = *(const f32x4*)(gain + c0 + 4);
            *(f32x4*)(Y + (size_t)m * DM + c0) = (f32x4){bflo(xv.x), bfhi(xv.x), bflo(xv.y), bfhi(xv.y)} * rs * g0; *(f32x4*)(Y + (size_t)m * DM + c0 + 4) = (f32x4){bflo(xv.z), bfhi(xv.z), bflo(xv.w), bfhi(xv.w)} * rs * g1; } }
}
DI void lerp_rows(const WG& w, const bf16_t* XB, const float* SS, const float* gain, const float* shift_state, const float* mu, bf16_t* XL, float* shp, float* shs) {
    constexpr int RPW = 36;
    for (int task = w.gw; task < 4 * (M / RPW); task += w.ngw) { const int cq = task & 3, m0 = (task >> 2) * RPW, c0 = 512 * cq + 8 * w.lane;
        float gg[8], mm[6][8], hp[8];
        { const f32x4 g0 = *(const f32x4*)(gain + c0), g1 = *(const f32x4*)(gain + c0 + 4); gg[0] = g0.x; gg[1] = g0.y; gg[2] = g0.z; gg[3] = g0.w; gg[4] = g1.x; gg[5] = g1.y; gg[6] = g1.z; gg[7] = g1.w; }
#pragma unroll
        for (int i = 0; i < 6; ++i) { const int mrow = (i == 1) ? 2 : (i == 2) ? 3 : (i == 3) ? 1 : i;
            const float* mp = mu + (size_t)mrow * DM + c0; const f32x4 a = *(const f32x4*)mp, b = *(const f32x4*)(mp + 4); mm[i][0] = a.x; mm[i][1] = a.y; mm[i][2] = a.z; mm[i][3] = a.w; mm[i][4] = b.x; mm[i][5] = b.y; mm[i][6] = b.z; mm[i][7] = b.w; }
        { const bool first0 = (m0 == 0) || (m0 >= MP && (m0 & 63) == 0);
            if (!first0) { const float rsp = rs_of_row(SS, m0 - 1, w.lane); const u32x4 pv = *(const u32x4*)(XB + (size_t)(m0 - 1) * DM + c0);
                hp[0] = bflo(pv.x); hp[1] = bfhi(pv.x); hp[2] = bflo(pv.y); hp[3] = bfhi(pv.y); hp[4] = bflo(pv.z); hp[5] = bfhi(pv.z); hp[6] = bflo(pv.w); hp[7] = bfhi(pv.w);
#pragma unroll
                for (int e = 0; e < 8; ++e) hp[e] *= rsp * gg[e]; }
            else {
#pragma unroll
                for (int e = 0; e < 8; ++e) hp[e] = 0.f; } }
#pragma unroll 2
        for (int rr = 0; rr < RPW; ++rr) { const int m = m0 + rr;
            const float rs = rs_of_row(SS, m, w.lane); const u32x4 hv = *(const u32x4*)(XB + (size_t)m * DM + c0);
            float h[8] = {bflo(hv.x), bfhi(hv.x), bflo(hv.y), bfhi(hv.y), bflo(hv.z), bfhi(hv.z), bflo(hv.w), bfhi(hv.w)};
#pragma unroll
            for (int e = 0; e < 8; ++e) h[e] *= rs * gg[e];
            if (m == 0) {
#pragma unroll
                for (int e = 0; e < 8; ++e) hp[e] = 0.f;
            } else if (m >= MP && (m & 63) == 0) { const float* sp = shift_state + (size_t)((m - MP) >> 6) * DM + c0; const f32x4 s0 = *(const f32x4*)sp, s1 = *(const f32x4*)(sp + 4);
                hp[0] = s0.x; hp[1] = s0.y; hp[2] = s0.z; hp[3] = s0.w; hp[4] = s1.x; hp[5] = s1.y; hp[6] = s1.z; hp[7] = s1.w; }
            float* sh = nullptr; if (m == MP - 1) sh = shp; else if (m >= MP && (m & 63) == 63) sh = shs + (size_t)((m - MP) >> 6) * DM;
            if (sh) { *(f32x4*)(sh + c0) = (f32x4){h[0], h[1], h[2], h[3]}; *(f32x4*)(sh + c0 + 4) = (f32x4){h[4], h[5], h[6], h[7]}; }
#pragma unroll
            for (int i = 0; i < 6; ++i) { float o[8];
#pragma unroll
                for (int e = 0; e < 8; ++e) o[e] = h[e] + (hp[e] - h[e]) * mm[i][e];
                u32x4 ov; ov.x = pk2(o[0], o[1]); ov.y = pk2(o[2], o[3]); ov.z = pk2(o[4], o[5]); ov.w = pk2(o[6], o[7]);
                *(u32x4*)(XL + ((size_t)i * M + m) * DM + c0) = ov; }
#pragma unroll
            for (int e = 0; e < 8; ++e) hp[e] = h[e];
        }
    }
}
constexpr int AT_KS = 72, AT_VS = 196;
constexpr int AT_V_OFF = 192 * AT_KS * 2;
DI u32x4 ld8_f32_as_bf16(const float* p) { const f32x4 a = *(const f32x4*)p, b = *(const f32x4*)(p + 4); u32x4 o; o.x = pk2(a.x, a.y); o.y = pk2(a.z, a.w); o.z = pk2(b.x, b.y); o.w = pk2(b.z, b.w); return o; }
DI bf16x8 pack8(const f32x16& x, int s) {
    u32x4 p; p.x = pk2(x[8 * s], x[8 * s + 1]); p.y = pk2(x[8 * s + 2], x[8 * s + 3]); p.z = pk2(x[8 * s + 4], x[8 * s + 5]); p.w = pk2(x[8 * s + 6], x[8 * s + 7]);
    return __builtin_bit_cast(bf16x8, p);
}
DI bf16x8 ld_perm_frag(const LAS bf16_t* p) {
    const s16x4 lo = *(const LAS s16x4*)p, hi = *(const LAS s16x4*)(p + 8); return __builtin_shufflevector(lo, hi, 0, 1, 2, 3, 4, 5, 6, 7);
}
DI f32x16 zero16() { f32x16 z; for (int i = 0; i < 16; ++i) z[i] = 0.f; return z; }

typedef short v4i16_t __attribute__((ext_vector_type(4)));
DI s16x4 ds_tr(const LAS unsigned char* p) { return __builtin_bit_cast(s16x4, __builtin_amdgcn_ds_read_tr16_b64_v4i16((LAS v4i16_t*)p)); }
constexpr int AT_VB = 9344;
DI void attn_load_kv(const bf16_t* Kb, const bf16_t* Vb, const float* ck, const float* cv, int c, int g, int tid, u32x4 (&pk)[3], u32x4 (&pv)[3]) {
#pragma unroll
    for (int i = 0; i < 3; ++i) { const int idx = tid + 512 * i, sl = idx >> 3, dc = idx & 7;
        u32x4 kv = {0u, 0u, 0u, 0u}, vv = {0u, 0u, 0u, 0u};
        if (c < NCHP) { const int tok = 64 * (c - 2) + sl; if (tok >= 0) { kv = *(const u32x4*)(Kb + (size_t)tok * 256 + g * 64 + dc * 8); vv = *(const u32x4*)(Vb + (size_t)tok * 256 + g * 64 + dc * 8); } }
        else { const int b = c - NCHP;
            if (sl < AWIN) { const size_t o = (((size_t)b * AWIN + sl) * AKV + g) * AHD + dc * 8; kv = ld8_f32_as_bf16(ck + o); vv = ld8_f32_as_bf16(cv + o); }
            else { const int tok = MP + 64 * b + (sl - AWIN); kv = *(const u32x4*)(Kb + (size_t)tok * 256 + g * 64 + dc * 8); vv = *(const u32x4*)(Vb + (size_t)tok * 256 + g * 64 + dc * 8); } }
        pk[i] = kv; pv[i] = vv; }
}
DI void attn_load_q(const bf16_t* Qb, int c, int qh, int hq, int r, int h, bf16x8 (&qf)[4]) {
#pragma unroll
    for (int sx = 0; sx < 4; ++sx) qf[sx] = *(const bf16x8*)(Qb + (size_t)(64 * c + 32 * qh + r) * DM + hq * 64 + 16 * sx + 8 * h);
}
DI void attn_phase(const WG& w, const bf16_t* Qb, const bf16_t* Kb, const bf16_t* Vb, const float* ck, const float* cv, const float* sinks, bf16_t* AO) {
    LAS bf16_t* Ks = (LAS bf16_t*)(w.lds); LAS unsigned char* Vl = w.lds + AT_V_OFF;
    const int NU = NCH * AKV;
    u32x4 pk[3], pv[3]; bf16x8 qn[4];
    if (w.bid < NU) { const int c = w.bid >> 2, g = w.bid & 3; attn_load_kv(Kb, Vb, ck, cv, c, g, w.tid, pk, pv); attn_load_q(Qb, c, 0, g * 8 + w.wave, w.lane & 31, w.lane >> 5, qn); }
#pragma unroll 1
    for (int u = w.bid; u < NU; u += w.G) {
        const int c = u >> 2, g = u & 3, un = u + w.G, cn = un >> 2, gn = un & 3;
        int tid = w.tid; asm volatile("" : "+v"(tid)); const int lane = tid & 63, r = lane & 31, h = lane >> 5;
        LDS_BARRIER();
#pragma unroll
        for (int i = 0; i < 3; ++i) { const int idx = tid + 512 * i, sl = idx >> 3, dc = idx & 7;
            *(LAS u32x4*)(Ks + sl * AT_KS + dc * 8) = pk[i];
            *(LAS u32x4*)(Vl + (dc >> 1) * AT_VB + 32 * sl + 128 * (sl >> 3) + (dc & 1) * 16) = pv[i]; }
        LDS_BARRIER();
        const int hq = g * 8 + w.wave; const float sink2 = sinks[hq] * 1.4426950408889634f;
        const int i0 = (c < NCHP) ? (c == 0 ? 4 : (c == 1 ? 2 : 0)) : 0;
        const LAS unsigned char* vbase = Vl + ((lane >> 4) & 1) * AT_VB + 128 * h + 32 * ((lane & 15) >> 2) + 8 * (lane & 3);
#pragma unroll 1
        for (int qh = 0; qh < 2; ++qh) {
            bf16x8 qf[4];
#pragma unroll
            for (int sx = 0; sx < 4; ++sx) qf[sx] = qn[sx];
            if (qh == 0) { attn_load_q(Qb, c, 1, hq, r, h, qn); if (un < NU) attn_load_kv(Kb, Vb, ck, cv, cn, gn, tid, pk, pv); }
            else if (un < NU) attn_load_q(Qb, cn, 0, gn * 8 + w.wave, r, h, qn);
            const int qrow = 64 * c + 32 * qh + r;
            float mx = sink2;
#pragma unroll
            for (int i = 0; i < 6; ++i) if (i >= i0) { f32x16 t = zero16();
#pragma unroll
                for (int sx = 0; sx < 4; ++sx) { const bf16x8 kf = *(const LAS bf16x8*)(Ks + (32 * i + r) * AT_KS + 16 * sx + 8 * h); t = MFMA32(kf, qf[sx], t); }
#pragma unroll
                for (int e = 0; e < 16; ++e) mx = fmaxf(mx, t[e]); }
            mx = fmaxf(mx, __shfl_xor(mx, 32));
            float sum = 0.f; bf16x8 pf[6][2];
#pragma unroll
            for (int i = 0; i < 6; ++i) if (i >= i0) { f32x16 t = zero16();
#pragma unroll
                for (int sx = 0; sx < 4; ++sx) { const bf16x8 kf = *(const LAS bf16x8*)(Ks + (32 * i + r) * AT_KS + 16 * sx + 8 * h); t = MFMA32(kf, qf[sx], t); }
#pragma unroll
                for (int e = 0; e < 16; ++e) { t[e] = __builtin_amdgcn_exp2f(t[e] - mx); sum += t[e]; }
                pf[i][0] = pack8(t, 0); pf[i][1] = pack8(t, 1); }
            sum += __shfl_xor(sum, 32);
            const float inv = 1.f / (sum + __builtin_amdgcn_exp2f(sink2 - mx));
            f32x16 ot[2]; ot[0] = zero16(); ot[1] = zero16();
#pragma unroll
            for (int i = 0; i < 6; ++i) if (i >= i0) {
#pragma unroll
                for (int s2 = 0; s2 < 2; ++s2) {
#pragma unroll
                    for (int dt = 0; dt < 2; ++dt) { const LAS unsigned char* vp = vbase + dt * (2 * AT_VB) + i * 1536 + s2 * 768; const s16x4 lo = ds_tr(vp), hi = ds_tr(vp + 384);
                        const bf16x8 vf = __builtin_shufflevector(lo, hi, 0, 1, 2, 3, 4, 5, 6, 7); ot[dt] = MFMA32(vf, pf[i][s2], ot[dt]); } } }
#pragma unroll
            for (int dt = 0; dt < 2; ++dt)
#pragma unroll
                for (int gq = 0; gq < 4; ++gq) { u32x2 o; o.x = pk2(ot[dt][4 * gq] * inv, ot[dt][4 * gq + 1] * inv); o.y = pk2(ot[dt][4 * gq + 2] * inv, ot[dt][4 * gq + 3] * inv);
                    *(u32x2*)(AO + (size_t)qrow * DM + hq * 64 + 32 * dt + 8 * gq + 4 * h) = o; }
        }
    }
}
DI void cache_shift(const WG& w, const float* ck, const float* cv, float* kS, float* vS) {
    const int n4 = DBATCH * 64 * 256 / 4;
    for (int i = w.bid * 512 + w.tid; i < n4; i += w.G * 512) { const int b = i / (64 * 64), rem = i % (64 * 64);
        ((f32x4*)kS)[(size_t)b * (128 * 64) + rem] = ((const f32x4*)ck)[(size_t)b * (128 * 64) + 64 * 64 + rem];
        ((f32x4*)vS)[(size_t)b * (128 * 64) + rem] = ((const f32x4*)cv)[(size_t)b * (128 * 64) + 64 * 64 + rem]; }
}

DI float ret_lg2(int hh) { return __log2f(1.f - __builtin_amdgcn_exp2f(-5.f - (float)hh)); }
constexpr int RI_KS = 264, RI_VS = 68, RI_V_OFF = 64 * RI_KS * 2;
DI void ret_intra_phase(const WG& w, const bf16_t* P, bf16_t* O) {
    LAS bf16_t* Ks = (LAS bf16_t*)(w.lds); LAS bf16_t* Vt = (LAS bf16_t*)(w.lds + RI_V_OFF);
    const int lane = w.lane, r = lane & 31, h = lane >> 5, tt = w.wave & 1, dvq = w.wave >> 1;
    for (int u = w.bid; u < NCH * RH; u += w.G) {
        const int c = u >> 3, hh = u & 7; const float lg2 = ret_lg2(hh);
        LDS_BARRIER();
#pragma unroll
        for (int i = 0; i < 4; ++i) { const int idx = w.tid + 512 * i, s = idx >> 5, dc = idx & 31;
            *(LAS u32x4*)(Ks + s * RI_KS + dc * 8) = *(const u32x4*)(P + (size_t)(64 * c + s) * RIN + 2048 + hh * 256 + dc * 8); }
#pragma unroll
        for (int i = 0; i < 8; ++i) { const int idx = w.tid + 512 * i, s = idx >> 6, dc = idx & 63;
            const u32x4 vv = *(const u32x4*)(P + (size_t)(64 * c + s) * RIN + 4096 + hh * 512 + dc * 8); const unsigned e[4] = {vv.x, vv.y, vv.z, vv.w};
#pragma unroll
            for (int j = 0; j < 4; ++j) { Vt[(dc * 8 + 2 * j) * RI_VS + s] = (bf16_t)(e[j] & 0xffffu); Vt[(dc * 8 + 2 * j + 1) * RI_VS + s] = (bf16_t)(e[j] >> 16); } }
        LDS_BARRIER();
        const int qrow = 64 * c + 32 * tt + r;
        f32x16 st[2]; st[0] = zero16(); st[1] = zero16();
#pragma unroll 4
        for (int ks = 0; ks < 16; ++ks) { const bf16x8 qf = *(const bf16x8*)(P + (size_t)qrow * RIN + hh * 256 + 16 * ks + 8 * h);
#pragma unroll
            for (int si = 0; si < 2; ++si) if (si <= tt) { const bf16x8 kf = *(const LAS bf16x8*)(Ks + (32 * si + r) * RI_KS + 16 * ks + 8 * h); st[si] = MFMA32(kf, qf, st[si]); } }
        const int t = 32 * tt + r;
#pragma unroll
        for (int si = 0; si < 2; ++si)
#pragma unroll
            for (int e = 0; e < 16; ++e) { const int s = 32 * si + (e & 3) + 8 * (e >> 2) + 4 * h; st[si][e] = (s <= t) ? st[si][e] * __builtin_amdgcn_exp2f(lg2 * (float)(t - s)) : 0.f; }
        f32x16 ot[4];
#pragma unroll
        for (int d = 0; d < 4; ++d) ot[d] = zero16();
#pragma unroll
        for (int si = 0; si < 2; ++si) if (si <= tt) {
#pragma unroll
            for (int s2 = 0; s2 < 2; ++s2) { const bf16x8 pf = pack8(st[si], s2);
#pragma unroll
                for (int d = 0; d < 4; ++d) { const bf16x8 vf = ld_perm_frag(Vt + (128 * dvq + 32 * d + r) * RI_VS + 32 * si + 16 * s2 + 4 * h); ot[d] = MFMA32(vf, pf, ot[d]); } } }
#pragma unroll
        for (int d = 0; d < 4; ++d)
#pragma unroll
            for (int gq = 0; gq < 4; ++gq) { u32x2 o; o.x = pk2(ot[d][4 * gq], ot[d][4 * gq + 1]); o.y = pk2(ot[d][4 * gq + 2], ot[d][4 * gq + 3]);
                *(u32x2*)(O + (size_t)qrow * RVD + hh * 512 + 128 * dvq + 32 * d + 8 * gq + 4 * h) = o; }
    }
}
constexpr int RC_QS = 264, RC_QX = 0, RC_KZ = 33792, RC_VT = 82944, RC_OS = 107520, RC_OSS = 20, RC_BLK = 3072, RC_PT = 148480, RC_PS = 72;
constexpr int RGRP = 8, RNG = NCHP / RGRP;
#define MFMA16(a, b, c) __builtin_amdgcn_mfma_f32_16x16x32_bf16((a), (b), (c), 0, 0, 0)
DI unsigned blk_row(unsigned r) { return 32u * r + 128u * (r >> 3); }
DI unsigned tr_base(unsigned lane) { const unsigned g = lane >> 4, q = (lane & 15) >> 2, p = lane & 3; return blk_row(8 * g + q) + 8 * p; }
DI bf16x8 tr_frag(const LAS unsigned char* base_lane, int c, int ks) {
    const s16x4 lo = ds_tr(base_lane + c * RC_BLK + ks * 1536), hi = ds_tr(base_lane + c * RC_BLK + ks * 1536 + 128); return __builtin_shufflevector(lo, hi, 0, 1, 2, 3, 4, 5, 6, 7);
}
DI u32x4 scale8(u32x4 v, float s) { u32x4 o; o.x = pk2(bflo(v.x) * s, bfhi(v.x) * s); o.y = pk2(bflo(v.y) * s, bfhi(v.y) * s); o.z = pk2(bflo(v.z) * s, bfhi(v.z) * s); o.w = pk2(bflo(v.w) * s, bfhi(v.w) * s); return o; }
template <bool LOAD, bool BF> DI void ret_state_io(LAS unsigned char* L, void* gpv  , f32x4 (&S)[16], int tid, int wave) {
    LAS float* T = (LAS float*)(L + RC_QX); const int lane = tid & 63, c16 = lane & 15, g = lane >> 4; float* gp = (float*)gpv; bf16_t* gb = (bf16_t*)gpv;
#pragma unroll
    for (int p = 0; p < 4; ++p) {
        LDS_BARRIER();
        if (LOAD) {
            if (BF) {
#pragma unroll
                for (int i = 0; i < 2; ++i) { const int idx = tid + 512 * i, row = idx >> 4, c8 = idx & 15; const u32x4 v = *(const u32x4*)(gb + (size_t)(64 * p + row) * RDV + 8 * c8); LAS float* tp = T + row * 132 + 8 * c8;
                    tp[0] = bflo(v.x); tp[1] = bfhi(v.x); tp[2] = bflo(v.y); tp[3] = bfhi(v.y); tp[4] = bflo(v.z); tp[5] = bfhi(v.z); tp[6] = bflo(v.w); tp[7] = bfhi(v.w); }
            } else {
#pragma unroll
                for (int i = 0; i < 4; ++i) { const int idx = tid + 512 * i, row = idx >> 5, c4 = idx & 31; const f32x4 v = *(const f32x4*)(gp + (size_t)(64 * p + row) * RDV + 4 * c4); LAS float* tp = T + row * 132 + 4 * c4; tp[0] = v.x; tp[1] = v.y; tp[2] = v.z; tp[3] = v.w; }
            }
            LDS_BARRIER();
#pragma unroll
            for (int kq = 0; kq < 4; ++kq)
#pragma unroll
                for (int i = 0; i < 4; ++i) { const float v = T[(16 * kq + 4 * g + i) * 132 + 16 * wave + c16];
                    S[4 * p + kq][i] = v; }
        } else {
#pragma unroll
            for (int kq = 0; kq < 4; ++kq)
#pragma unroll
                for (int i = 0; i < 4; ++i) { const float v = S[4 * p + kq][i]; T[(16 * kq + 4 * g + i) * 132 + 16 * wave + c16] = v; }
            LDS_BARRIER();
            if (BF) {
#pragma unroll
                for (int i = 0; i < 2; ++i) { const int idx = tid + 512 * i, row = idx >> 4, c8 = idx & 15; const LAS float* tp = T + row * 132 + 8 * c8;
                    u32x4 o; o.x = pk2(tp[0], tp[1]); o.y = pk2(tp[2], tp[3]); o.z = pk2(tp[4], tp[5]); o.w = pk2(tp[6], tp[7]); *(u32x4*)(gb + (size_t)(64 * p + row) * RDV + 8 * c8) = o; }
            } else {
#pragma unroll
                for (int i = 0; i < 4; ++i) { const int idx = tid + 512 * i, row = idx >> 5, c4 = idx & 31; const LAS float* tp = T + row * 132 + 4 * c4; *(f32x4*)(gp + (size_t)(64 * p + row) * RDV + 4 * c4) = (f32x4){tp[0], tp[1], tp[2], tp[3]}; }
            }
        }
    }
    LDS_BARRIER();
}
template <int MODE>
DI void ret_chain_phase(const WG& w, const bf16_t* P, bf16_t* O, const float* state_in, bf16_t* slots, float* outS, int dup) {
    LAS unsigned char* L = w.lds;
    const int ntask = (MODE == 0) ? RNG * 32 : RNG * 32 + DBATCH * 32;
    for (int task = w.bid; task < ntask; task += w.G) {
        const bool smp = task >= RNG * 32; const int ts = smp ? task - RNG * 32 : task, gb = ts >> 5, hh = (ts >> 2) & 7, j = ts & 3;
        const int c_lo = smp ? NCHP + gb : RGRP * gb, nch = smp ? 1 : RGRP;
        const size_t so = ((size_t)gb * RH + hh) * RDK * RDV;
        const int dvw = 128 * j + 16 * w.wave; const float lg2 = ret_lg2(hh), gam64 = __builtin_amdgcn_exp2f(lg2 * 64.f);
        int lane0 = w.lane; asm volatile("" : "+v"(lane0));
        f32x4 S[16];
        if (MODE == 1) { if (smp) ret_state_io<true, false>(L, (void*)(state_in + so + 128 * j), S, w.tid, w.wave); else ret_state_io<true, true>(L, (void*)(slots + so + 128 * j), S, w.tid, w.wave); }
        else {
#pragma unroll
            for (int kt = 0; kt < 16; ++kt) S[kt] = (f32x4){0.f, 0.f, 0.f, 0.f}; }
        u32x4 pq[4], pk[4], pv[2];
        {   const int tid = w.tid;
#pragma unroll
            for (int i = 0; i < 4; ++i) { const int idx = tid + 512 * i, t = idx >> 5, dc = idx & 31; const bf16_t* pr = P + (size_t)(64 * c_lo + t) * RIN + hh * 256 + dc * 8;
                if (MODE == 1) pq[i] = *(const u32x4*)pr; pk[i] = *(const u32x4*)(pr + 2048); }
#pragma unroll
            for (int i = 0; i < 2; ++i) { const int idx = tid + 512 * i, t = idx >> 4, dc = idx & 15; pv[i] = *(const u32x4*)(P + (size_t)(64 * c_lo + t) * RIN + 4096 + hh * 512 + 128 * j + dc * 8); } }
#pragma unroll 1
        for (int cc = 0; cc < nch; ++cc) { const int c = c_lo + cc;
            int tid = w.tid; asm volatile("" : "+v"(tid)); const int ln = tid & 63, c16 = ln & 15, g = ln >> 4;
            LDS_BARRIER();
#pragma unroll
            for (int i = 0; i < 4; ++i) { const int idx = tid + 512 * i, t = idx >> 5, dc = idx & 31;
                if (MODE == 1) *(LAS u32x4*)(L + RC_QX + (t * RC_QS + dc * 8) * 2) = scale8(pq[i], __builtin_amdgcn_exp2f(lg2 * (float)(t + 1)));
                *(LAS u32x4*)(L + RC_KZ + (dc >> 1) * RC_BLK + blk_row(t) + (dc & 1) * 16) = scale8(pk[i], __builtin_amdgcn_exp2f(lg2 * (float)(63 - t))); }
#pragma unroll
            for (int i = 0; i < 2; ++i) { const int idx = tid + 512 * i, t = idx >> 4, dc = idx & 15; *(LAS u32x4*)(L + RC_VT + (dc >> 1) * RC_BLK + blk_row(t) + (dc & 1) * 16) = pv[i]; }
            LDS_BARRIER();
            if (cc + 1 < nch) {
#pragma unroll
                for (int i = 0; i < 4; ++i) { const int idx = tid + 512 * i, t = idx >> 5, dc = idx & 31; const bf16_t* pr = P + (size_t)(64 * (c + 1) + t) * RIN + hh * 256 + dc * 8;
                    if (MODE == 1) pq[i] = *(const u32x4*)pr; pk[i] = *(const u32x4*)(pr + 2048); }
#pragma unroll
                for (int i = 0; i < 2; ++i) { const int idx = tid + 512 * i, t = idx >> 4, dc = idx & 15; pv[i] = *(const u32x4*)(P + (size_t)(64 * (c + 1) + t) * RIN + 4096 + hh * 512 + 128 * j + dc * 8); } }
            const LAS unsigned char* kb = L + RC_KZ + tr_base(ln); const LAS unsigned char* vb = L + RC_VT + tr_base(ln) + w.wave * RC_BLK;
            const bf16x8 vf0 = tr_frag(vb, 0, 0), vf1 = tr_frag(vb, 0, 1);
            if (MODE == 1) {
                const LAS bf16_t* Qx = (const LAS bf16_t*)(L + RC_QX); LAS bf16_t* PT = (LAS bf16_t*)(L + RC_PT);
                const float gm64 = __builtin_amdgcn_exp2f(-64.f * lg2);
#pragma unroll
                for (int q2 = 0; q2 < 2; ++q2) { const int tile = w.wave + 8 * q2, tt = tile >> 2, st = tile & 3; f32x4 d = (f32x4){0.f, 0.f, 0.f, 0.f};
                    if (st <= tt) {
#pragma unroll
                        for (int ks = 0; ks < 8; ++ks) { const bf16x8 af = *(const LAS bf16x8*)(Qx + (16 * tt + c16) * RC_QS + 32 * ks + 8 * g);
                            const bf16x8 bfr = *(const LAS bf16x8*)(L + RC_KZ + (2 * ks + (g >> 1)) * RC_BLK + blk_row(16 * st + c16) + 16 * (g & 1)); d = MFMA16(af, bfr, d); } }
#pragma unroll
                    for (int i = 0; i < 4; ++i) { const int t = 16 * tt + 4 * g + i, sx = 16 * st + c16; PT[t * RC_PS + sx] = f2bf((sx <= t) ? d[i] * gm64 : 0.f); } }
                f32x4 o[4];
#pragma unroll
                for (int tt = 0; tt < 4; ++tt) o[tt] = (f32x4){0.f, 0.f, 0.f, 0.f};
#pragma unroll
                for (int kp = 0; kp < 8; ++kp) { u32x4 sp; sp.x = pk2(S[2 * kp][0], S[2 * kp][1]); sp.y = pk2(S[2 * kp][2], S[2 * kp][3]); sp.z = pk2(S[2 * kp + 1][0], S[2 * kp + 1][1]); sp.w = pk2(S[2 * kp + 1][2], S[2 * kp + 1][3]);
                    const bf16x8 sf = __builtin_bit_cast(bf16x8, sp);
#pragma unroll
                    for (int tt = 0; tt < 4; ++tt) { const LAS bf16_t* qp = Qx + (16 * tt + c16) * RC_QS + 32 * kp + 4 * g; const s16x4 lo = *(const LAS s16x4*)qp, hi = *(const LAS s16x4*)(qp + 16);
                        const bf16x8 af = __builtin_shufflevector(lo, hi, 0, 1, 2, 3, 4, 5, 6, 7); o[tt] = MFMA16(af, sf, o[tt]); } if (kp & 1) asm volatile("" ::: "memory"); }
                LDS_BARRIER();
#pragma unroll
                for (int tt = 0; tt < 4; ++tt) { const bf16x8 p0 = *(const LAS bf16x8*)(PT + (16 * tt + c16) * RC_PS + 8 * g), p1 = *(const LAS bf16x8*)(PT + (16 * tt + c16) * RC_PS + 32 + 8 * g);
                    o[tt] = MFMA16(p0, vf0, o[tt]); o[tt] = MFMA16(p1, vf1, o[tt]); }
                LAS float* os = (LAS float*)(L + RC_OS + w.wave * (64 * RC_OSS * 4));
#pragma unroll
                for (int tt = 0; tt < 4; ++tt)
#pragma unroll
                    for (int i = 0; i < 4; ++i) os[(16 * tt + 4 * g + i) * RC_OSS + c16] = o[tt][i];
                const f32x4 r0 = *(const LAS f32x4*)(os + ln * RC_OSS), r1 = *(const LAS f32x4*)(os + ln * RC_OSS + 4), r2 = *(const LAS f32x4*)(os + ln * RC_OSS + 8), r3 = *(const LAS f32x4*)(os + ln * RC_OSS + 12);
                u32x4 n0, n1; n0.x = pk2(r0.x, r0.y); n0.y = pk2(r0.z, r0.w); n0.z = pk2(r1.x, r1.y); n0.w = pk2(r1.z, r1.w); n1.x = pk2(r2.x, r2.y); n1.y = pk2(r2.z, r2.w); n1.z = pk2(r3.x, r3.y); n1.w = pk2(r3.z, r3.w);
                bf16_t* orow = O + (size_t)(64 * c + ln) * RVD + hh * 512 + dvw;
                if (!dup) { *(u32x4*)orow = n0; *(u32x4*)(orow + 8) = n1; }
            }
            if (MODE == 0 || smp || cc + 1 < nch) {
#pragma unroll
                for (int kt = 0; kt < 16; ++kt) { S[kt] = S[kt] * gam64;
                    const bf16x8 k0 = tr_frag(kb, kt, 0), k1 = tr_frag(kb, kt, 1);
                    S[kt] = MFMA16(k0, vf0, S[kt]); S[kt] = MFMA16(k1, vf1, S[kt]); if ((kt & 3) == 3) asm volatile("" ::: "memory"); }
            }
        }
        if (MODE == 0) ret_state_io<false, true>(L, (void*)(slots + so + 128 * j), S, w.tid, w.wave); else if (smp) ret_state_io<false, false>(L, (void*)(outS + so + 128 * j), S, w.tid, w.wave);
    }
}
DI void ret_prefix_phase(const WG& w, bf16_t* slots, float* outP) {
    constexpr int N8 = RH * RDK * RDV / 8;
    for (int e = w.bid * 512 + w.tid; e < N8; e += w.G * 512) { const int hh = e / (RDK * RDV / 8); const float g512 = __builtin_amdgcn_exp2f(ret_lg2(hh) * (float)(64 * RGRP));
        float carry[8];
#pragma unroll
        for (int q = 0; q < 8; ++q) carry[q] = 0.f;
#pragma unroll 8
        for (int g = 0; g < RNG; ++g) { u32x4* p = (u32x4*)slots + (size_t)g * N8 + e; const u32x4 t = *p;
            u32x4 o; o.x = pk2(carry[0], carry[1]); o.y = pk2(carry[2], carry[3]); o.z = pk2(carry[4], carry[5]); o.w = pk2(carry[6], carry[7]); *p = o;
            const float tv[8] = {bflo(t.x), bfhi(t.x), bflo(t.y), bfhi(t.y), bflo(t.z), bfhi(t.z), bflo(t.w), bfhi(t.w)};
#pragma unroll
            for (int q = 0; q < 8; ++q) carry[q] = carry[q] * g512 + tv[q]; }
        ((f32x4*)outP)[2 * e] = (f32x4){carry[0], carry[1], carry[2], carry[3]}; ((f32x4*)outP)[2 * e + 1] = (f32x4){carry[4], carry[5], carry[6], carry[7]}; }
}
DI void ret_gn_phase(const WG& w, const bf16_t* P, bf16_t* O, const float* gnw, bf16_t* Odst) {
    for (int idx0 = w.gw * 4; idx0 < M * RH; idx0 += w.ngw * 4) {
        u32x4 ov[4], gv[4];
#pragma unroll
        for (int q = 0; q < 4; ++q) { const int idx = idx0 + q, m = idx >> 3, hh = idx & 7; ov[q] = *(const u32x4*)(O + (size_t)m * RVD + hh * 512 + 8 * w.lane); gv[q] = *(const u32x4*)(P + (size_t)m * RIN + 8192 + hh * 512 + 8 * w.lane); }
#pragma unroll
        for (int q = 0; q < 4; ++q) { const int idx = idx0 + q, m = idx >> 3, hh = idx & 7;
            float x[8] = {bflo(ov[q].x), bfhi(ov[q].x), bflo(ov[q].y), bfhi(ov[q].y), bflo(ov[q].z), bfhi(ov[q].z), bflo(ov[q].w), bfhi(ov[q].w)};
            const float gt[8] = {bflo(gv[q].x), bfhi(gv[q].x), bflo(gv[q].y), bfhi(gv[q].y), bflo(gv[q].z), bfhi(gv[q].z), bflo(gv[q].w), bfhi(gv[q].w)};
            float s = 0.f;
#pragma unroll
            for (int e = 0; e < 8; ++e) s += x[e];
            const float mean = wave_sum_fast(s) * (1.f / 512.f); float s2 = 0.f;
#pragma unroll
            for (int e = 0; e < 8; ++e) { x[e] -= mean; s2 += x[e] * x[e]; }
            const float rs = 1.f / sqrtf(wave_sum_fast(s2) * (1.f / 512.f) + 1e-5f);
            const float* gp = gnw + hh * 512 + 8 * w.lane; const f32x4 g0 = *(const f32x4*)gp, g1 = *(const f32x4*)(gp + 4); const float gw8[8] = {g0.x, g0.y, g0.z, g0.w, g1.x, g1.y, g1.z, g1.w};
#pragma unroll
            for (int e = 0; e < 8; ++e) x[e] = x[e] * rs * gw8[e] * (gt[e] / (1.f + __expf(-gt[e])));
            u32x4 o; o.x = pk2(x[0], x[1]); o.y = pk2(x[2], x[3]); o.z = pk2(x[4], x[5]); o.w = pk2(x[6], x[7]); *(u32x4*)(Odst + (size_t)m * RVD + hh * 512 + 8 * w.lane) = o; }
    }
}
constexpr int REC_WT = 0, REC_BHT = 8192, REC_RT = 16384, REC_ARB = 24576, REC_VT = 32768, REC_VK = 40960, REC_AKV = 49152, REC_PL = 57344, REC = 57600;
constexpr int WSEG = 32, WNSEG = NCHP / WSEG;
constexpr size_t SEGBUF = (size_t)WSEG * WH * REC;
constexpr int PP_S = 72;
constexpr int PP_AT = 0, PP_RT = 9216, PP_BT = 18432, PP_KT = 27648, PP_KH = 36864, PP_VT = 46080, PP_AAK = 55296, PP_ARK = 64512, PP_AAB = 73728, PP_X2 = 90112, PP_PART = 106496, PP_X1 = 110592, PP_ARB = 126976, PP_BHT = 136192, PP_MT = 145408;
DI int pswap(int k) { return (k & ~12) | ((k & 4) << 1) | ((k & 8) >> 1); }

DI void copy_tile_pswap(const LAS bf16_t* T, unsigned char* dst, int task) {
    const int row = task >> 2, m = task & 3; const LAS u32x4* sp = (const LAS u32x4*)(T + row * PP_S + 16 * m); const u32x4 a = sp[0], b = sp[1];
    u32x4 o0, o1; o0.x = a.x; o0.y = a.y; o0.z = b.x; o0.w = b.y; o1.x = a.z; o1.y = a.w; o1.z = b.z; o1.w = b.w;
    u32x4* dp = (u32x4*)(dst + row * 128 + 32 * m); dp[0] = o0; dp[1] = o1;
}
DI void copy_tile_pswap_f32(const LAS float* T, unsigned char* dst, int task) {
    const int row = task >> 2, m = task & 3; const LAS f32x4* sp = (const LAS f32x4*)(T + row * 64 + 16 * m); const f32x4 a0 = sp[0], a1 = sp[1], b0 = sp[2], b1 = sp[3];
    u32x4 o0, o1; o0.x = pk2(a0.x, a0.y); o0.y = pk2(a0.z, a0.w); o0.z = pk2(b0.x, b0.y); o0.w = pk2(b0.z, b0.w); o1.x = pk2(a1.x, a1.y); o1.y = pk2(a1.z, a1.w); o1.z = pk2(b1.x, b1.y); o1.w = pk2(b1.z, b1.w);
    u32x4* dp = (u32x4*)(dst + row * 128 + 32 * m); dp[0] = o0; dp[1] = o1;
}
struct RwkvIn { const bf16_t *Rb, *Kb, *Vb, *Ab, *Gb; const float* LW; const float *k_k, *k_a, *r_k, *ln_w, *ln_b; float* bonus; bf16_t* Ob; };

struct PrepRaw { unsigned short rb[8], kb[8], vb[8], ab[8]; float lw[8]; };
DI void prep_load(const WG& w, const RwkvIn& in, int c, int hd, PrepRaw& q) {
    int lane = w.lane; asm volatile("" : "+v"(lane));
#pragma unroll
    for (int i = 0; i < 8; ++i) { const size_t off = (size_t)(64 * c + 8 * w.wave + i) * DM + hd * 64 + lane; q.rb[i] = in.Rb[off]; q.kb[i] = in.Kb[off]; q.vb[i] = in.Vb[off]; q.ab[i] = in.Ab[off]; q.lw[i] = in.LW[off]; }
}
DI void rwkv_prep_pair(const WG& w, const RwkvIn& in, int c, int hd, unsigned char* rec, const PrepRaw& raw, gu32* qctr, volatile LAS unsigned* qw) {
    LAS bf16_t* AT = (LAS bf16_t*)(w.lds + PP_AT); LAS bf16_t* RT2 = (LAS bf16_t*)(w.lds + PP_RT); LAS bf16_t* BT = (LAS bf16_t*)(w.lds + PP_BT); LAS bf16_t* KT = (LAS bf16_t*)(w.lds + PP_KT);
    LAS bf16_t* KHt = (LAS bf16_t*)(w.lds + PP_KH); LAS bf16_t* VtL = (LAS bf16_t*)(w.lds + PP_VT); LAS bf16_t* AAK = (LAS bf16_t*)(w.lds + PP_AAK); LAS bf16_t* ARK = (LAS bf16_t*)(w.lds + PP_ARK);
    LAS float* AAB = (LAS float*)(w.lds + PP_AAB); LAS float* X2 = (LAS float*)(w.lds + PP_X2); LAS float* PART = (LAS float*)(w.lds + PP_PART); LAS float* X1 = (LAS float*)(w.lds + PP_X1); LAS bf16_t* ARBT = (LAS bf16_t*)(w.lds + PP_ARB); LAS bf16_t* BHT_T = (LAS bf16_t*)(w.lds + PP_BHT);
    int lane_ = w.lane; asm volatile("" : "+v"(lane_));
    const int lane = lane_, tg = w.wave, col = hd * 64 + lane, r = lane & 31, h = lane >> 5;
    LDS_BARRIER();
    {
        const float kkc = in.k_k[col], kac = in.k_a[col], rkc = in.r_k[col];
        float rr[8], kp[8], aa[8], lw[8], kk[8], cl[8], bsum[8]; unsigned short vb[8], kb[8];
        float run = 0.f;
#pragma unroll
        for (int i = 0; i < 8; ++i) { rr[i] = bf2f(raw.rb[i]); kb[i] = raw.kb[i]; vb[i] = raw.vb[i]; aa[i] = bf2f(raw.ab[i]); lw[i] = raw.lw[i]; }
#pragma unroll
        for (int i = 0; i < 8; ++i) { const float kr = bf2f(kb[i]);
            const float kkr = kr * kkc; const float ss = wave_sum_fast(kkr * kkr); kk[i] = kkr / fmaxf(sqrtf(ss), 1e-12f); kp[i] = kr * (1.f + (aa[i] - 1.f) * kac);
            bsum[i] = wave_sum_fast(rr[i] * kp[i] * rkc);
            run += lw[i]; cl[i] = run; }
        if (lane < 8) { float bv = bsum[0];
#pragma unroll
            for (int i = 1; i < 8; ++i) bv = (lane == i) ? bsum[i] : bv;
            in.bonus[(size_t)(64 * c + 8 * tg + lane) * WH + hd] = bv; }
        PART[tg * 64 + lane] = run;
        LDS_BARRIER();
        float pre = 0.f, tot = 0.f;
#pragma unroll
        for (int t2 = 0; t2 < 8; ++t2) { const float p = PART[t2 * 64 + lane]; tot += p; if (t2 < tg) pre += p; }
        unsigned short khs[8], bhs[8];
#pragma unroll
        for (int i = 0; i < 8; ++i) { const int t = 8 * tg + i; const float cs = pre + cl[i], csp = cs - lw[i];
            const float e_cs = __expf(cs), e_ncs = __expf(-cs), e_csp = __expf(csp), e_l = __expf(tot - cs); const float b = kk[i] * aa[i];
            const unsigned short rt = f2bf(rr[i] * e_cs);
            AT[t * PP_S + lane] = f2bf(-kk[i] * e_csp); RT2[t * PP_S + lane] = rt; BT[t * PP_S + lane] = f2bf(b * e_ncs); KT[t * PP_S + lane] = f2bf(kp[i] * e_ncs);
            khs[i] = f2bf(kp[i] * e_l); bhs[i] = f2bf(b * e_l); }
        u32x4 kq, vq; kq.x = khs[0] | ((unsigned)khs[1] << 16); kq.y = khs[2] | ((unsigned)khs[3] << 16); kq.z = khs[4] | ((unsigned)khs[5] << 16); kq.w = khs[6] | ((unsigned)khs[7] << 16);
        vq.x = vb[0] | ((unsigned)vb[1] << 16); vq.y = vb[2] | ((unsigned)vb[3] << 16); vq.z = vb[4] | ((unsigned)vb[5] << 16); vq.w = vb[6] | ((unsigned)vb[7] << 16);
        *(LAS u32x4*)(KHt + lane * PP_S + 8 * tg) = kq; *(LAS u32x4*)(VtL + lane * PP_S + 8 * tg) = vq;
        { u32x4 bq; bq.x = bhs[0] | ((unsigned)bhs[1] << 16); bq.y = bhs[2] | ((unsigned)bhs[3] << 16); bq.z = bhs[4] | ((unsigned)bhs[5] << 16); bq.w = bhs[6] | ((unsigned)bhs[7] << 16);
          *(LAS u32x4*)(BHT_T + lane * PP_S + 8 * tg) = bq; }
        if (tg == 0) ((float*)(rec + REC_PL))[lane] = __expf(tot);
    }
    LDS_BARRIER();
    {
        const int pi = tg >> 1, tt = tg & 1; const LAS bf16_t* X = (pi < 2) ? AT : RT2; const LAS bf16_t* Y = (pi & 1) ? KT : BT;
#pragma unroll
        for (int si = 0; si < 2; ++si) { f32x16 d = zero16();
            if (si <= tt) {
#pragma unroll
                for (int ks = 0; ks < 4; ++ks) { const bf16x8 xa = *(const LAS bf16x8*)(X + (32 * tt + r) * PP_S + 16 * ks + 8 * h), yb = *(const LAS bf16x8*)(Y + (32 * si + r) * PP_S + 16 * ks + 8 * h);
                    d = (pi == 0) ? MFMA32(yb, xa, d) : MFMA32(xa, yb, d); } }
            if (pi == 0) {
#pragma unroll
                for (int e = 0; e < 16; ++e) { const int sx = 32 * si + (e & 3) + 8 * (e >> 2) + 4 * h, t = 32 * tt + r; AAB[sx * 64 + t] = (sx < t) ? d[e] : 0.f; }
            } else { const int sx = 32 * si + r;
#pragma unroll
                for (int e = 0; e < 16; ++e) { const int t = 32 * tt + (e & 3) + 8 * (e >> 2) + 4 * h; const bool keep = (pi < 2) ? (sx < t) : (sx <= t); const float val = keep ? d[e] : 0.f;
                    if (pi == 1) AAK[t * PP_S + sx] = f2bf(val); else if (pi == 3) ARK[t * PP_S + sx] = f2bf(val); else ARBT[t * PP_S + sx] = f2bf(val); } } }
    }
    LDS_BARRIER();
    if (tg == 7 && lane == 0) qw[0] = __hip_atomic_fetch_add(qctr, 1u, __ATOMIC_RELAXED, __HIP_MEMORY_SCOPE_AGENT);
    for (int id = tg; id < 12; id += 8) { const int prod = id >> 2, it = (id >> 1) & 1, vt = id & 1; const LAS bf16_t* Am = (prod == 0) ? AAK : (prod == 1 ? ARK : KHt);
        f32x16 d = zero16();
#pragma unroll
        for (int ks = 0; ks < 4; ++ks) { const bf16x8 a = *(const LAS bf16x8*)(Am + (32 * it + r) * PP_S + 16 * ks + 8 * h), b = *(const LAS bf16x8*)(VtL + (32 * vt + r) * PP_S + 16 * ks + 8 * h); d = MFMA32(a, b, d); }
        if (prod == 0) {
#pragma unroll
            for (int e = 0; e < 16; ++e) X2[(32 * it + (e & 3) + 8 * (e >> 2) + 4 * h) * 64 + 32 * vt + r] = d[e];
        } else { u32x4* dst = (u32x4*)(rec + (prod == 1 ? REC_AKV : REC_VK) + ((it * 2 + vt) * 64 + lane) * 32);
            u32x4 o0, o1; o0.x = pk2(d[0], d[1]); o0.y = pk2(d[2], d[3]); o0.z = pk2(d[4], d[5]); o0.w = pk2(d[6], d[7]); o1.x = pk2(d[8], d[9]); o1.y = pk2(d[10], d[11]); o1.z = pk2(d[12], d[13]); o1.w = pk2(d[14], d[15]);
            dst[0] = o0; dst[1] = o1; } }
    LAS bf16_t* MT = (LAS bf16_t*)(w.lds + PP_MT);
    if (tg >= 4) {
        const int b = tg - 4; float y[16]; const bool live = b > (lane >> 4);
        const LAS f32x4* np = (const LAS f32x4*)(AAB + lane * 64 + 16 * b); const f32x4 n0 = np[0], n1 = np[1], n2 = np[2], n3 = np[3];
        const float nv[16] = {n0.x, n0.y, n0.z, n0.w, n1.x, n1.y, n1.z, n1.w, n2.x, n2.y, n2.z, n2.w, n3.x, n3.y, n3.z, n3.w};
#pragma unroll
        for (int i2 = 0; i2 < 16; ++i2) y[i2] = live ? nv[i2] : 0.f;
#pragma unroll
        for (int i2 = 0; i2 < 15; ++i2) { const LAS f32x4* ap = (const LAS f32x4*)(AAB + (16 * b + i2) * 64 + 16 * b); const f32x4 a0 = ap[0], a1 = ap[1], a2 = ap[2], a3 = ap[3];
            const float av[16] = {a0.x, a0.y, a0.z, a0.w, a1.x, a1.y, a1.z, a1.w, a2.x, a2.y, a2.z, a2.w, a3.x, a3.y, a3.z, a3.w};
#pragma unroll
            for (int i3 = i2 + 1; i3 < 16; ++i3) y[i3] += av[i3] * y[i2]; }
#pragma unroll
        for (int i2 = 0; i2 < 16; ++i2) MT[(16 * b + i2) * PP_S + lane] = f2bf(y[i2]);
    }
    LDS_BARRIER();
    LAS bf16_t* YT0 = BT; LAS bf16_t* YT1 = KHt;
    {
        const int b = tg & 3, colw = (tg >> 2) * 64 + lane; float y[16];
#pragma unroll
        for (int i2 = 0; i2 < 16; ++i2) y[i2] = (colw < 64) ? bf2f(AT[(16 * b + i2) * PP_S + colw]) : X2[(16 * b + i2) * 64 + colw - 64];
#pragma unroll
        for (int i2 = 0; i2 < 15; ++i2) { const LAS f32x4* ap = (const LAS f32x4*)(AAB + (16 * b + i2) * 64 + 16 * b); const f32x4 a0 = ap[0], a1 = ap[1], a2 = ap[2], a3 = ap[3];
            const float av[16] = {a0.x, a0.y, a0.z, a0.w, a1.x, a1.y, a1.z, a1.w, a2.x, a2.y, a2.z, a2.w, a3.x, a3.y, a3.z, a3.w};
#pragma unroll
            for (int i3 = i2 + 1; i3 < 16; ++i3) y[i3] += av[i3] * y[i2]; }
        LAS float* yf = (colw < 64) ? X1 + colw : X2 + (colw - 64);
#pragma unroll
        for (int i2 = 0; i2 < 16; ++i2) yf[(16 * b + i2) * 64] = y[i2];
        u32x4 o0, o1; o0.x = pk2(y[0], y[1]); o0.y = pk2(y[2], y[3]); o0.z = pk2(y[4], y[5]); o0.w = pk2(y[6], y[7]); o1.x = pk2(y[8], y[9]); o1.y = pk2(y[10], y[11]); o1.z = pk2(y[12], y[13]); o1.w = pk2(y[14], y[15]);
        LAS u32x4* yp = (LAS u32x4*)(YT0 + colw * PP_S + 16 * b); yp[0] = o0; yp[1] = o1;
    }
    LDS_BARRIER();
    {
        const int rt = tg & 1, ct = tg >> 1; LAS float* Yf = (ct < 2) ? X1 + 32 * ct : X2 + 32 * (ct - 2);
        f32x16 yacc;
#pragma unroll
        for (int e2 = 0; e2 < 16; ++e2) yacc[e2] = Yf[(32 * rt + (e2 & 3) + 8 * (e2 >> 2) + 4 * h) * 64 + r];
        bf16x8 mf[4];
#pragma unroll
        for (int ks = 0; ks < 4; ++ks) mf[ks] = *(const LAS bf16x8*)(MT + (32 * rt + r) * PP_S + 16 * ks + 8 * h);
#pragma unroll
        for (int st = 0; st < 3; ++st) { const LAS bf16_t* src = (st & 1) ? YT1 : YT0; LAS bf16_t* dstt = (st & 1) ? YT0 : YT1;
            f32x16 acc = yacc;
#pragma unroll
            for (int ks = 0; ks < 4; ++ks) { const bf16x8 bfr = *(const LAS bf16x8*)(src + (32 * ct + r) * PP_S + 16 * ks + 8 * h); acc = MFMA32(mf[ks], bfr, acc); }
            if (st < 2) {
#pragma unroll
                for (int gq = 0; gq < 4; ++gq) { u32x2 o; o.x = pk2(acc[4 * gq], acc[4 * gq + 1]); o.y = pk2(acc[4 * gq + 2], acc[4 * gq + 3]); *(LAS u32x2*)(dstt + (32 * ct + r) * PP_S + 32 * rt + 8 * gq + 4 * h) = o; }
                LDS_BARRIER();
            } else if (ct < 2) {
#pragma unroll
                for (int e2 = 0; e2 < 16; ++e2) Yf[(32 * rt + (e2 & 3) + 8 * (e2 >> 2) + 4 * h) * 64 + r] = acc[e2];
            } else { u32x4* dst = (u32x4*)(rec + REC_VT + ((rt * 2 + (ct - 2)) * 64 + lane) * 32); u32x4 o0, o1;
                o0.x = pk2(acc[0], acc[1]); o0.y = pk2(acc[2], acc[3]); o0.z = pk2(acc[4], acc[5]); o0.w = pk2(acc[6], acc[7]); o1.x = pk2(acc[8], acc[9]); o1.y = pk2(acc[10], acc[11]); o1.z = pk2(acc[12], acc[13]); o1.w = pk2(acc[14], acc[15]);
                dst[0] = o0; dst[1] = o1; }
        }
    }
    LDS_BARRIER();
    for (int task = w.tid; task < 1024; task += 512) { const int which = task >> 8, tk = task & 255;
        if (which == 0) copy_tile_pswap(RT2, rec + REC_RT, tk); else if (which == 1) copy_tile_pswap(ARBT, rec + REC_ARB, tk); else if (which == 2) copy_tile_pswap(BHT_T, rec + REC_BHT, tk); else copy_tile_pswap_f32(X1, rec + REC_WT, tk); }
}
DI f32x16 ld_acc_init(const unsigned char* p) { const u32x4 a = ((const u32x4*)p)[0], b = ((const u32x4*)p)[1]; f32x16 o;
    o[0] = bflo(a.x); o[1] = bfhi(a.x); o[2] = bflo(a.y); o[3] = bfhi(a.y); o[4] = bflo(a.z); o[5] = bfhi(a.z); o[6] = bflo(a.w); o[7] = bfhi(a.w);
    o[8] = bflo(b.x); o[9] = bfhi(b.x); o[10] = bflo(b.y); o[11] = bfhi(b.y); o[12] = bflo(b.z); o[13] = bfhi(b.z); o[14] = bflo(b.w); o[15] = bfhi(b.w); return o; }
DI void rwkv_scan_task(int lane, const unsigned char* recs, size_t rec_stride, int nch, int hd, int vh, int row0, const float* s_in, float* s_out, bf16_t* Ob, int dup) {
    const int r = lane & 31, h = lane >> 5, v = 32 * vh + r;
    f32x16 sT[2];
#pragma unroll
    for (int kt = 0; kt < 2; ++kt)
#pragma unroll
        for (int e = 0; e < 16; ++e) sT[kt][e] = s_in ? s_in[v * 64 + 32 * kt + (e & 3) + 8 * (e >> 2) + 4 * h] : 0.f;
#pragma unroll 1
    for (int cc = 0; cc < nch; ++cc) { const unsigned char* rec = recs + (size_t)cc * rec_stride;
        const bf16_t* WTp = (const bf16_t*)(rec + REC_WT); const bf16_t* BHp = (const bf16_t*)(rec + REC_BHT); const bf16_t* RTp = (const bf16_t*)(rec + REC_RT); const bf16_t* ARp = (const bf16_t*)(rec + REC_ARB);
        bf16x8 Sf[2][2], Uf[2][2];
#pragma unroll
        for (int kt = 0; kt < 2; ++kt) { Sf[kt][0] = pack8(sT[kt], 0); Sf[kt][1] = pack8(sT[kt], 1); }
#pragma unroll
        for (int rt = 0; rt < 2; ++rt) { f32x16 u = ld_acc_init(rec + REC_VT + ((rt * 2 + vh) * 64 + lane) * 32);
#pragma unroll
            for (int kt = 0; kt < 2; ++kt)
#pragma unroll
                for (int s2 = 0; s2 < 2; ++s2) { const bf16x8 a = *(const bf16x8*)(WTp + (32 * rt + r) * 64 + 32 * kt + 16 * s2 + 8 * h); u = MFMA32(a, Sf[kt][s2], u); }
            Uf[rt][0] = pack8(u, 0); Uf[rt][1] = pack8(u, 1); }
        f32x16 n[2];
#pragma unroll
        for (int kt = 0; kt < 2; ++kt) { n[kt] = ld_acc_init(rec + REC_VK + ((kt * 2 + vh) * 64 + lane) * 32);
#pragma unroll
            for (int rt = 0; rt < 2; ++rt)
#pragma unroll
                for (int s2 = 0; s2 < 2; ++s2) { const bf16x8 a = *(const bf16x8*)(BHp + (32 * kt + r) * 64 + 32 * rt + 16 * s2 + 8 * h); n[kt] = MFMA32(a, Uf[rt][s2], n[kt]); } }
#pragma unroll
        for (int rt = 0; rt < 2; ++rt) { f32x16 o = ld_acc_init(rec + REC_AKV + ((rt * 2 + vh) * 64 + lane) * 32);
#pragma unroll
            for (int kt = 0; kt < 2; ++kt)
#pragma unroll
                for (int s2 = 0; s2 < 2; ++s2) { const bf16x8 a = *(const bf16x8*)(RTp + (32 * rt + r) * 64 + 32 * kt + 16 * s2 + 8 * h); o = MFMA32(a, Sf[kt][s2], o); }
#pragma unroll
            for (int r2 = 0; r2 < 2; ++r2)
#pragma unroll
                for (int s2 = 0; s2 < 2; ++s2) { const bf16x8 a = *(const bf16x8*)(ARp + (32 * rt + r) * 64 + 32 * r2 + 16 * s2 + 8 * h); o = MFMA32(a, Uf[r2][s2], o); }
#pragma unroll
            for (int e = 0; e < 16; ++e) { const unsigned short ov = f2bf(o[e]); if (!dup) Ob[(size_t)(row0 + 64 * cc + 32 * rt + (e & 3) + 8 * (e >> 2) + 4 * h) * DM + hd * 64 + v] = ov; } }
        const float* pl = (const float*)(rec + REC_PL);
#pragma unroll
        for (int kt = 0; kt < 2; ++kt)
#pragma unroll
            for (int gq = 0; gq < 4; ++gq) { const f32x4 p4 = *(const f32x4*)(pl + 32 * kt + 8 * gq + 4 * h);
#pragma unroll
                for (int i = 0; i < 4; ++i) sT[kt][4 * gq + i] = p4[i] * sT[kt][4 * gq + i] + n[kt][4 * gq + i]; }
    }
#pragma unroll
    for (int kt = 0; kt < 2; ++kt)
#pragma unroll
        for (int e = 0; e < 16; ++e) { if (!dup) s_out[v * 64 + 32 * kt + (e & 3) + 8 * (e >> 2) + 4 * h] = sT[kt][e]; }
}
constexpr int SA_SLOT = 25600  , SA_VT = 16384, SA_VK = 20480, SA_PL = 24576, SX_OFF = 4 * SA_SLOT;
DI void sc_issue(const unsigned char* recs, size_t rec_stride, int nch, int cj, LAS unsigned char* L, int wave, int lane, int vh) {
    const int ca = cj < nch ? cj : nch - 1; const unsigned char* ra = recs + (size_t)ca * rec_stride; LAS unsigned char* sa = L + (cj & 3) * SA_SLOT;
    const int row8 = lane >> 3, c16 = (lane & 7) ^ (row8 & 7);
#pragma unroll
    for (int i = 0; i < 5; ++i) { const int j = (wave - 3) + 5 * i; const unsigned char* src; LAS unsigned char* dst;
        if (j < 16) { const int m = j >> 3, blk = j & 7; src = ra + m * 8192 + (8 * blk + row8) * 128 + c16 * 16; dst = sa + m * 8192 + blk * 1024; }
        else if (j < 24) { const int jj = j - 16, a = jj >> 2, piece = jj & 3; src = ra + REC_VT + a * 8192 + ((piece >> 1) * 2 + vh) * 2048 + (piece & 1) * 1024 + lane * 16; dst = sa + SA_VT + a * 4096 + piece * 1024; }
        else { src = ra + REC_PL + (lane & 15) * 16; dst = sa + SA_PL; }
        __builtin_amdgcn_global_load_lds((const unsigned*)src, (LAS unsigned*)dst, 16, 0, 0); }
}
DI f32x16 unpack_acc(u32x4 a, u32x4 b) { f32x16 o;
    o[0] = bflo(a.x); o[1] = bfhi(a.x); o[2] = bflo(a.y); o[3] = bfhi(a.y); o[4] = bflo(a.z); o[5] = bfhi(a.z); o[6] = bflo(a.w); o[7] = bfhi(a.w);
    o[8] = bflo(b.x); o[9] = bfhi(b.x); o[10] = bflo(b.y); o[11] = bfhi(b.y); o[12] = bflo(b.z); o[13] = bfhi(b.z); o[14] = bflo(b.w); o[15] = bfhi(b.w); return o; }
DI f32x16 ld_acc_init_lds(const LAS unsigned char* p) { return unpack_acc(((const LAS u32x4*)p)[0], ((const LAS u32x4*)p)[1]); }
DI bf16x8 sc_frag(const LAS unsigned char* mat, int row, int cidx) { return *(const LAS bf16x8*)(mat + row * 128 + ((cidx ^ (row & 7)) << 4)); }
DI void rwkv_scan_prompt(const WG& w, const unsigned char* recs, size_t rec_stride, int nch, int hd, int vh, int row0, const float* s_in, float* s_out, bf16_t* Ob, int dup) {
    const int lane = w.lane, wave = w.wave, r = lane & 31, h = lane >> 5, v = 32 * vh + r;
    LAS unsigned char* L = w.lds;
    if (wave == 0) {
        f32x16 sT[2];
#pragma unroll
        for (int kt = 0; kt < 2; ++kt)
#pragma unroll
            for (int e = 0; e < 16; ++e) sT[kt][e] = s_in ? s_in[v * 64 + 32 * kt + (e & 3) + 8 * (e >> 2) + 4 * h] : 0.f;
#pragma unroll
        for (int kt = 0; kt < 2; ++kt)
#pragma unroll
            for (int e = 0; e < 16; ++e) asm volatile("" : "+v"(sT[kt][e]));
        LDS_BARRIER();
#pragma unroll 1
        for (int cc = 0; cc < nch + 2; ++cc) {
            if (cc < nch && dup != 3) { const LAS unsigned char* sa = L + (cc & 3) * SA_SLOT; LAS unsigned char* ex = L + SX_OFF + (cc % 3) * 8192;
                bf16x8 Sf[4], Uf[4];
#pragma unroll
                for (int q = 0; q < 4; ++q) { Sf[q] = pack8(sT[q >> 1], q & 1); *(LAS bf16x8*)(ex + q * 1024 + lane * 16) = Sf[q]; }
                {   bf16x8 fa[2][4]; f32x16 u[2];
#pragma unroll
                    for (int rt = 0; rt < 2; ++rt) { u[rt] = ld_acc_init_lds(sa + SA_VT + rt * 2048 + lane * 32);
#pragma unroll
                        for (int q = 0; q < 4; ++q) fa[rt][q] = sc_frag(sa, 32 * rt + r, 2 * q + h); }
                    __builtin_amdgcn_sched_barrier(0);
#pragma unroll
                    for (int q = 0; q < 4; ++q)
#pragma unroll
                        for (int rt = 0; rt < 2; ++rt) u[rt] = MFMA32(fa[rt][q], Sf[q], u[rt]);
#pragma unroll
                    for (int q = 0; q < 4; ++q) { Uf[q] = pack8(u[q >> 1], q & 1); *(LAS bf16x8*)(ex + 4096 + q * 1024 + lane * 16) = Uf[q]; } }
                f32x16 n[2];
                {   bf16x8 fa[2][4];
#pragma unroll
                    for (int kt = 0; kt < 2; ++kt) { n[kt] = ld_acc_init_lds(sa + SA_VK + kt * 2048 + lane * 32);
#pragma unroll
                        for (int q = 0; q < 4; ++q) fa[kt][q] = sc_frag(sa + 8192, 32 * kt + r, 2 * q + h); }
                    __builtin_amdgcn_sched_barrier(0);
#pragma unroll
                    for (int q = 0; q < 4; ++q)
#pragma unroll
                        for (int kt = 0; kt < 2; ++kt) n[kt] = MFMA32(fa[kt][q], Uf[q], n[kt]); }
                const LAS float* pl = (const LAS float*)(sa + SA_PL);
#pragma unroll
                for (int kt = 0; kt < 2; ++kt)
#pragma unroll
                    for (int gq = 0; gq < 4; ++gq) { const f32x4 p4 = *(const LAS f32x4*)(pl + 32 * kt + 8 * gq + 4 * h);
#pragma unroll
                        for (int i = 0; i < 4; ++i) sT[kt][4 * gq + i] = p4[i] * sT[kt][4 * gq + i] + n[kt][4 * gq + i]; }
            }
            LDS_BARRIER();
        }
        LDS_BARRIER();
#pragma unroll
        for (int kt = 0; kt < 2; ++kt)
#pragma unroll
            for (int e = 0; e < 16; ++e) { if (!dup) s_out[v * 64 + 32 * kt + (e & 3) + 8 * (e >> 2) + 4 * h] = sT[kt][e]; }
    } else if (wave < 3) {
        bf16x8 gr[2][4], gu[2][4]; u32x4 ga[2][2];
        LDS_BARRIER();
#pragma unroll 1
        for (int cc = 0; cc < nch + 2; ++cc) {
            if ((((cc ^ wave) & 1) != 0) && dup != 3) { const int c2 = cc - 2;
                if (c2 >= 0) { const LAS unsigned char* ex = L + SX_OFF + (c2 % 3) * 8192;
                    bf16x8 Sf[4], Uf[4];
#pragma unroll
                    for (int q = 0; q < 4; ++q) { Sf[q] = *(const LAS bf16x8*)(ex + q * 1024 + lane * 16); Uf[q] = *(const LAS bf16x8*)(ex + 4096 + q * 1024 + lane * 16); }
                    f32x16 o[2];
#pragma unroll
                    for (int rt = 0; rt < 2; ++rt) o[rt] = unpack_acc(ga[rt][0], ga[rt][1]);
#pragma unroll
                    for (int q = 0; q < 4; ++q)
#pragma unroll
                        for (int rt = 0; rt < 2; ++rt) o[rt] = MFMA32(gr[rt][q], Sf[q], o[rt]);
#pragma unroll
                    for (int q = 0; q < 4; ++q)
#pragma unroll
                        for (int rt = 0; rt < 2; ++rt) o[rt] = MFMA32(gu[rt][q], Uf[q], o[rt]);
                    bf16_t* op = Ob + (size_t)(row0 + 64 * c2 + 4 * h) * DM + hd * 64 + v;
#pragma unroll
                    for (int rt = 0; rt < 2; ++rt)
#pragma unroll
                        for (int e = 0; e < 16; ++e) { const unsigned short ov = f2bf(o[rt][e]); if (!dup) op[(size_t)(32 * rt + (e & 3) + 8 * (e >> 2)) * DM] = ov; }
                }
                if (cc < nch) { const unsigned char* rec = recs + (size_t)cc * rec_stride;
#pragma unroll
                    for (int rt = 0; rt < 2; ++rt) { const u32x4* ap = (const u32x4*)(rec + REC_AKV + ((rt * 2 + vh) * 64 + lane) * 32); ga[rt][0] = ap[0]; ga[rt][1] = ap[1];
#pragma unroll
                        for (int q = 0; q < 4; ++q) { gr[rt][q] = *(const bf16x8*)(rec + REC_RT + ((32 * rt + r) * 64 + 16 * q + 8 * h) * 2); gu[rt][q] = *(const bf16x8*)(rec + REC_ARB + ((32 * rt + r) * 64 + 16 * q + 8 * h) * 2); } } }
            }
            LDS_BARRIER();
        }
        LDS_BARRIER();
    } else {
        sc_issue(recs, rec_stride, nch, 0, L, wave, lane, vh); sc_issue(recs, rec_stride, nch, 1, L, wave, lane, vh); sc_issue(recs, rec_stride, nch, 2, L, wave, lane, vh); asm volatile("s_waitcnt vmcnt(10)" ::: "memory");
        LDS_BARRIER();
#pragma unroll 1
        for (int cc = 0; cc < nch + 2; ++cc) { sc_issue(recs, rec_stride, nch, cc + 3, L, wave, lane, vh); if (dup != 2) asm volatile("s_waitcnt vmcnt(10)" ::: "memory");
            LDS_BARRIER(); }
        asm volatile("s_waitcnt vmcnt(0)" ::: "memory");
        LDS_BARRIER();
    }
}
DI float sum8_dpp(float v) {
#define DPP_ADD_(ctrl) v += __builtin_bit_cast(float, __builtin_amdgcn_update_dpp(0, __builtin_bit_cast(int, v), ctrl, 0xf, 0xf, true));
    DPP_ADD_(0xB1) DPP_ADD_(0x4E) DPP_ADD_(0x141)
#undef DPP_ADD_
    return v;
}
constexpr int FIN_RPW = 36, FIN_RG_A = (MP - 64 * WSEG) / FIN_RPW  , FIN_RG_B = (MP + FIN_RPW - 1) / FIN_RPW  ;
template <bool EARLY> DI void rwkv_final_phase(const WG& w, const RwkvIn& in, bf16_t* Odst, int gw, int ngw) {
    constexpr int RPW = FIN_RPW, NRG = M / RPW, NE = FIN_RG_A + (NRG - FIN_RG_B), NL = FIN_RG_B - FIN_RG_A;
    for (int task = gw; task < 4 * (EARLY ? NE : NL); task += ngw) { const int cq = task & 3, ix = task >> 2, rg = EARLY ? (ix < FIN_RG_A ? ix : ix - FIN_RG_A + FIN_RG_B) : ix + FIN_RG_A, m0 = rg * RPW, c0 = 512 * cq + 8 * w.lane, hd = c0 >> 6;
        const f32x4 w0 = *(const f32x4*)(in.ln_w + c0), w1 = *(const f32x4*)(in.ln_w + c0 + 4), b0 = *(const f32x4*)(in.ln_b + c0), b1 = *(const f32x4*)(in.ln_b + c0 + 4);
        const float lw8[8] = {w0.x, w0.y, w0.z, w0.w, w1.x, w1.y, w1.z, w1.w}, lb8[8] = {b0.x, b0.y, b0.z, b0.w, b1.x, b1.y, b1.z, b1.w};
#pragma unroll 4
        for (int rr = 0; rr < RPW; ++rr) { const int m = m0 + rr; const size_t off = (size_t)m * DM + c0;
            const u32x4 ov = *(const u32x4*)(in.Ob + off), vv = *(const u32x4*)(in.Vb + off), gv = *(const u32x4*)(in.Gb + off);
            const float bon = in.bonus[(size_t)m * WH + hd];
            float o[8] = {bflo(ov.x), bfhi(ov.x), bflo(ov.y), bfhi(ov.y), bflo(ov.z), bfhi(ov.z), bflo(ov.w), bfhi(ov.w)};
            const float vf[8] = {bflo(vv.x), bfhi(vv.x), bflo(vv.y), bfhi(vv.y), bflo(vv.z), bfhi(vv.z), bflo(vv.w), bfhi(vv.w)};
            const float gf[8] = {bflo(gv.x), bfhi(gv.x), bflo(gv.y), bfhi(gv.y), bflo(gv.z), bfhi(gv.z), bflo(gv.w), bfhi(gv.w)};
            float s1 = 0.f;
#pragma unroll
            for (int e = 0; e < 8; ++e) s1 += o[e];
            const float mean = sum8_dpp(s1) * (1.f / 64.f); float s2 = 0.f;
#pragma unroll
            for (int e = 0; e < 8; ++e) { o[e] -= mean; s2 += o[e] * o[e]; }
            const float rs = 1.f / sqrtf(sum8_dpp(s2) * (1.f / 64.f) + 64e-5f);
#pragma unroll
            for (int e = 0; e < 8; ++e) o[e] = (o[e] * rs * lw8[e] + lb8[e] + bon * vf[e]) * gf[e];
            u32x4 r; r.x = pk2(o[0], o[1]); r.y = pk2(o[2], o[3]); r.z = pk2(o[4], o[5]); r.w = pk2(o[6], o[7]); *(u32x4*)(Odst + off) = r; }
    }
}
DI void rwkv_phi(const WG& w, const RwkvIn& in, int k, unsigned char* seg0, unsigned char* seg1, unsigned char* sbuf, const float* st_in, float* outP, float* outS, int dup, gu32* qctr, volatile LAS unsigned* qw) {
    if (k >= 1 && w.bid < 64) {
        const int sg = k - 1, hd = w.bid >> 1, vh = w.bid & 1; const unsigned char* sb = (sg & 1) ? seg1 : seg0; float* st = outP + (size_t)hd * 4096;
        rwkv_scan_prompt(w, sb + (size_t)hd * REC, (size_t)WH * REC, WSEG, hd, vh, 64 * WSEG * sg, sg == 0 ? nullptr : st, st, in.Ob, dup);
    }
    {
        const int nseg = (k < WNSEG) ? WSEG * WH : 0, nsmp = (k == 1 || k == 2) ? 512 : 0, lo = (k - 1) * 512, ntot = nseg + nsmp;
        unsigned char* sb = (k & 1) ? seg1 : seg0;
#define PAIR_OF(q, cvar, hvar, rvar) { if ((q) < nseg) { cvar = WSEG * k + ((q) >> 5); hvar = (q) & 31; rvar = sb + (size_t)(q) * REC; } else { const int p_ = lo + (q) - nseg; cvar = NCHP + (p_ >> 5); hvar = p_ & 31; rvar = sbuf + (size_t)p_ * REC; } }
#define Q_FETCH(var) { if (w.tid == 0) qw[0] = __hip_atomic_fetch_add(qctr, 1u, __ATOMIC_RELAXED, __HIP_MEMORY_SCOPE_AGENT); LDS_BARRIER(); var = (int)qw[0]; LDS_BARRIER(); }
        if (ntot > 0) {
            PrepRaw cur, nxt; int q, qn; Q_FETCH(q) Q_FETCH(qn)
            if (q < ntot) { int c0, h0; unsigned char* r0; PAIR_OF(q, c0, h0, r0) (void)r0; prep_load(w, in, c0, h0, cur); }
#pragma unroll 1
            while (q < ntot) { int cc_, hh_; unsigned char* rr_; PAIR_OF(q, cc_, hh_, rr_)
                if (qn < ntot) { int c1, h1; unsigned char* r1; PAIR_OF(qn, c1, h1, r1) (void)r1; prep_load(w, in, c1, h1, nxt); }
                rwkv_prep_pair(w, in, cc_, hh_, rr_, cur, qctr, qw);
                const int q2 = (int)qw[0];
                cur = nxt; q = qn; qn = q2; }
        }
#undef Q_FETCH
#undef PAIR_OF
    }
    if (k == 3) { const int nb = w.G, b0 = w.bid;
        for (int id = b0 * 8 + w.wave; id < DBATCH * WH * 2; id += nb * 8) { const int p = id >> 1, vh = id & 1, b = p >> 5, hd = p & 31;
            rwkv_scan_task(w.lane, sbuf + (size_t)p * REC, 0, 1, hd, vh, MP + 64 * b, st_in + (size_t)p * 4096, outS + (size_t)p * 4096, in.Ob, dup); } }
    if (k == WNSEG && w.bid >= 64 && !dup) rwkv_final_phase<true>(w, in, in.Ob, (w.bid - 64) * 8 + w.wave, (w.G - 64) * 8);
}
constexpr size_t MiB = (size_t)1 << 20;
constexpr size_t WS_CTL = 0, CTL_ZERO_BYTES = 1 * MiB;
constexpr size_t WS_WUP = 1 * MiB, WS_WDN = 33 * MiB, WS_WMIX = 65 * MiB, WS_H = 129 * MiB, WS_BIG = 201 * MiB, WS_SS = WS_BIG + 777 * MiB, WS_END = WS_SS + 23 * MiB;
constexpr size_t U72 = 72 * MiB;
constexpr int CW_BAR = 4096, CW_QUEUE = 16384, CW_SPLIT = 65536;
constexpr int LDS_BYTES = 163840, LDSCTL_OFF = LDS_BYTES - 512, MISC_OFF = LDSCTL_OFF + 320;
constexpr int NPHASE = 36;

constexpr size_t O_Y = 0, O_KP = (size_t)M * DM, O_VP = O_KP + 65536, O_KS = O_VP + 65536, O_VS = O_KS + 2097152, O_RP = O_VS + 2097152, O_RS = O_RP + 1048576,
                 O_WP = O_RS + 33554432, O_WS = O_WP + 131072, O_SHP = O_WS + 4194304, O_SHS = O_SHP + 2048, O_END = O_SHS + 65536;

struct Args { const float* in[34]; float* out; unsigned char* ws; int ph_lo, ph_hi, dup, pad; };

DI void up_convert(const WG& w, const Args& a, int layer, int b0, int nb) { convert_w(w, a.in[32] + (size_t)layer * DM * DFF, DM, DFF, (bf16_t*)(a.ws + WS_WUP), DM, DFF, a.in[8] + (size_t)layer * DM, b0, nb); }
DI void dn_convert(const WG& w, const Args& a, int layer, int b0, int nb) { convert_w(w, a.in[33] + (size_t)layer * DFF * DM, DFF, DM, (bf16_t*)(a.ws + WS_WDN), DFF, DM, nullptr, b0, nb); }
DI void attn_convert(const WG& w, const Args& a, int j, int layer, int b0, int nb) {
    convert_w(w, a.in[10] + (size_t)j * DM * AQKV, DM, AQKV, (bf16_t*)(a.ws + WS_WMIX), DM, AQKV, a.in[7] + (size_t)layer * DM, b0, nb);
    convert_w(w, a.in[12] + (size_t)j * DM * DM, DM, DM, (bf16_t*)(a.ws + WS_WMIX + 10 * MiB), DM, DM, nullptr, b0, nb);
}
DI void ret_convert(const WG& w, const Args& a, int b0, int nb) {
    convert_w(w, a.in[13], DM, RIN, (bf16_t*)(a.ws + WS_WMIX), DM, RIN, a.in[7] + 1 * DM, b0, nb); convert_w(w, a.in[15], RVD, DM, (bf16_t*)(a.ws + WS_WMIX + 48 * MiB), RVD, DM, nullptr, b0, nb);
}
DI void rwkv_convert(const WG& w, const Args& a, int b0, int nb) {
    unsigned char* WMIX = a.ws + WS_WMIX;
#pragma unroll 1
    for (int z = 0; z < 3; ++z) convert_w(w, a.in[17] + (size_t)z * DM * DM, DM, DM, (bf16_t*)(WMIX + (size_t)z * 8 * MiB), DM, DM, nullptr, b0, nb);
    convert_w(w, a.in[18], DM, DM, (bf16_t*)(WMIX + 24 * MiB), DM, DM, nullptr, b0, nb);
    convert_w(w, a.in[20], DM, 96, (bf16_t*)(WMIX + 32 * MiB), DM, 256, nullptr, b0, nb); convert_w(w, a.in[23], DM, 96, (bf16_t*)(WMIX + 33 * MiB), DM, 256, nullptr, b0, nb); convert_w(w, a.in[25], DM, 256, (bf16_t*)(WMIX + 34 * MiB), DM, 256, nullptr, b0, nb);
    convert_w(w, a.in[21], 96, DM, (bf16_t*)(WMIX + 35 * MiB), 256, DM, nullptr, b0, nb); convert_w(w, a.in[24], 96, DM, (bf16_t*)(WMIX + 36 * MiB), 256, DM, nullptr, b0, nb); convert_w(w, a.in[26], 256, DM, (bf16_t*)(WMIX + 37 * MiB), 256, DM, nullptr, b0, nb);
}

__global__ void __launch_bounds__(512, 2) fwd_kernel(Args args) {
    extern __shared__ __attribute__((aligned(16))) unsigned char lds_raw[];
    WG w; w.lds = (LAS unsigned char*)lds_raw; w.tid = threadIdx.x; w.lane = w.tid & 63; w.wave = __builtin_amdgcn_readfirstlane(w.tid >> 6);
    w.G = gridDim.x; w.bid = blockIdx.x; w.gw = w.bid * 8 + w.wave; w.ngw = w.G * 8;
    volatile LAS unsigned* MISC = (volatile LAS unsigned*)(w.lds + MISC_OFF);
    for (int u = w.tid; u < (LDS_BYTES - LDSCTL_OFF) / 4; u += 512) ((LAS unsigned*)(w.lds + LDSCTL_OFF))[u] = 0u;
    __syncthreads();
    unsigned char* ws = args.ws; gu32* ctl = (gu32*)(ws + WS_CTL);
    XcdBarrier bar; bar.bar = (unsigned*)(ctl + CW_BAR); bar.x = 0; bar.st = nullptr;
#if !MK_PER_PHASE
    bar = xcd_barrier_post((unsigned*)(ctl + CW_BAR), MISC + 8, w.wave);
#endif
    const int lo = args.ph_lo, hi = args.ph_hi;
    bf16_t* XBO = args.dup ? (bf16_t*)(ws + WS_BIG + 432 * MiB) : (bf16_t*)(ws + WS_H); const size_t ssd = args.dup ? ((WS_BIG + 504 * MiB) - WS_SS) / 4 : 0;
    bf16_t* XB = (bf16_t*)(ws + WS_H);
    float* SS = (float*)(ws + WS_SS);
    bf16_t* WUP = (bf16_t*)(ws + WS_WUP); bf16_t* WDN = (bf16_t*)(ws + WS_WDN); unsigned char* WMIX = ws + WS_WMIX; unsigned char* BIG = ws + WS_BIG;
    const float* norm_mix = args.in[7];
    int ph = 0;
#if MK_PER_PHASE
#define SEAM() do { } while (0)
#else
#define SEAM() xcd_barrier(bar, w.wave)
#endif
#define PH_BEGIN if (ph >= lo && ph < hi) { { const int l_ = lane_now(); w.lane = l_; w.tid = w.wave * 64 + l_; }
#define PH_END   if (ph + 1 < hi) SEAM(); } ++ph;
#define GEMM_LDS ((PG8_LAS unsigned char*)w.lds)
#define SSQ(s) (SS + (size_t)(s) * M * 32)
#define RSTAB ((const LAS float*)(w.lds + pg8::RSTAB_OFF))
#define SK_SLAB ((float*)(BIG + 300 * MiB))
#define SK_CNT ((unsigned*)(ctl + CW_SPLIT + (size_t)(ph * 16 + (args.dup & 15)) * 256))
#define SK_SETUP if (w.tid == 0) { volatile LAS unsigned long long* skp_ = (volatile LAS unsigned long long*)(w.lds + pg8::SK_LDS_OFF); skp_[0] = (unsigned long long)SK_SLAB; }
#define GEMM_RESID_SK(Aexpr, Wexpr, Kdim, ssq_, nsl_) { pg8::Gemm g{Aexpr, Wexpr, M, DM, Kdim, 0, 0}; pg8::Order S; S.init_full_rounds(M, DM, w.G, w.bid); pg8::EpiResid E{nullptr, nullptr, XBO, ssq_}; pg8::gemm_phase<pg8::EpiResid>(GEMM_LDS, g, S, E, w.wave); \
        pg8::OrderSK S2; S2.init(M, DM, w.G, w.bid, nsl_); pg8::Unit u2; if (!(args.dup & 32) && S2.next(0, u2, (Kdim) / 64)) { SK_SETUP const int st_ = w.bid % (w.G >> 2), ks_ = w.bid / (w.G >> 2); pg8::EpiSlab E2{(const LAS unsigned*)(w.lds + pg8::SK_LDS_OFF), st_ * 4 + ks_}; \
            pg8::gemm_phase<pg8::EpiSlab, true, true, true, pg8::OrderSK>(GEMM_LDS, g, S2, E2, w.wave); pg8::sk_reduce(w.lds, SK_SLAB, SK_CNT, u2, st_, ks_, nsl_, XBO, ssq_, w.wave); } }
#define TAIL_SK 192
#define TAIL_B0 64
#define MLP_PHASES(s_in, nsl_, tail_stmt) \
    PH_BEGIN { pg8::Gemm g{XB, WUP, M, DFF, DM, 0, 0}; pg8::Order S; S.init(M, DFF, 1, w.G, w.bid); pg8::fill_rs_table(w.lds, S, SSQ(s_in), w.tid); pg8::EpiRelu2 E{(bf16_t*)BIG, DFF, RSTAB}; pg8::gemm_phase<pg8::EpiRelu2>(GEMM_LDS, g, S, E, w.wave); } PH_END \
    PH_BEGIN { GEMM_RESID_SK((bf16_t*)BIG, WDN, DFF, SSQ((s_in) + 1) + ssd, nsl_) if (!(args.dup & 16)) { tail_stmt } } PH_END
#define ATTN_PHASES(j, resP_, resS_, s_in, tail_stmt) { \
    bf16_t* Qb = (bf16_t*)BIG; bf16_t* Kb = (bf16_t*)(BIG + 72 * MiB); bf16_t* Vb = (bf16_t*)(BIG + 81 * MiB); bf16_t* AO = (bf16_t*)(BIG + 90 * MiB); \
    const float* ck = args.in[2] + (size_t)(j) * 1048576; const float* cv = args.in[3] + (size_t)(j) * 1048576; \
    float* kS = args.out + O_KS + (size_t)(j) * 1048576; float* vS = args.out + O_VS + (size_t)(j) * 1048576; \
    PH_BEGIN { pg8::Gemm g{XB, (bf16_t*)WMIX, M, AQKV, DM, 0, 0}; pg8::Order S; S.init(M, AQKV, 1, w.G, w.bid); pg8::fill_rs_table(w.lds, S, SSQ(s_in), w.tid); pg8::EpiAttnQKV E{Qb, args.out, O_KP + (size_t)(j) * 32768, O_KS + (size_t)(j) * 1048576, RSTAB}; pg8::gemm_phase<pg8::EpiAttnQKV>(GEMM_LDS, g, S, E, w.wave); } PH_END \
    PH_BEGIN attn_phase(w, Qb, Kb, Vb, ck, cv, args.in[11] + (j) * AH, AO); cache_shift(w, ck, cv, kS, vS); PH_END \
    PH_BEGIN { pg8::Gemm g{AO, (bf16_t*)(WMIX + 10 * MiB), M, DM, DM, 0, 0}; pg8::Order S; S.init(M, DM, 1, w.G, w.bid); pg8::EpiResid E{resP_, resS_, XBO, SSQ((s_in) + 1) + ssd}; pg8::gemm_phase<pg8::EpiResid>(GEMM_LDS, g, S, E, w.wave); tail_stmt } PH_END }

    PH_BEGIN rows0(w, args.in[0], args.in[1], XB, SSQ(0)); attn_convert(w, args, 0, 0, 0, 0); up_convert(w, args, 0, 0, 0); PH_END
    ATTN_PHASES(0, args.in[0], args.in[1], 0, dn_convert(w, args, 0, TAIL_B0, w.G - TAIL_B0);)
    MLP_PHASES(1, 3, ret_convert(w, args, TAIL_SK, w.G - TAIL_SK); up_convert(w, args, 1, TAIL_SK, w.G - TAIL_SK);)
    {
        bf16_t* P = (bf16_t*)BIG; bf16_t* RO = (bf16_t*)(BIG + 432 * MiB);
        PH_BEGIN { pg8::Gemm g{XB, (bf16_t*)WMIX, M, RIN, DM, 0, 0}; pg8::Order S; S.init(M, RIN, 1, w.G, w.bid); pg8::fill_rs_table(w.lds, S, SSQ(2), w.tid); pg8::EpiRetProj E{P, RSTAB}; pg8::gemm_phase<pg8::EpiRetProj>(GEMM_LDS, g, S, E, w.wave); } PH_END
        bf16_t* slots = (bf16_t*)(BIG + 576 * MiB);
        PH_BEGIN ret_chain_phase<0>(w, P, RO, args.in[4], slots, args.out + O_RS, 0); PH_END
        PH_BEGIN ret_prefix_phase(w, slots, args.out + O_RP); PH_END
        PH_BEGIN ret_chain_phase<1>(w, P, RO, args.in[4], slots, args.out + O_RS, args.dup); PH_END
        PH_BEGIN ret_gn_phase(w, P, RO, args.in[14], args.dup ? (bf16_t*)(BIG + 576 * MiB) : RO); PH_END
        PH_BEGIN { GEMM_RESID_SK(RO, (bf16_t*)(WMIX + 48 * MiB), RVD, SSQ(3) + ssd, 3) dn_convert(w, args, 1, TAIL_SK, w.G - TAIL_SK); } PH_END
    }
    MLP_PHASES(3, 3, rwkv_convert(w, args, TAIL_SK, w.G - TAIL_SK); up_convert(w, args, 2, TAIL_SK, w.G - TAIL_SK);)
    {
        bf16_t* XL = (bf16_t*)BIG; bf16_t* Rb = (bf16_t*)(BIG + 432 * MiB); bf16_t* L1 = (bf16_t*)(BIG + 648 * MiB);
        float* LW = (float*)BIG; bf16_t* Ab = (bf16_t*)(BIG + 144 * MiB); bf16_t* Gb = (bf16_t*)(BIG + 216 * MiB);
        unsigned char* seg0 = BIG + 288 * MiB; unsigned char* seg1 = BIG + 345 * MiB; float* bonus = (float*)(BIG + 402 * MiB); unsigned char* sbuf = BIG + 648 * MiB;
        bf16_t* Ob = (bf16_t*)(BIG + 705 * MiB);
        RwkvIn rin{Rb, Rb + (size_t)M * DM, Rb + (size_t)2 * M * DM, Ab, Gb, LW, args.in[27], args.in[28], args.in[29], args.in[30], args.in[31], bonus, Ob};
        PH_BEGIN lerp_rows(w, XB, SSQ(4), norm_mix + 2 * DM, args.in[6], args.in[16], XL, args.out + O_SHP, args.out + O_SHS); PH_END
        PH_BEGIN { { pg8::Gemm g{XL, (bf16_t*)WMIX, M, DM, DM, U72, 8 * MiB}; pg8::Order S; S.init(M, DM, 3, w.G, w.bid); pg8::EpiAct E{Rb, DM, (size_t)M * DM, 0, (const LAS float*)nullptr}; pg8::gemm_phase<pg8::EpiAct>(GEMM_LDS, g, S, E, w.wave); }
                   { pg8::Gemm g{XL + (size_t)3 * M * DM, (bf16_t*)(WMIX + 32 * MiB), M, 256, DM, U72, 1 * MiB}; pg8::Order S; S.init(M, 256, 3, w.G, w.bid); pg8::EpiAct E{L1, 256, (size_t)M * 256, 2 | (0 << 4) | (3 << 8), (const LAS float*)nullptr}; pg8::gemm_phase<pg8::EpiAct>(GEMM_LDS, g, S, E, w.wave); } } PH_END
        PH_BEGIN { int k2 = 256; asm volatile("" : "+s"(k2));     pg8::Gemm g{L1, (bf16_t*)(WMIX + 35 * MiB), M, DM, k2, (size_t)M * 256 * 2, 1 * MiB}; pg8::Order S; S.init(M, DM, 3, w.G, w.bid); pg8::EpiRwkv2 E{LW, Ab, args.in[19], args.in[22]}; pg8::gemm_phase<pg8::EpiRwkv2>(GEMM_LDS, g, S, E, w.wave); } PH_END
#pragma unroll 1
        for (int k = 0; k < 9; ++k) { PH_BEGIN rwkv_phi(w, rin, k, seg0, seg1, sbuf, args.in[5], args.out + O_WP, args.out + O_WS, args.dup, ctl + CW_QUEUE + 64 * (k + 16 * (args.dup & 15)), MISC + 16); PH_END }
        PH_BEGIN rwkv_final_phase<false>(w, rin, args.dup ? (bf16_t*)(BIG + 576 * MiB) : Ob, w.gw, w.ngw); PH_END
        PH_BEGIN { pg8::Gemm g{Ob, (bf16_t*)(WMIX + 24 * MiB), M, DM, DM, 0, 0}; pg8::Order S; S.init(M, DM, 1, w.G, w.bid); pg8::EpiResid E{nullptr, nullptr, XBO, SSQ(5) + ssd}; pg8::gemm_phase<pg8::EpiResid>(GEMM_LDS, g, S, E, w.wave); dn_convert(w, args, 2, TAIL_B0, w.G - TAIL_B0); } PH_END
    }
    MLP_PHASES(5, 3, attn_convert(w, args, 1, 3, TAIL_SK, w.G - TAIL_SK); up_convert(w, args, 3, TAIL_SK, w.G - TAIL_SK);)
    ATTN_PHASES(1, (const float*)nullptr, (const float*)nullptr, 6, dn_convert(w, args, 3, TAIL_B0, w.G - TAIL_B0);)
    PH_BEGIN { pg8::Gemm g{XB, WUP, M, DFF, DM, 0, 0}; pg8::Order S; S.init(M, DFF, 1, w.G, w.bid); pg8::fill_rs_table(w.lds, S, SSQ(7), w.tid); pg8::EpiRelu2 E{(bf16_t*)BIG, DFF, RSTAB}; pg8::gemm_phase<pg8::EpiRelu2>(GEMM_LDS, g, S, E, w.wave); } PH_END
    PH_BEGIN { GEMM_RESID_SK((bf16_t*)BIG, WDN, DFF, SSQ(8) + ssd, 4) } PH_END
    PH_BEGIN final_norm(w, XB, SSQ(8), args.in[9], args.out); PH_END
}

extern "C" void kernel_launch(void* const* d_in, const int* in_sizes, int n_in, void* d_out, int out_size, void* d_ws, size_t ws_size, hipStream_t stream) {
    static int grid = 0;
    if (grid == 0) {
        if (n_in != 34 || (size_t)out_size != O_END || ws_size < WS_END) { fprintf(stderr, "kernel_launch: unexpected shapes: n_in %d out %d ws %zu (need %zu)\n", n_in, out_size, ws_size, (size_t)WS_END); grid = -1; return; }
        int dev = 0, cus = 0;
        if (hipGetDevice(&dev) != hipSuccess || hipDeviceGetAttribute(&cus, hipDeviceAttributeMultiprocessorCount, dev) != hipSuccess) { grid = -1; return; }
        if (hipFuncSetAttribute((const void*)fwd_kernel, hipFuncAttributeMaxDynamicSharedMemorySize, LDS_BYTES) != hipSuccess) { fprintf(stderr, "kernel_launch: hipFuncSetAttribute failed\n"); grid = -1; return; }
        int per_cu = 0;
        if (hipOccupancyMaxActiveBlocksPerMultiprocessor(&per_cu, (const void*)fwd_kernel, 512, LDS_BYTES) != hipSuccess || per_cu < 1) { fprintf(stderr, "kernel_launch: occupancy query reports %d\n", per_cu); }
        (void)hipGetLastError();
        grid = cus;
    }
    if (grid < 0) return;
    (void)hipMemsetAsync((char*)d_ws + WS_CTL, 0, CTL_ZERO_BYTES, stream);
    Args a{};
    for (int i = 0; i < 34; ++i) a.in[i] = (const float*)d_in[i];
    a.out = (float*)d_out; a.ws = (unsigned char*)d_ws;
#if MK_PER_PHASE
    static const unsigned char REP[NPHASE] = { 1 };
    for (int p = 0; p < NPHASE; ++p) for (int r = 0; r < REP[p]; ++r) { a.ph_lo = p; a.ph_hi = p + 1; a.dup = (r == 0) ? 0 : 1; hipLaunchKernelGGL(fwd_kernel, dim3(grid), dim3(512), LDS_BYTES, stream, a); }
#else
    a.ph_lo = 0; a.ph_hi = NPHASE;
    hipLaunchKernelGGL(fwd_kernel, dim3(grid), dim3(512), LDS_BYTES, stream, a);
#endif
}
```

```cpp
#include <hip/hip_runtime.h>
#include <cstdio>
#include <cstdint>

#ifndef MK_PER_PHASE
#define MK_PER_PHASE 0
#endif

#define GAS __attribute__((address_space(1)))
#define LAS __attribute__((address_space(3)))
#define DI __device__ __forceinline__
typedef unsigned short bf16_t;
typedef short bf16x8 __attribute__((ext_vector_type(8)));
typedef short s16x4 __attribute__((ext_vector_type(4)));
typedef float f32x2 __attribute__((ext_vector_type(2)));
typedef float f32x4 __attribute__((ext_vector_type(4)));
typedef float f32x16 __attribute__((ext_vector_type(16)));
typedef unsigned u32x2 __attribute__((ext_vector_type(2)));
typedef unsigned u32x4 __attribute__((ext_vector_type(4)));
typedef __bf16 bf16x2_t __attribute__((ext_vector_type(2)));
typedef GAS unsigned gu32;

DI unsigned pk2(float lo, float hi) { f32x2 v = {lo, hi}; bf16x2_t b = __builtin_convertvector(v, bf16x2_t); return __builtin_bit_cast(unsigned, b); }
DI float bf2f(unsigned short u) { return __builtin_bit_cast(float, (unsigned)u << 16); }
DI float bflo(unsigned u) { return __builtin_bit_cast(float, u << 16); }
DI float bfhi(unsigned u) { return __builtin_bit_cast(float, u & 0xffff0000u); }
DI unsigned short f2bf(float f) { return (unsigned short)(pk2(f, 0.f) & 0xffffu); }
DI float wave_sum(float v) {
#pragma unroll
    for (int o = 1; o < 64; o <<= 1) v += __shfl_xor(v, o);
    return v;
}
DI float wave_sum_fast(float v) {
#define DPP_ADD_(ctrl) v += __builtin_bit_cast(float, __builtin_amdgcn_update_dpp(0, __builtin_bit_cast(int, v), ctrl, 0xf, 0xf, true));
    DPP_ADD_(0xB1) DPP_ADD_(0x4E) DPP_ADD_(0x141) DPP_ADD_(0x140)
#undef DPP_ADD_
    const int iv = __builtin_bit_cast(int, v);
    return (__builtin_bit_cast(float, __builtin_amdgcn_readlane(iv, 0)) + __builtin_bit_cast(float, __builtin_amdgcn_readlane(iv, 16))) + (__builtin_bit_cast(float, __builtin_amdgcn_readlane(iv, 32)) + __builtin_bit_cast(float, __builtin_amdgcn_readlane(iv, 48)));
}
DI float wave_max(float v) {
#pragma unroll
    for (int o = 1; o < 64; o <<= 1) v = fmaxf(v, __shfl_xor(v, o));
    return v;
}
DI void st16_wt(void* p, u32x4 v) { asm volatile("global_store_dwordx4 %0, %1, off sc1\n\ts_nop 1" :: "v"(p), "v"(v) : "memory"); }
DI void st8_wt(void* p, u32x2 v) { asm volatile("global_store_dwordx2 %0, %1, off sc1\n\ts_nop 1" :: "v"(p), "v"(v) : "memory"); }
DI int lane_now() { int l_; asm volatile("v_mbcnt_lo_u32_b32 %0, -1, 0\n\tv_mbcnt_hi_u32_b32 %0, -1, %0" : "=v"(l_)); return l_; }
#define MFMA32(a, b, c) __builtin_amdgcn_mfma_f32_32x32x16_bf16((a), (b), (c), 0, 0, 0)
#define LDS_WAIT() asm volatile("s_waitcnt lgkmcnt(0)" ::: "memory")
#define VM_WAIT() asm volatile("s_waitcnt vmcnt(0)" ::: "memory")
#define LDS_BARRIER() asm volatile("s_waitcnt lgkmcnt(0)\n\ts_barrier" ::: "memory")

constexpr int DM = 2048, SEQ = 16384, DBATCH = 32, DSEQ = 64, PAST = 4096;
constexpr int MP = SEQ, MS = DBATCH * DSEQ, M = MP + MS;
constexpr int NCHP = SEQ / 64, NCH = M / 64;
constexpr int DFF = 8192;
constexpr int AH = 32, AKV = 4, AHD = 64, AQKV = 2560, AWIN = 128;
constexpr int RH = 8, RDK = 256, RDV = 512, RIN = 12288, RVD = RH * RDV;
constexpr int WH = 32, WN = 64;
constexpr float NORM_EPS = 1e-5f;

namespace pg8 {
#define PG8_LAS __attribute__((address_space(3)))
#define PG8_GAS __attribute__((address_space(1)))
constexpr int BM = 256, BK = 64, HALF = 128, HTB = HALF * BK * 2  , STAGE_BYTES = 8 * HTB, NXCD = 8, WGM = 8;
__host__ __device__ __forceinline__ int lds_byte(int r, int c) { const int st = (r >> 4) * 2 + (c >> 5), rr = r & 15, cc = c & 31, ob = rr * 64 + cc * 2; return st * 1024 + (ob ^ (((ob >> 9) & 1) << 5)); }
__host__ __device__ __forceinline__ void stage_rc(int b, int& R, int& C) { const int st = b / 1024, sb = b % 1024, swz = sb ^ (((sb >> 9) & 1) << 5); R = (st >> 1) * 16 + swz / 64; C = (st & 1) * 32 + (swz % 64) / 2; }
__host__ __device__ __forceinline__ int perm32(int rho) { const int n = rho >> 4, i = rho & 15; return 8 * (i >> 2) + 4 * n + (i & 3); }

struct Unit { int pm, pn, z, i, ks, k0, nk; };
struct Gemm { const bf16_t* A; const bf16_t* Bt; int M, N, K; size_t zA, zB; };
constexpr int SK_LDS_OFF = 163840 - 512 + 320 + 96;

struct Order {
    int nM, nN, nz, per, G, c; long tot;
    __device__ __forceinline__ void init(int M, int N, int nz_, int G_, int c_) { nM = M / BM; nN = N / BM; nz = nz_; per = nM * nN; G = G_; c = c_; tot = (long)per * nz; }
    __device__ __forceinline__ bool split_ok() const { const int rem = per % G; return nz == 1 && rem > 0 && rem * 4 == G; }
    __device__ __forceinline__ void init_full_rounds(int M, int N, int G_, int c_) { init(M, N, 1, G_, c_); if (split_ok()) tot = (long)(per / G) * G; }
    __device__ __forceinline__ void map(long L, Unit& u) const {
        u.z = (int)(L / per); int wgid = (int)(L % per);
        { const int q = per / NXCD, r = per % NXCD, xcd = wgid % NXCD, off = wgid / NXCD; wgid = (xcd < r ? xcd * (q + 1) : r * (q + 1) + (xcd - r) * q) + off; }
        const int nig = WGM * nN, gid = wgid / nig, fm = gid * WGM, gsz = (nM - fm) < WGM ? (nM - fm) : WGM;
        u.pm = fm + ((wgid % nig) % gsz); u.pn = (wgid % nig) / gsz;
    }
    __device__ __forceinline__ bool next(int i, Unit& u) const {
        const long L = (long)i * G + c; if (L >= tot) return false;
        u.i = i; u.ks = 0; map(L, u); return true;
    }
};
struct OrderSK {
    Order o; int G, c, nsl;
    __device__ __forceinline__ void init(int M, int N, int G_, int c_, int nsl_) { o.init(M, N, 1, G_, c_); G = G_; c = c_; nsl = nsl_; }
    __device__ __forceinline__ bool next(int i, Unit& u, int nt_all) const {
        const int rem = G >> 2;
        if (i != 0 || !o.split_ok() || c >= rem * nsl) return false;
        u.i = o.per / G; u.ks = c / rem; o.map((long)u.i * G + c % rem, u);
        const int it = nt_all >> 1, b0 = (it * u.ks + nsl - 1) / nsl, b1 = (it * (u.ks + 1) + nsl - 1) / nsl; u.k0 = 2 * b0; u.nk = 2 * (b1 - b0); return true;
    }
    __device__ __forceinline__ bool next(int i, Unit& u) const { return false; }
};
template <class Epi, bool ALIGN_EPI = true, bool SP2 = true, bool SPLITK = false, class Ord = Order>
__device__ __forceinline__ void gemm_phase(PG8_LAS unsigned char* lds, const Gemm g, const Ord& S, const Epi& E, int wave_id) {
    const int wid = wave_id, lane = lane_now(), tid = wid * 64 + lane, wr = wid >> 2, wc = wid & 3, fr = lane & 15, fq = lane >> 4;
    const int K = g.K; int nt = K / BK;
    unsigned voffA[2], voffB[2];
#pragma unroll
    for (int i = 0; i < 2; ++i) { int R, C; stage_rc(tid * 16 + i * 8192, R, C); const int Rb = Epi::PERM ? ((R & ~31) + perm32(R & 31)) : R;
        voffA[i] = (unsigned)(R * K + C) * 2u; voffB[i] = (unsigned)(Rb * K + C) * 2u; }
    const size_t kstep = (size_t)(BK * 2);
    const size_t hstep = (size_t)HALF * K * 2;
    const size_t tstep = 2 * hstep;
    const unsigned ldsw = (unsigned)wid * 1024u;
    const int aoff = lds_byte(wr * 64 + fr, fq * 8), boff = lds_byte(wc * 32 + fr, fq * 8);
#define PG8_SA(b, h) (((b) * 2 + (h)) * HTB)
#define PG8_SB(b, h) ((4 + (b) * 2 + (h)) * HTB)
#define PG8_STAGE(bufoff, gbase, voff) do { _Pragma("unroll") for (int _i = 0; _i < 2; ++_i) \
        __builtin_amdgcn_global_load_lds((const unsigned*)((const char*)(gbase) + (voff)[_i]), (PG8_LAS unsigned*)(lds + (bufoff) + ldsw + _i * 8192), 16, 0, 0); } while (0)
#define PG8_LDA(dst, b, h) do { _Pragma("unroll") for (int m = 0; m < 4; ++m) _Pragma("unroll") for (int k = 0; k < 2; ++k) dst[m][k] = *(const PG8_LAS bf16x8*)(lds + PG8_SA(b, h) + aoff + m * 2048 + k * 1024); } while (0)
#define PG8_LDB(dst, b, h) do { _Pragma("unroll") for (int n = 0; n < 2; ++n) _Pragma("unroll") for (int k = 0; k < 2; ++k) dst[n][k] = *(const PG8_LAS bf16x8*)(lds + PG8_SB(b, h) + boff + n * 2048 + k * 1024); } while (0)
#define PG8_MMA(ai, bj, At, Bt) do { __builtin_amdgcn_s_setprio(1); _Pragma("unroll") for (int m = 0; m < 4; ++m) _Pragma("unroll") for (int n = 0; n < 2; ++n) _Pragma("unroll") for (int k = 0; k < 2; ++k) \
        acc[ai][bj][m][n] = __builtin_amdgcn_mfma_f32_16x16x32_bf16(Bt[n][k], At[m][k], acc[ai][bj][m][n], 0, 0, 0); __builtin_amdgcn_s_setprio(0); } while (0)
#define PG8_WAIT_V(n) asm volatile("s_waitcnt vmcnt(" #n ")" ::: "memory")
#define PG8_WAIT_L(n) asm volatile("s_waitcnt lgkmcnt(" #n ")" ::: "memory")
#define PG8_BAR __builtin_amdgcn_s_barrier()
#define PG8_SCHED __builtin_amdgcn_sched_barrier(0)
    Unit cur, nxt; int ui = 0;
    if constexpr (SPLITK) { if (!S.next(0, cur, nt)) return; nt = cur.nk; asm volatile("" : "+s"(nt)); }
    else { if (!S.next(0, cur)) return; }
    f32x4 acc[2][2][4][2];
#pragma unroll
    for (int a = 0; a < 2; ++a)
#pragma unroll
        for (int b = 0; b < 2; ++b)
#pragma unroll
            for (int m = 0; m < 4; ++m)
#pragma unroll
                for (int n = 0; n < 2; ++n) acc[a][b][m][n] = (f32x4){0.f, 0.f, 0.f, 0.f};
    bf16x8 At[4][2], B0[2][2], B1[2][2];
#define PG8_KOFF(u) (SPLITK ? (size_t)(u).k0 * kstep : (size_t)0)
    const char* cA = (const char*)g.A + (size_t)cur.z * g.zA + (size_t)cur.pm * tstep + PG8_KOFF(cur); const char* cB = (const char*)g.Bt + (size_t)cur.z * g.zB + (size_t)cur.pn * tstep + PG8_KOFF(cur);
    if constexpr (SP2) {
        PG8_STAGE(PG8_SB(0, 0), cB, voffB); PG8_STAGE(PG8_SB(0, 1), cB + hstep, voffB); PG8_STAGE(PG8_SA(0, 0), cA, voffA); PG8_STAGE(PG8_SA(0, 1), cA + hstep, voffA);
        if (wr == 1) PG8_BAR;
        PG8_WAIT_V(2); PG8_BAR;
        PG8_STAGE(PG8_SB(1, 0), cB + kstep, voffB); PG8_STAGE(PG8_SA(1, 0), cA + kstep, voffA); PG8_STAGE(PG8_SB(1, 1), cB + hstep + kstep, voffB);
        PG8_WAIT_V(6); PG8_BAR;
    } else {
        PG8_STAGE(PG8_SB(0, 0), cB, voffB); PG8_STAGE(PG8_SA(0, 0), cA, voffA); PG8_STAGE(PG8_SB(0, 1), cB + hstep, voffB); PG8_STAGE(PG8_SA(0, 1), cA + hstep, voffA);
        if (wr == 1) PG8_BAR;
        PG8_WAIT_V(4); PG8_BAR;
        PG8_STAGE(PG8_SB(1, 0), cB + kstep, voffB); PG8_STAGE(PG8_SA(1, 0), cA + kstep, voffA); PG8_STAGE(PG8_SB(1, 1), cB + hstep + kstep, voffB);
        PG8_WAIT_V(6); PG8_BAR;
    }
    for (;;) {
        const bool has_next = S.next(ui + 1, nxt);
        const char* nA = has_next ? (const char*)g.A + (size_t)nxt.z * g.zA + (size_t)nxt.pm * tstep : cA; const char* nB = has_next ? (const char*)g.Bt + (size_t)nxt.z * g.zB + (size_t)nxt.pn * tstep : cB;
        for (int t = 0; t < nt; t += 2) {
            const bool last = (t == nt - 2);
            const char* a1 = cA + (size_t)(t + 1) * kstep;
            const char* a2 = last ? nA : cA + (size_t)(t + 2) * kstep; const char* b2 = last ? nB : cB + (size_t)(t + 2) * kstep;
            const char* a3 = a2 + kstep; const char* b3 = b2 + kstep;
            if constexpr (SP2) {
            PG8_LDB(B0, 0, 0); PG8_LDB(B1, 0, 1); PG8_SCHED; PG8_LDA(At, 0, 0); PG8_STAGE(PG8_SA(1, 1), a1 + hstep, voffA);
            PG8_WAIT_V(8); PG8_WAIT_L(0); PG8_BAR; PG8_MMA(0, 0, At, B0); PG8_MMA(0, 1, At, B1); PG8_BAR; PG8_SCHED;
            PG8_LDA(At, 0, 1); PG8_STAGE(PG8_SB(0, 0), b2, voffB); PG8_STAGE(PG8_SB(0, 1), b2 + hstep, voffB); PG8_STAGE(PG8_SA(0, 0), a2, voffA);
            PG8_WAIT_V(8); PG8_WAIT_L(0); PG8_BAR; PG8_MMA(1, 0, At, B0); PG8_MMA(1, 1, At, B1); PG8_BAR; PG8_SCHED;
            PG8_LDB(B0, 1, 0); PG8_LDB(B1, 1, 1); PG8_SCHED; PG8_LDA(At, 1, 0); PG8_STAGE(PG8_SA(0, 1), a2 + hstep, voffA);
            PG8_WAIT_V(8); PG8_WAIT_L(0); PG8_BAR; PG8_MMA(0, 0, At, B0); PG8_MMA(0, 1, At, B1); PG8_BAR; PG8_SCHED;
            PG8_LDA(At, 1, 1); PG8_STAGE(PG8_SB(1, 0), b3, voffB); PG8_STAGE(PG8_SB(1, 1), b3 + hstep, voffB); PG8_STAGE(PG8_SA(1, 0), a3, voffA);
            PG8_WAIT_V(8); PG8_WAIT_L(0); PG8_BAR; PG8_MMA(1, 0, At, B0); PG8_MMA(1, 1, At, B1); PG8_BAR; PG8_SCHED;
            } else {
            PG8_LDB(B0, 0, 0); PG8_SCHED; PG8_LDA(At, 0, 0); PG8_STAGE(PG8_SA(1, 1), a1 + hstep, voffA);
            PG8_WAIT_L(8); PG8_BAR; PG8_WAIT_L(0); PG8_MMA(0, 0, At, B0); PG8_BAR; PG8_SCHED;
            PG8_LDB(B1, 0, 1); PG8_STAGE(PG8_SB(0, 0), b2, voffB);
            PG8_BAR; PG8_WAIT_L(0); PG8_MMA(0, 1, At, B1); PG8_BAR;
            PG8_LDA(At, 0, 1); PG8_STAGE(PG8_SA(0, 0), a2, voffA);
            PG8_BAR; PG8_WAIT_L(0); PG8_MMA(1, 0, At, B0); PG8_BAR; PG8_SCHED;
            PG8_STAGE(PG8_SB(0, 1), b2 + hstep, voffB);
            PG8_WAIT_V(6); PG8_BAR; PG8_MMA(1, 1, At, B1); PG8_BAR;
            PG8_LDB(B0, 1, 0); PG8_SCHED; PG8_LDA(At, 1, 0); PG8_STAGE(PG8_SA(0, 1), a2 + hstep, voffA);
            PG8_WAIT_L(8); PG8_BAR; PG8_WAIT_L(0); PG8_MMA(0, 0, At, B0); PG8_BAR; PG8_SCHED;
            PG8_LDB(B1, 1, 1); PG8_STAGE(PG8_SB(1, 0), b3, voffB);
            PG8_BAR; PG8_WAIT_L(0); PG8_MMA(0, 1, At, B1); PG8_BAR;
            PG8_LDA(At, 1, 1); PG8_STAGE(PG8_SA(1, 0), a3, voffA);
            PG8_BAR; PG8_WAIT_L(0); PG8_MMA(1, 0, At, B0); PG8_BAR; PG8_SCHED;
            PG8_STAGE(PG8_SB(1, 1), b3 + hstep, voffB);
            PG8_WAIT_V(6); PG8_BAR; PG8_MMA(1, 1, At, B1); PG8_BAR;
            }
        }
        if constexpr (ALIGN_EPI) { if (wr == 0) PG8_BAR; }
        E(acc, cur, wr, wc, fr, fq);
        if (!has_next) break;
#pragma unroll
        for (int a = 0; a < 2; ++a)
#pragma unroll
            for (int b = 0; b < 2; ++b)
#pragma unroll
                for (int m = 0; m < 4; ++m)
#pragma unroll
                    for (int n = 0; n < 2; ++n) acc[a][b][m][n] = (f32x4){0.f, 0.f, 0.f, 0.f};
        cur = nxt; cA = nA; cB = nB; ++ui;
        if constexpr (ALIGN_EPI) { if (wr == 1) PG8_BAR; }
    }
    PG8_WAIT_V(0);
    if constexpr (!ALIGN_EPI) { if (wr == 0) PG8_BAR; }
    PG8_BAR;
#undef PG8_KOFF
#undef PG8_SA
#undef PG8_SB
#undef PG8_STAGE
#undef PG8_LDA
#undef PG8_LDB
#undef PG8_MMA
#undef PG8_WAIT_V
#undef PG8_WAIT_L
#undef PG8_BAR
#undef PG8_SCHED
}
}
namespace pg8 {
DI float act_apply(float x, int act) {
    if (act == 1) { const float r = fmaxf(x, 0.f); return r * r; }
    if (act == 2) { return 1.f - 2.f / (__expf(2.f * x) + 1.f); }
    if (act == 3) { return 1.f / (1.f + __expf(-x)); }
    return x;
}
constexpr int RSTAB_OFF = 131072, RSTAB_MAX = 16;
DI void fill_rs_table(LAS unsigned char* lds, const Order& S, const float* ps, int tid) {
    LAS float* T = (LAS float*)(lds + RSTAB_OFF); Unit u;
    for (int i = 0; i < RSTAB_MAX && S.next(i, u); ++i) { const int row = tid >> 1, hf = tid & 1; const float* p = ps + (size_t)(u.pm * BM + row) * 32 + 16 * hf;
        const f32x4 a = *(const f32x4*)p, b = *(const f32x4*)(p + 4), c = *(const f32x4*)(p + 8), d = *(const f32x4*)(p + 12);
        float sx = (((a.x + a.y) + (a.z + a.w)) + ((b.x + b.y) + (b.z + b.w))) + (((c.x + c.y) + (c.z + c.w)) + ((d.x + d.y) + (d.z + d.w)));
        sx += __shfl_xor(sx, 1); if (hf == 0) T[i * 256 + row] = 1.f / sqrtf(sx * (1.f / DM) + NORM_EPS); }
    asm volatile("s_waitcnt lgkmcnt(0)\n\ts_barrier" ::: "memory");
}
DI float rs_row(const LAS float* T, const Unit& u, int row) { return T[u.i * 256 + (row & 255)]; }
struct EpiAct {
    static constexpr bool PERM = true;
    bf16_t* O; int ldc; size_t zO; int acts; const LAS float* ss;
    DI void operator()(const f32x4 (&acc)[2][2][4][2], const Unit& u, int wr, int wc, int fr_, int fq) const {
        int fr = fr_; asm volatile("" : "+v"(fr));
        const int row0 = u.pm * BM + wr * 64 + fr, col0 = u.pn * BM + wc * 32 + 8 * fq, act = (acts >> (4 * u.z)) & 15;
        bf16_t* base = O + (size_t)u.z * zO;
#pragma unroll
        for (int ai = 0; ai < 2; ++ai)
#pragma unroll
            for (int m = 0; m < 4; ++m) { bf16_t* rowp = base + (size_t)(row0 + ai * HALF + m * 16) * ldc + col0; const float rs = ss ? rs_row(ss, u, row0 + ai * HALF + m * 16) : 1.f;
#pragma unroll
                for (int bj = 0; bj < 2; ++bj) { f32x4 v0 = acc[ai][bj][m][0] * rs, v1 = acc[ai][bj][m][1] * rs;
                    if (act) {
#pragma unroll
                        for (int j = 0; j < 4; ++j) { v0[j] = act_apply(v0[j], act); v1[j] = act_apply(v1[j], act); } }
                    u32x4 w; w.x = pk2(v0[0], v0[1]); w.y = pk2(v0[2], v0[3]); w.z = pk2(v1[0], v1[1]); w.w = pk2(v1[2], v1[3]);
                    *(u32x4*)(rowp + bj * HALF) = w; } }
    }
};
struct EpiRelu2 {
    static constexpr bool PERM = true;
    bf16_t* O; int ldc; const LAS float* ss;
    DI void operator()(const f32x4 (&acc)[2][2][4][2], const Unit& u, int wr, int wc, int fr_, int fq) const {
        int fr = fr_; asm volatile("" : "+v"(fr));
        const int row0 = u.pm * BM + wr * 64 + fr, col0 = u.pn * BM + wc * 32 + 8 * fq;
#pragma unroll
        for (int ai = 0; ai < 2; ++ai)
#pragma unroll
            for (int m = 0; m < 4; ++m) { bf16_t* rowp = O + (size_t)(row0 + ai * HALF + m * 16) * ldc + col0; const float rs = rs_row(ss, u, row0 + ai * HALF + m * 16);
#pragma unroll
                for (int bj = 0; bj < 2; ++bj) { f32x4 v0 = acc[ai][bj][m][0] * rs, v1 = acc[ai][bj][m][1] * rs;
#pragma unroll
                    for (int j = 0; j < 4; ++j) { const float a = fmaxf(v0[j], 0.f), b = fmaxf(v1[j], 0.f); v0[j] = a * a; v1[j] = b * b; }
                    u32x4 w; w.x = pk2(v0[0], v0[1]); w.y = pk2(v0[2], v0[3]); w.z = pk2(v1[0], v1[1]); w.w = pk2(v1[2], v1[3]);
                    *(u32x4*)(rowp + bj * HALF) = w; } }
    }
};
struct EpiResid {
    static constexpr bool PERM = true;
    const float* resP; const float* resS; bf16_t* XB; float* SS;
    DI void operator()(const f32x4 (&acc)[2][2][4][2], const Unit& u, int wr, int wc, int fr_, int fq) const {
        int fr = fr_; asm volatile("" : "+v"(fr));
        const int row0 = u.pm * BM + wr * 64 + fr, col0 = u.pn * BM + wc * 32 + 8 * fq;
        const bool pr = u.pm < MP / BM; const float* rb = pr ? resP : resS; const int rsub = pr ? 0 : MP;
#pragma unroll
        for (int ai = 0; ai < 2; ++ai)
#pragma unroll
            for (int m = 0; m < 4; ++m) { const int row = row0 + ai * HALF + m * 16; bf16_t* xp = XB + (size_t)row * DM + col0;
                float sq = 0.f;
#pragma unroll
                for (int bj = 0; bj < 2; ++bj) { f32x4 r0, r1;
                    if (resP) { const float* rp = rb + (size_t)(row - rsub) * DM + col0 + bj * HALF; r0 = *(const f32x4*)rp; r1 = *(const f32x4*)(rp + 4); }
                    else { const u32x4 xv = *(const u32x4*)(xp + bj * HALF); r0 = (f32x4){bflo(xv.x), bfhi(xv.x), bflo(xv.y), bfhi(xv.y)}; r1 = (f32x4){bflo(xv.z), bfhi(xv.z), bflo(xv.w), bfhi(xv.w)}; }
                    r0 = r0 + acc[ai][bj][m][0]; r1 = r1 + acc[ai][bj][m][1];
                    u32x4 wv; wv.x = pk2(r0[0], r0[1]); wv.y = pk2(r0[2], r0[3]); wv.z = pk2(r1[0], r1[1]); wv.w = pk2(r1[2], r1[3]); *(u32x4*)(xp + bj * HALF) = wv;
                    sq += (r0[0] * r0[0] + r0[1] * r0[1]) + (r0[2] * r0[2] + r0[3] * r0[3]) + (r1[0] * r1[0] + r1[1] * r1[1]) + (r1[2] * r1[2] + r1[3] * r1[3]); }
                sq += __shfl_xor(sq, 16); sq += __shfl_xor(sq, 32);
                if (fq == 0) SS[(size_t)row * 32 + u.pn * 4 + wc] = sq; }
    }
};
struct EpiSlab {
    static constexpr bool PERM = true;
    const LAS unsigned* skp; int slot;
    DI void operator()(const f32x4 (&acc)[2][2][4][2], const Unit& u, int wr, int wc, int fr, int fq) const {
        int tid2 = (wr * 4 + wc) * 64 + lane_now(); asm volatile("" : "+v"(tid2));
        const unsigned long long pb = ((unsigned long long)(unsigned)__builtin_amdgcn_readfirstlane((int)skp[1]) << 32) | (unsigned)__builtin_amdgcn_readfirstlane((int)skp[0]);
        GAS char* p = (GAS char*)pb + (size_t)slot * 262144; const unsigned voff = (unsigned)tid2 * 16u;
#pragma unroll
        for (int q = 0; q < 32; ++q) *(GAS f32x4*)(p + q * 8192 + voff) = acc[q >> 4][(q >> 3) & 1][(q >> 1) & 3][q & 1];
    }
};
DI void sk_reduce(unsigned char LAS* lds, float* slabs, unsigned* cnts, const Unit& u, int st, int ks, int nsl, bf16_t* XB, float* SS, int wave_id) {
    const int lane = lane_now(), tid = wave_id * 64 + lane, wr = wave_id >> 2, wc = wave_id & 3, fr = lane & 15, fq = lane >> 4;
    if (tid == 0) {
        unsigned* cnt = cnts + st * 4;
        __builtin_amdgcn_fence(__ATOMIC_RELEASE, "agent"); asm volatile("s_waitcnt vmcnt(0)" ::: "memory");
        (void)__hip_atomic_fetch_add(cnt, 1u, __ATOMIC_RELAXED, __HIP_MEMORY_SCOPE_AGENT);
        unsigned sp = 0; while (__hip_atomic_load(cnt, __ATOMIC_RELAXED, __HIP_MEMORY_SCOPE_AGENT) < (unsigned)nsl && ++sp < (1u << 24)) __builtin_amdgcn_s_sleep(1);
        __builtin_amdgcn_fence(__ATOMIC_ACQUIRE, "agent"); asm volatile("s_waitcnt vmcnt(0)" ::: "memory");
    }
    __syncthreads();
    const GAS char* p = (const GAS char*)slabs + (size_t)st * (4 * 262144); const unsigned voff = (unsigned)tid * 16u;
    const int rowb = u.pm * BM + wr * 64 + fr, col0 = u.pn * BM + wc * 32 + 8 * fq;
#pragma unroll 1
    for (int cm = ks; cm < 8; cm += nsl) { const int ai = cm >> 2, m = cm & 3, row = rowb + ai * HALF + m * 16; bf16_t* xp = XB + (size_t)row * DM + col0;
        f32x4 v[2][2][4]; u32x4 xv[2];
#pragma unroll
        for (int bj = 0; bj < 2; ++bj) { xv[bj] = *(const u32x4*)(xp + bj * HALF);
#pragma unroll
            for (int n = 0; n < 2; ++n)
#pragma unroll
                for (int sl = 0; sl < 4; ++sl) v[bj][n][sl] = (sl < nsl) ? *(const GAS f32x4*)(p + (size_t)sl * 262144 + (((ai * 2 + bj) * 4 + m) * 2 + n) * 8192 + voff) : (f32x4){0.f, 0.f, 0.f, 0.f}; }
        float sq = 0.f;
#pragma unroll
        for (int bj = 0; bj < 2; ++bj) {
            f32x4 r0 = (f32x4){bflo(xv[bj].x), bfhi(xv[bj].x), bflo(xv[bj].y), bfhi(xv[bj].y)}, r1 = (f32x4){bflo(xv[bj].z), bfhi(xv[bj].z), bflo(xv[bj].w), bfhi(xv[bj].w)};
            r0 = r0 + (((v[bj][0][0] + v[bj][0][1]) + v[bj][0][2]) + v[bj][0][3]); r1 = r1 + (((v[bj][1][0] + v[bj][1][1]) + v[bj][1][2]) + v[bj][1][3]);
            u32x4 wv; wv.x = pk2(r0[0], r0[1]); wv.y = pk2(r0[2], r0[3]); wv.z = pk2(r1[0], r1[1]); wv.w = pk2(r1[2], r1[3]); *(u32x4*)(xp + bj * HALF) = wv;
            sq += (r0[0] * r0[0] + r0[1] * r0[1]) + (r0[2] * r0[2] + r0[3] * r0[3]) + (r1[0] * r1[0] + r1[1] * r1[1]) + (r1[2] * r1[2] + r1[3] * r1[3]); }
        sq += __shfl_xor(sq, 16); sq += __shfl_xor(sq, 32);
        if (fq == 0) SS[(size_t)row * 32 + u.pn * 4 + wc] = sq; }
}
DI int tok_pos(int row) { return row < MP ? row : PAST + (row & 63); }
DI void sincos_rev(int pos, float inv, float& c, float& s) {
    double r = (double)pos * (double)inv * 0.15915494309189535; r = r - __builtin_floor(r); const float f = (float)r;
    s = __builtin_amdgcn_sinf(f); c = __builtin_amdgcn_cosf(f);
}
struct EpiAttnQKV {
    static constexpr bool PERM = true;
    bf16_t* Qb; float* outf; size_t okP, okS; const LAS float* ss;
    DI void operator()(const f32x4 (&acc)[2][2][4][2], const Unit& u, int wr, int wc, int fr_, int fq) const {
        int fr = fr_; asm volatile("" : "+v"(fr));
        const int row0 = u.pm * BM + wr * 64 + fr, cl = wc * 32 + 8 * fq;
        const bool rot = (u.pn < 9) && ((wc & 1) == 0) && (fq < 2);
        float inv[8];
#pragma unroll
        for (int j = 0; j < 8; ++j) inv[j] = __builtin_amdgcn_exp2f(-(float)j * 2.3664461f);
        const float qs = (u.pn < 8) ? 0.18033688f : 1.f;
        const size_t ooff = (u.pn < 8) ? (size_t)0 : (u.pn == 8 ? (size_t)M * DM : (size_t)M * DM + (size_t)M * 256); bf16_t* ob = Qb + ooff; const int ldo = (u.pn < 8) ? DM : 256, ocol = (u.pn < 8) ? u.pn * BM + cl : cl;
        float* cP = outf + okP + (u.pn == 9 ? 65536 : 0); float* cS = outf + okS + (u.pn == 9 ? 2097152 : 0);
#pragma unroll
        for (int ai = 0; ai < 2; ++ai)
#pragma unroll
            for (int m = 0; m < 4; ++m) { const int row = row0 + ai * HALF + m * 16; const int pos = tok_pos(row);
                const float rs = rs_row(ss, u, row);
                f32x4 p0 = acc[ai][0][m][0] * rs, p1 = acc[ai][0][m][1] * rs, q0 = acc[ai][1][m][0] * rs, q1 = acc[ai][1][m][1] * rs;
                if (rot) {
#define ROPE_J(j, pv, qv, e) { float c_, s_; sincos_rev(pos, inv[j], c_, s_); const float ya = __shfl_xor(pv[e], 16), yb = __shfl_xor(qv[e], 16); \
                        pv[e] = (fq == 0) ? pv[e] * c_ - ya * s_ : pv[e] * c_ + ya * s_; qv[e] = (fq == 0) ? qv[e] * c_ - yb * s_ : qv[e] * c_ + yb * s_; }
                    ROPE_J(0, p0, q0, 0) ROPE_J(1, p0, q0, 1) ROPE_J(2, p0, q0, 2) ROPE_J(3, p0, q0, 3) ROPE_J(4, p1, q1, 0) ROPE_J(5, p1, q1, 1) ROPE_J(6, p1, q1, 2) ROPE_J(7, p1, q1, 3)
#undef ROPE_J
                }
                { u32x4 wv; wv.x = pk2(p0[0] * qs, p0[1] * qs); wv.y = pk2(p0[2] * qs, p0[3] * qs); wv.z = pk2(p1[0] * qs, p1[1] * qs); wv.w = pk2(p1[2] * qs, p1[3] * qs);
                  *(u32x4*)(ob + (size_t)row * ldo + ocol) = wv;
                  wv.x = pk2(q0[0] * qs, q0[1] * qs); wv.y = pk2(q0[2] * qs, q0[3] * qs); wv.z = pk2(q1[0] * qs, q1[1] * qs); wv.w = pk2(q1[2] * qs, q1[3] * qs);
                  *(u32x4*)(ob + (size_t)row * ldo + ocol + HALF) = wv; }
                if (u.pn >= 8) {
                    float* cp = nullptr;
                    if (row >= MP) cp = cS + ((size_t)((row - MP) >> 6) * AWIN + 64 + (row & 63)) * 256; else if (row >= MP - AWIN) cp = cP + (size_t)(row - (MP - AWIN)) * 256;
                    if (cp) { *(f32x4*)(cp + cl) = p0; *(f32x4*)(cp + cl + 4) = p1; *(f32x4*)(cp + cl + HALF) = q0; *(f32x4*)(cp + cl + HALF + 4) = q1; }
                } }
    }
};
struct EpiRetProj {
    static constexpr bool PERM = true;
    bf16_t* P; const LAS float* ss;
    DI void operator()(const f32x4 (&acc)[2][2][4][2], const Unit& u, int wr, int wc, int fr_, int fq) const {
        int fr = fr_; asm volatile("" : "+v"(fr));
        const int row0 = u.pm * BM + wr * 64 + fr, cl = wc * 32 + 8 * fq; const bool rot = u.pn < 16; const float sc = (u.pn >= 8 && u.pn < 16) ? 0.0625f : 1.f;
        float inv[8];
#pragma unroll
        for (int j = 0; j < 8; ++j) inv[j] = __builtin_amdgcn_exp2f(-(float)(cl + j) * 0.10381025f);
#pragma unroll
        for (int ai = 0; ai < 2; ++ai)
#pragma unroll
            for (int m = 0; m < 4; ++m) { const int row = row0 + ai * HALF + m * 16; const int pos = tok_pos(row);
                const float rs = rs_row(ss, u, row);
                f32x4 a0 = acc[ai][0][m][0] * rs, a1 = acc[ai][0][m][1] * rs, b0 = acc[ai][1][m][0] * rs, b1 = acc[ai][1][m][1] * rs;
                if (rot) {
                    float x1[8] = {a0[0], a0[1], a0[2], a0[3], a1[0], a1[1], a1[2], a1[3]}, x2[8] = {b0[0], b0[1], b0[2], b0[3], b1[0], b1[1], b1[2], b1[3]};
#pragma unroll
                    for (int j = 0; j < 8; ++j) { float c, s; sincos_rev(pos, inv[j], c, s); const float p = x1[j], q = x2[j]; x1[j] = (p * c - q * s) * sc; x2[j] = (q * c + p * s) * sc; }
                    a0 = (f32x4){x1[0], x1[1], x1[2], x1[3]}; a1 = (f32x4){x1[4], x1[5], x1[6], x1[7]}; b0 = (f32x4){x2[0], x2[1], x2[2], x2[3]}; b1 = (f32x4){x2[4], x2[5], x2[6], x2[7]};
                }
                bf16_t* rowp = P + (size_t)row * RIN + u.pn * BM + cl;
                u32x4 w; w.x = pk2(a0[0], a0[1]); w.y = pk2(a0[2], a0[3]); w.z = pk2(a1[0], a1[1]); w.w = pk2(a1[2], a1[3]); *(u32x4*)rowp = w;
                w.x = pk2(b0[0], b0[1]); w.y = pk2(b0[2], b0[3]); w.z = pk2(b1[0], b1[1]); w.w = pk2(b1[2], b1[3]); *(u32x4*)(rowp + HALF) = w; }
    }
};
struct EpiRwkv2 {
    static constexpr bool PERM = true;
    float* LW; bf16_t* Ab; const float* w0; const float* a0;
    DI void operator()(const f32x4 (&acc)[2][2][4][2], const Unit& u, int wr, int wc, int fr_, int fq) const {
        int fr = fr_; asm volatile("" : "+v"(fr));
        const int row0 = u.pm * BM + wr * 64 + fr, col0 = u.pn * BM + wc * 32 + 8 * fq;
        const float* bp = (u.z == 0) ? w0 : a0; bf16_t* ob = Ab + (u.z == 2 ? (size_t)M * DM : (size_t)0);
#pragma unroll
        for (int bj = 0; bj < 2; ++bj)
#pragma unroll
            for (int n = 0; n < 2; ++n) { const int col = col0 + bj * HALF + 4 * n;
                f32x4 bias = (f32x4){0.f, 0.f, 0.f, 0.f}; if (u.z < 2) bias = *(const f32x4*)(bp + col);
#pragma unroll
                for (int ai = 0; ai < 2; ++ai)
#pragma unroll
                    for (int m = 0; m < 4; ++m) { const int row = row0 + ai * HALF + m * 16; f32x4 x = acc[ai][bj][m][n] + bias;
                        if (u.z == 0) {
#pragma unroll
                            for (int j = 0; j < 4; ++j) { const float y = -x[j]; const float sp = fmaxf(y, 0.f) + __logf(1.f + __expf(-fabsf(y))); x[j] = -__expf(-sp - 0.5f); }
                            *(f32x4*)(LW + (size_t)row * DM + col) = x;
                        } else {
                            if (u.z == 1) {
#pragma unroll
                                for (int j = 0; j < 4; ++j) x[j] = 1.f / (1.f + __expf(-x[j])); }
                            u32x2 wv; wv.x = pk2(x[0], x[1]); wv.y = pk2(x[2], x[3]); *(u32x2*)(ob + (size_t)row * DM + col) = wv;
                        } }
                asm volatile("" ::: "memory"); }
    }
};
}
#define XB_TMO      128
#define XB_XCNT(j)  (256  + 64 * (j))
#define XB_XSUB(j)  (1280 + 64 * (j))
#define XB_XGEN(j)  (2304 + 64 * (j))
#define XB_TOP      3328
#define XB_TOPGEN   3392
#define XCD_BAR_WORDS 3456
#define XB_SPIN_CAP (1u << 18)

__device__ __forceinline__ unsigned xb_ld(unsigned* p)              { return __hip_atomic_load(p, __ATOMIC_RELAXED, __HIP_MEMORY_SCOPE_AGENT); }
__device__ __forceinline__ unsigned xb_add(unsigned* p, unsigned v) { return __hip_atomic_fetch_add(p, v, __ATOMIC_RELAXED, __HIP_MEMORY_SCOPE_AGENT); }
__device__ __forceinline__ unsigned xb_xcc_id() { return (unsigned)__builtin_amdgcn_s_getreg((3 << 11) | 20) & 0xFu; }
#define XB_SPIN(cond, bar) do { unsigned _sp = 0; while (cond) { __builtin_amdgcn_s_sleep(1); \
    if ((++_sp & 255u) == 0u) { if (xb_ld(&(bar)[XB_TMO])) break; if (_sp > XB_SPIN_CAP) { atomicAdd(&(bar)[XB_TMO], 1u); break; } } } } while (0)

struct XcdBarrier {
    unsigned* bar; unsigned x;
    volatile LAS unsigned* st;
};

__device__ __forceinline__ XcdBarrier xcd_barrier_post(unsigned* bar, volatile LAS unsigned* st, int wave_id) {
    XcdBarrier b; b.bar = bar; b.x = xb_xcc_id(); b.st = st;
    if (wave_id == 0 && lane_now() == 0) (void)xb_add(&bar[XB_XCNT(b.x)], 1u);
    return b;
}
__device__ __forceinline__ void xcd_barrier_complete(unsigned* bar, unsigned x, unsigned& nloc, unsigned& nx) {
    const unsigned G = gridDim.x * gridDim.y * gridDim.z;
    unsigned sum, cnt, mine, sp = 0u;
    for (;;) {
        sum = 0u; cnt = 0u; mine = 0u;
#pragma unroll
        for (unsigned j = 0; j < 16; ++j) { const unsigned c = xb_ld(&bar[XB_XCNT(j)]); sum += c; cnt += (c > 0u) ? 1u : 0u; mine = (j == x) ? c : mine; }
        if (sum == G) break;
        __builtin_amdgcn_s_sleep(1);
        if ((++sp & 255u) == 0u) { if (xb_ld(&bar[XB_TMO])) break; if (sp > XB_SPIN_CAP) { atomicAdd(&bar[XB_TMO], 1u); break; } }
    }
    nloc = mine > 0u ? mine : 1u; nx = cnt > 0u ? cnt : 1u;
}

__device__ __forceinline__ void xcd_barrier(const XcdBarrier& b, int wave_id) {
    asm volatile("s_waitcnt vmcnt(0)" ::: "memory");
    __syncthreads();
    if (wave_id == 0 && lane_now() == 0) {
        unsigned* bar = b.bar;
        __builtin_amdgcn_s_waitcnt(0);
        unsigned nloc = b.st[0], nx = b.st[1];
        if (nloc == 0u) { xcd_barrier_complete(bar, b.x, nloc, nx); b.st[0] = nloc; b.st[1] = nx; }
        const unsigned old = xb_add(&bar[XB_XSUB(b.x)], 1u);
        const unsigned gen = old / nloc;
        if (old + 1u == (gen + 1u) * nloc) {
            __builtin_amdgcn_fence(__ATOMIC_RELEASE, "agent");
            asm volatile("s_waitcnt vmcnt(0)" ::: "memory");
            const unsigned og = xb_add(&bar[XB_TOP], 1u);
            const unsigned tg = og / nx;
            if (og + 1u == (tg + 1u) * nx) xb_add(&bar[XB_TOPGEN], 1u);
            else XB_SPIN(xb_ld(&bar[XB_TOPGEN]) == tg, bar);
            __builtin_amdgcn_fence(__ATOMIC_ACQUIRE, "agent");
            xb_add(&bar[XB_XGEN(b.x)], 1u);
            asm volatile("s_waitcnt vmcnt(0)" ::: "memory");
        } else {
            XB_SPIN(xb_ld(&bar[XB_XGEN(b.x)]) == gen, bar);
            __builtin_amdgcn_fence(__ATOMIC_ACQUIRE, "agent");
            asm volatile("s_waitcnt vmcnt(0)" ::: "memory");
        }
    }
    __syncthreads();
}
struct WG { LAS unsigned char* lds; int tid, lane, wave, gw, ngw, G, bid; };

DI void convert_w(const WG& w, const float* W, int Kv, int Nv, bf16_t* WT, int Kp, int Np, const float* gain = nullptr, int b0 = 0, int nb = 0, int part = 0) {
    const int nkt = Kp / 128, nnt = Np / 128, nall = nkt * nnt; if (nb == 0) nb = w.G;
    if (w.bid < b0 || w.bid >= b0 + nb) return;
    const int tcut = (nall * 5) >> 3, ntile = (part == 1) ? tcut : nall;
    int tile = ((part == 2) ? tcut : 0) + (w.bid - b0); if (tile >= ntile) return;
    int tid = w.tid; asm volatile("" : "+v"(tid)); const int lane = tid & 63, wv = tid >> 6;
    f32x4 r0[8], r1[8], r2[8], r3[8]; float g0[8], g1[8], g2[8], g3[8]; int it = 0;
#define CW_LOAD(dst, gd, tl) { const int k0_ = ((tl) / nnt) * 128, n0_ = ((tl) % nnt) * 128; _Pragma("unroll") for (int i = 0; i < 8; ++i) { const int k = k0_ + 16 * wv + 2 * i + (lane >> 5), n = n0_ + 4 * (lane & 31); \
        f32x4 x_ = (f32x4){0.f, 0.f, 0.f, 0.f}; float g_ = 1.f; if (k < Kv && n < Nv) { x_ = *(const f32x4*)(W + (size_t)k * Nv + n); if (gain) g_ = gain[k]; } dst[i] = x_; gd[i] = g_; } }
#define CW_STEP(cur, gc, pf, gp) { const int k0 = (tile / nnt) * 128, n0 = (tile % nnt) * 128; LAS float* T = (LAS float*)w.lds + (it & 1) * (128 * 129 + 64); const int tp_ = tile + 3 * nb; \
        if (tp_ < ntile) CW_LOAD(pf, gp, tp_) \
        _Pragma("unroll") for (int i = 0; i < 8; ++i) { const int kk = 16 * wv + 2 * i + (lane >> 5); LAS float* tp = T + kk * 129 + 4 * (lane & 31); tp[0] = cur[i].x * gc[i]; tp[1] = cur[i].y * gc[i]; tp[2] = cur[i].z * gc[i]; tp[3] = cur[i].w * gc[i]; } \
        LDS_BARRIER(); \
        _Pragma("unroll") for (int i = 0; i < 4; ++i) { const int nn = 16 * wv + 4 * i + (lane >> 4), kj = 8 * (lane & 15); const LAS float* sp = T + kj * 129 + nn; \
            u32x4 o; o.x = pk2(sp[0], sp[129]); o.y = pk2(sp[2 * 129], sp[3 * 129]); o.z = pk2(sp[4 * 129], sp[5 * 129]); o.w = pk2(sp[6 * 129], sp[7 * 129]); \
            *(u32x4*)(WT + (size_t)(n0 + nn) * Kp + k0 + kj) = o; } \
        ++it; tile += nb; }
    CW_LOAD(r0, g0, tile)
    if (tile + nb < ntile) CW_LOAD(r1, g1, tile + nb)
    if (tile + 2 * nb < ntile) CW_LOAD(r2, g2, tile + 2 * nb)
    LDS_BARRIER();
    for (;;) {
        CW_STEP(r0, g0, r3, g3) if (tile >= ntile) break;
        CW_STEP(r1, g1, r0, g0) if (tile >= ntile) break;
        CW_STEP(r2, g2, r1, g1) if (tile >= ntile) break;
        CW_STEP(r3, g3, r2, g2) if (tile >= ntile) break;
    }
#undef CW_LOAD
#undef CW_STEP
    LDS_BARRIER();
}

DI void rows0(const WG& w, const float* xp, const float* xs, bf16_t* XB, float* SS) {
    for (int m = w.gw; m < M; m += w.ngw) {
        const float* xr = (m < MP) ? xp + (size_t)m * DM : xs + (size_t)(m - MP) * DM;
        f32x4 v[8]; float s = 0.f;
#pragma unroll
        for (int j = 0; j < 8; ++j) { v[j] = ((const f32x4*)xr)[w.lane + 64 * j]; s += (v[j].x * v[j].x + v[j].y * v[j].y) + (v[j].z * v[j].z + v[j].w * v[j].w); }
        s = wave_sum_fast(s); if (w.lane < 32) SS[(size_t)m * 32 + w.lane] = (w.lane == 0) ? s : 0.f;
#pragma unroll
        for (int j = 0; j < 8; ++j) { u32x2 o; o.x = pk2(v[j].x, v[j].y); o.y = pk2(v[j].z, v[j].w); ((u32x2*)(XB + (size_t)m * DM))[w.lane + 64 * j] = o; }
    }
}
DI float rs_of_row(const float* ps, int m, int lane) { const float v = (lane < 32) ? ps[(size_t)m * 32 + lane] : 0.f; return 1.f / sqrtf(wave_sum_fast(v) * (1.f / DM) + NORM_EPS); }
DI void norm_rows(const WG& w, const float* xp, const float* xs, const float* gain, bf16_t* H, float* shp, float* shs) {
    for (int m = w.gw; m < M; m += w.ngw) {
        const float* xr = (m < MP) ? xp + (size_t)m * DM : xs + (size_t)(m - MP) * DM;
        f32x4 v[8]; float s = 0.f;
#pragma unroll
        for (int j = 0; j < 8; ++j) { v[j] = ((const f32x4*)xr)[w.lane + 64 * j]; s += (v[j].x * v[j].x + v[j].y * v[j].y) + (v[j].z * v[j].z + v[j].w * v[j].w); }
        const float rs = 1.f / sqrtf(wave_sum_fast(s) * (1.f / DM) + NORM_EPS);
        float* sh = nullptr;
        if (shp && m == MP - 1) sh = shp; else if (shs && m >= MP && (m & 63) == 63) sh = shs + (size_t)((m - MP) >> 6) * DM;
#pragma unroll
        for (int j = 0; j < 8; ++j) { const f32x4 g = ((const f32x4*)gain)[w.lane + 64 * j]; const f32x4 y = v[j] * rs * g;
            u32x2 o; o.x = pk2(y.x, y.y); o.y = pk2(y.z, y.w); ((u32x2*)(H + (size_t)m * DM))[w.lane + 64 * j] = o;
            if (sh) ((f32x4*)sh)[w.lane + 64 * j] = y; }
    }
}
DI void final_norm(const WG& w, const bf16_t* XB, const float* SS, const float* gain, float* Y) {
    for (int m = w.gw; m < M; m += w.ngw) { const float rs = rs_of_row(SS, m, w.lane);
#pragma unroll
        for (int j = 0; j < 4; ++j) { const int c0 = 8 * (w.lane + 64 * j); const u32x4 xv = *(const u32x4*)(XB + (size_t)m * DM + c0);
            const f32x4 g0 = *(const f32x4*)(gain + c0), g1 = *(const f32x4*)(gain + c0 + 4);
            *(f32x4*)(Y + (size_t)m * DM + c0) = (f32x4){bflo(xv.x), bfhi(xv.x), bflo(xv.y), bfhi(xv.y)} * rs * g0; *(f32x4*)(Y + (size_t)m * DM + c0 + 4) = (f32x4){bflo(xv.z), bfhi(xv.z), bflo(xv.w), bfhi(xv.w)} * rs * g1; } }
}
DI void lerp_rows(const WG& w, const bf16_t* XB, const float* SS, const float* gain, const float* shift_state, const float* mu, bf16_t* XL, float* shp, float* shs) {
    constexpr int RPW = 36;
    for (int task = w.gw; task < 4 * (M / RPW); task += w.ngw) { const int cq = task & 3, m0 = (task >> 2) * RPW, c0 = 512 * cq + 8 * w.lane;
        float gg[8], mm[6][8], hp[8];
        { const f32x4 g0 = *(const f32x4*)(gain + c0), g1 = *(const f32x4*)(gain + c0 + 4); gg[0] = g0.x; gg[1] = g0.y; gg[2] = g0.z; gg[3] = g0.w; gg[4] = g1.x; gg[5] = g1.y; gg[6] = g1.z; gg[7] = g1.w; }
#pragma unroll
        for (int i = 0; i < 6; ++i) { const int mrow = (i == 1) ? 2 : (i == 2) ? 3 : (i == 3) ? 1 : i;
            const float* mp = mu + (size_t)mrow * DM + c0; const f32x4 a = *(const f32x4*)mp, b = *(const f32x4*)(mp + 4); mm[i][0] = a.x; mm[i][1] = a.y; mm[i][2] = a.z; mm[i][3] = a.w; mm[i][4] = b.x; mm[i][5] = b.y; mm[i][6] = b.z; mm[i][7] = b.w; }
        { const bool first0 = (m0 == 0) || (m0 >= MP && (m0 & 63) == 0);
            if (!first0) { const float rsp = rs_of_row(SS, m0 - 1, w.lane); const u32x4 pv = *(const u32x4*)(XB + (size_t)(m0 - 1) * DM + c0);
                hp[0] = bflo(pv.x); hp[1] = bfhi(pv.x); hp[2] = bflo(pv.y); hp[3] = bfhi(pv.y); hp[4] = bflo(pv.z); hp[5] = bfhi(pv.z); hp[6] = bflo(pv.w); hp[7] = bfhi(pv.w);
#pragma unroll
                for (int e = 0; e < 8; ++e) hp[e] *= rsp * gg[e]; }
            else {
#pragma unroll
                for (int e = 0; e < 8; ++e) hp[e] = 0.f; } }
#pragma unroll 2
        for (int rr = 0; rr < RPW; ++rr) { const int m = m0 + rr;
            const float rs = rs_of_row(SS, m, w.lane); const u32x4 hv = *(const u32x4*)(XB + (size_t)m * DM + c0);
            float h[8] = {bflo(hv.x), bfhi(hv.x), bflo(hv.y), bfhi(hv.y), bflo(hv.z), bfhi(hv.z), bflo(hv.w), bfhi(hv.w)};
#pragma unroll
            for (int e = 0; e < 8; ++e) h[e] *= rs * gg[e];
            if (m == 0) {
#pragma unroll
                for (int e = 0; e < 8; ++e) hp[e] = 0.f;
            } else if (m >= MP && (m & 63) == 0) { const float* sp = shift_state + (size_t)((m - MP) >> 6) * DM + c0; const f32x4 s0 = *(const f32x4*)sp, s1 = *(const f32x4*)(sp + 4);
                hp[0] = s0.x; hp[1] = s0.y; hp[2] = s0.z; hp[3] = s0.w; hp[4] = s1.x; hp[5] = s1.y; hp[6] = s1.z; hp[7] = s1.w; }
            float* sh = nullptr; if (m == MP - 1) sh = shp; else if (m >= MP && (m & 63) == 63) sh = shs + (size_t)((m - MP) >> 6) * DM;
            if (sh) { *(f32x4*)(sh + c0) = (f32x4){h[0], h[1], h[2], h[3]}; *(f32x4*)(sh + c0 + 4) = (f32x4){h[4], h[5], h[6], h[7]}; }
#pragma unroll
            for (int i = 0; i < 6; ++i) { float o[8];
#pragma unroll
                for (int e = 0; e < 8; ++e) o[e] = h[e] + (hp[e] - h[e]) * mm[i][e];
                u32x4 ov; ov.x = pk2(o[0], o[1]); ov.y = pk2(o[2], o[3]); ov.z = pk2(o[4], o[5]); ov.w = pk2(o[6], o[7]);
                *(u32x4*)(XL + ((size_t)i * M + m) * DM + c0) = ov; }
#pragma unroll
            for (int e = 0; e < 8; ++e) hp[e] = h[e];
        }
    }
}
constexpr int AT_KS = 72, AT_VS = 196;
constexpr int AT_V_OFF = 192 * AT_KS * 2;
DI u32x4 ld8_f32_as_bf16(const float* p) { const f32x4 a = *(const f32x4*)p, b = *(const f32x4*)(p + 4); u32x4 o; o.x = pk2(a.x, a.y); o.y = pk2(a.z, a.w); o.z = pk2(b.x, b.y); o.w = pk2(b.z, b.w); return o; }
DI bf16x8 pack8(const f32x16& x, int s) {
    u32x4 p; p.x = pk2(x[8 * s], x[8 * s + 1]); p.y = pk2(x[8 * s + 2], x[8 * s + 3]); p.z = pk2(x[8 * s + 4], x[8 * s + 5]); p.w = pk2(x[8 * s + 6], x[8 * s + 7]);
    return __builtin_bit_cast(bf16x8, p);
}
DI bf16x8 ld_perm_frag(const LAS bf16_t* p) {
    const s16x4 lo = *(const LAS s16x4*)p, hi = *(const LAS s16x4*)(p + 8); return __builtin_shufflevector(lo, hi, 0, 1, 2, 3, 4, 5, 6, 7);
}
DI f32x16 zero16() { f32x16 z; for (int i = 0; i < 16; ++i) z[i] = 0.f; return z; }

typedef short v4i16_t __attribute__((ext_vector_type(4)));
DI s16x4 ds_tr(const LAS unsigned char* p) { return __builtin_bit_cast(s16x4, __builtin_amdgcn_ds_read_tr16_b64_v4i16((LAS v4i16_t*)p)); }
constexpr int AT_VB = 9344;
DI void attn_load_kv(const bf16_t* Kb, const bf16_t* Vb, const float* ck, const float* cv, int c, int g, int tid, u32x4 (&pk)[3], u32x4 (&pv)[3]) {
#pragma unroll
    for (int i = 0; i < 3; ++i) { const int idx = tid + 512 * i, sl = idx >> 3, dc = idx & 7;
        u32x4 kv = {0u, 0u, 0u, 0u}, vv = {0u, 0u, 0u, 0u};
        if (c < NCHP) { const int tok = 64 * (c - 2) + sl; if (tok >= 0) { kv = *(const u32x4*)(Kb + (size_t)tok * 256 + g * 64 + dc * 8); vv = *(const u32x4*)(Vb + (size_t)tok * 256 + g * 64 + dc * 8); } }
        else { const int b = c - NCHP;
            if (sl < AWIN) { const size_t o = (((size_t)b * AWIN + sl) * AKV + g) * AHD + dc * 8; kv = ld8_f32_as_bf16(ck + o); vv = ld8_f32_as_bf16(cv + o); }
            else { const int tok = MP + 64 * b + (sl - AWIN); kv = *(const u32x4*)(Kb + (size_t)tok * 256 + g * 64 + dc * 8); vv = *(const u32x4*)(Vb + (size_t)tok * 256 + g * 64 + dc * 8); } }
        pk[i] = kv; pv[i] = vv; }
}
DI void attn_load_q(const bf16_t* Qb, int c, int qh, int hq, int r, int h, bf16x8 (&qf)[4]) {
#pragma unroll
    for (int sx = 0; sx < 4; ++sx) qf[sx] = *(const bf16x8*)(Qb + (size_t)(64 * c + 32 * qh + r) * DM + hq * 64 + 16 * sx + 8 * h);
}
DI void attn_phase(const WG& w, const bf16_t* Qb, const bf16_t* Kb, const bf16_t* Vb, const float* ck, const float* cv, const float* sinks, bf16_t* AO) {
    LAS bf16_t* Ks = (LAS bf16_t*)(w.lds); LAS unsigned char* Vl = w.lds + AT_V_OFF;
    const int NU = NCH * AKV;
    u32x4 pk[3], pv[3]; bf16x8 qn[4];
    if (w.bid < NU) { const int c = w.bid >> 2, g = w.bid & 3; attn_load_kv(Kb, Vb, ck, cv, c, g, w.tid, pk, pv); attn_load_q(Qb, c, 0, g * 8 + w.wave, w.lane & 31, w.lane >> 5, qn); }
#pragma unroll 1
    for (int u = w.bid; u < NU; u += w.G) {
        const int c = u >> 2, g = u & 3, un = u + w.G, cn = un >> 2, gn = un & 3;
        int tid = w.tid; asm volatile("" : "+v"(tid)); const int lane = tid & 63, r = lane & 31, h = lane >> 5;
        LDS_BARRIER();
#pragma unroll
        for (int i = 0; i < 3; ++i) { const int idx = tid + 512 * i, sl = idx >> 3, dc = idx & 7;
            *(LAS u32x4*)(Ks + sl * AT_KS + dc * 8) = pk[i];
            *(LAS u32x4*)(Vl + (dc >> 1) * AT_VB + 32 * sl + 128 * (sl >> 3) + (dc & 1) * 16) = pv[i]; }
        LDS_BARRIER();
        const int hq = g * 8 + w.wave; const float sink2 = sinks[hq] * 1.4426950408889634f;
        const int i0 = (c < NCHP) ? (c == 0 ? 4 : (c == 1 ? 2 : 0)) : 0;
        const LAS unsigned char* vbase = Vl + ((lane >> 4) & 1) * AT_VB + 128 * h + 32 * ((lane & 15) >> 2) + 8 * (lane & 3);
#pragma unroll 1
        for (int qh = 0; qh < 2; ++qh) {
            bf16x8 qf[4];
#pragma unroll
            for (int sx = 0; sx < 4; ++sx) qf[sx] = qn[sx];
            if (qh == 0) { attn_load_q(Qb, c, 1, hq, r, h, qn); if (un < NU) attn_load_kv(Kb, Vb, ck, cv, cn, gn, tid, pk, pv); }
            else if (un < NU) attn_load_q(Qb, cn, 0, gn * 8 + w.wave, r, h, qn);
            const int qrow = 64 * c + 32 * qh + r;
            float mx = sink2;
#pragma unroll
            for (int i = 0; i < 6; ++i) if (i >= i0) { f32x16 t = zero16();
#pragma unroll
                for (int sx = 0; sx < 4; ++sx) { const bf16x8 kf = *(const LAS bf16x8*)(Ks + (32 * i + r) * AT_KS + 16 * sx + 8 * h); t = MFMA32(kf, qf[sx], t); }
#pragma unroll
                for (int e = 0; e < 16; ++e) mx = fmaxf(mx, t[e]); }
            mx = fmaxf(mx, __shfl_xor(mx, 32));
            float sum = 0.f; bf16x8 pf[6][2];
#pragma unroll
            for (int i = 0; i < 6; ++i) if (i >= i0) { f32x16 t = zero16();
#pragma unroll
                for (int sx = 0; sx < 4; ++sx) { const bf16x8 kf = *(const LAS bf16x8*)(Ks + (32 * i + r) * AT_KS + 16 * sx + 8 * h); t = MFMA32(kf, qf[sx], t); }
#pragma unroll
                for (int e = 0; e < 16; ++e) { t[e] = __builtin_amdgcn_exp2f(t[e] - mx); sum += t[e]; }
                pf[i][0] = pack8(t, 0); pf[i][1] = pack8(t, 1); }
            sum += __shfl_xor(sum, 32);
            const float inv = 1.f / (sum + __builtin_amdgcn_exp2f(sink2 - mx));
            f32x16 ot[2]; ot[0] = zero16(); ot[1] = zero16();
#pragma unroll
            for (int i = 0; i < 6; ++i) if (i >= i0) {
#pragma unroll
                for (int s2 = 0; s2 < 2; ++s2) {
#pragma unroll
                    for (int dt = 0; dt < 2; ++dt) { const LAS unsigned char* vp = vbase + dt * (2 * AT_VB) + i * 1536 + s2 * 768; const s16x4 lo = ds_tr(vp), hi = ds_tr(vp + 384);
                        const bf16x8 vf = __builtin_shufflevector(lo, hi, 0, 1, 2, 3, 4, 5, 6, 7); ot[dt] = MFMA32(vf, pf[i][s2], ot[dt]); } } }
#pragma unroll
            for (int dt = 0; dt < 2; ++dt)
#pragma unroll
                for (int gq = 0; gq < 4; ++gq) { u32x2 o; o.x = pk2(ot[dt][4 * gq] * inv, ot[dt][4 * gq + 1] * inv); o.y = pk2(ot[dt][4 * gq + 2] * inv, ot[dt][4 * gq + 3] * inv);
                    *(u32x2*)(AO + (size_t)qrow * DM + hq * 64 + 32 * dt + 8 * gq + 4 * h) = o; }
        }
    }
}
DI void cache_shift(const WG& w, const float* ck, const float* cv, float* kS, float* vS) {
    const int n4 = DBATCH * 64 * 256 / 4;
    for (int i = w.bid * 512 + w.tid; i < n4; i += w.G * 512) { const int b = i / (64 * 64), rem = i % (64 * 64);
        ((f32x4*)kS)[(size_t)b * (128 * 64) + rem] = ((const f32x4*)ck)[(size_t)b * (128 * 64) + 64 * 64 + rem];
        ((f32x4*)vS)[(size_t)b * (128 * 64) + rem] = ((const f32x4*)cv)[(size_t)b * (128 * 64) + 64 * 64 + rem]; }
}

DI float ret_lg2(int hh) { return __log2f(1.f - __builtin_amdgcn_exp2f(-5.f - (float)hh)); }
constexpr int RI_KS = 264, RI_VS = 68, RI_V_OFF = 64 * RI_KS * 2;
DI void ret_intra_phase(const WG& w, const bf16_t* P, bf16_t* O) {
    LAS bf16_t* Ks = (LAS bf16_t*)(w.lds); LAS bf16_t* Vt = (LAS bf16_t*)(w.lds + RI_V_OFF);
    const int lane = w.lane, r = lane & 31, h = lane >> 5, tt = w.wave & 1, dvq = w.wave >> 1;
    for (int u = w.bid; u < NCH * RH; u += w.G) {
        const int c = u >> 3, hh = u & 7; const float lg2 = ret_lg2(hh);
        LDS_BARRIER();
#pragma unroll
        for (int i = 0; i < 4; ++i) { const int idx = w.tid + 512 * i, s = idx >> 5, dc = idx & 31;
            *(LAS u32x4*)(Ks + s * RI_KS + dc * 8) = *(const u32x4*)(P + (size_t)(64 * c + s) * RIN + 2048 + hh * 256 + dc * 8); }
#pragma unroll
        for (int i = 0; i < 8; ++i) { const int idx = w.tid + 512 * i, s = idx >> 6, dc = idx & 63;
            const u32x4 vv = *(const u32x4*)(P + (size_t)(64 * c + s) * RIN + 4096 + hh * 512 + dc * 8); const unsigned e[4] = {vv.x, vv.y, vv.z, vv.w};
#pragma unroll
            for (int j = 0; j < 4; ++j) { Vt[(dc * 8 + 2 * j) * RI_VS + s] = (bf16_t)(e[j] & 0xffffu); Vt[(dc * 8 + 2 * j + 1) * RI_VS + s] = (bf16_t)(e[j] >> 16); } }
        LDS_BARRIER();
        const int qrow = 64 * c + 32 * tt + r;
        f32x16 st[2]; st[0] = zero16(); st[1] = zero16();
#pragma unroll 4
        for (int ks = 0; ks < 16; ++ks) { const bf16x8 qf = *(const bf16x8*)(P + (size_t)qrow * RIN + hh * 256 + 16 * ks + 8 * h);
#pragma unroll
            for (int si = 0; si < 2; ++si) if (si <= tt) { const bf16x8 kf = *(const LAS bf16x8*)(Ks + (32 * si + r) * RI_KS + 16 * ks + 8 * h); st[si] = MFMA32(kf, qf, st[si]); } }
        const int t = 32 * tt + r;
#pragma unroll
        for (int si = 0; si < 2; ++si)
#pragma unroll
            for (int e = 0; e < 16; ++e) { const int s = 32 * si + (e & 3) + 8 * (e >> 2) + 4 * h; st[si][e] = (s <= t) ? st[si][e] * __builtin_amdgcn_exp2f(lg2 * (float)(t - s)) : 0.f; }
        f32x16 ot[4];
#pragma unroll
        for (int d = 0; d < 4; ++d) ot[d] = zero16();
#pragma unroll
        for (int si = 0; si < 2; ++si) if (si <= tt) {
#pragma unroll
            for (int s2 = 0; s2 < 2; ++s2) { const bf16x8 pf = pack8(st[si], s2);
#pragma unroll
                for (int d = 0; d < 4; ++d) { const bf16x8 vf = ld_perm_frag(Vt + (128 * dvq + 32 * d + r) * RI_VS + 32 * si + 16 * s2 + 4 * h); ot[d] = MFMA32(vf, pf, ot[d]); } } }
#pragma unroll
        for (int d = 0; d < 4; ++d)
#pragma unroll
            for (int gq = 0; gq < 4; ++gq) { u32x2 o; o.x = pk2(ot[d][4 * gq], ot[d][4 * gq + 1]); o.y = pk2(ot[d][4 * gq + 2], ot[d][4 * gq + 3]);
                *(u32x2*)(O + (size_t)qrow * RVD + hh * 512 + 128 * dvq + 32 * d + 8 * gq + 4 * h) = o; }
    }
}
constexpr int RC_QS = 264, RC_QX = 0, RC_KZ = 33792, RC_VT = 82944, RC_OS = 107520, RC_OSS = 20, RC_BLK = 3072, RC_PT = 148480, RC_PS = 72;
constexpr int RGRP = 8, RNG = NCHP / RGRP;
#define MFMA16(a, b, c) __builtin_amdgcn_mfma_f32_16x16x32_bf16((a), (b), (c), 0, 0, 0)
DI unsigned blk_row(unsigned r) { return 32u * r + 128u * (r >> 3); }
DI unsigned tr_base(unsigned lane) { const unsigned g = lane >> 4, q = (lane & 15) >> 2, p = lane & 3; return blk_row(8 * g + q) + 8 * p; }
DI bf16x8 tr_frag(const LAS unsigned char* base_lane, int c, int ks) {
    const s16x4 lo = ds_tr(base_lane + c * RC_BLK + ks * 1536), hi = ds_tr(base_lane + c * RC_BLK + ks * 1536 + 128); return __builtin_shufflevector(lo, hi, 0, 1, 2, 3, 4, 5, 6, 7);
}
DI u32x4 scale8(u32x4 v, float s) { u32x4 o; o.x = pk2(bflo(v.x) * s, bfhi(v.x) * s); o.y = pk2(bflo(v.y) * s, bfhi(v.y) * s); o.z = pk2(bflo(v.z) * s, bfhi(v.z) * s); o.w = pk2(bflo(v.w) * s, bfhi(v.w) * s); return o; }
template <bool LOAD, bool BF> DI void ret_state_io(LAS unsigned char* L, void* gpv  , f32x4 (&S)[16], int tid, int wave) {
    LAS float* T = (LAS float*)(L + RC_QX); const int lane = tid & 63, c16 = lane & 15, g = lane >> 4; float* gp = (float*)gpv; bf16_t* gb = (bf16_t*)gpv;
#pragma unroll
    for (int p = 0; p < 4; ++p) {
        LDS_BARRIER();
        if (LOAD) {
            if (BF) {
#pragma unroll
                for (int i = 0; i < 2; ++i) { const int idx = tid + 512 * i, row = idx >> 4, c8 = idx & 15; const u32x4 v = *(const u32x4*)(gb + (size_t)(64 * p + row) * RDV + 8 * c8); LAS float* tp = T + row * 132 + 8 * c8;
                    tp[0] = bflo(v.x); tp[1] = bfhi(v.x); tp[2] = bflo(v.y); tp[3] = bfhi(v.y); tp[4] = bflo(v.z); tp[5] = bfhi(v.z); tp[6] = bflo(v.w); tp[7] = bfhi(v.w); }
            } else {
#pragma unroll
                for (int i = 0; i < 4; ++i) { const int idx = tid + 512 * i, row = idx >> 5, c4 = idx & 31; const f32x4 v = *(const f32x4*)(gp + (size_t)(64 * p + row) * RDV + 4 * c4); LAS float* tp = T + row * 132 + 4 * c4; tp[0] = v.x; tp[1] = v.y; tp[2] = v.z; tp[3] = v.w; }
            }
            LDS_BARRIER();
#pragma unroll
            for (int kq = 0; kq < 4; ++kq)
#pragma unroll
                for (int i = 0; i < 4; ++i) { const float v = T[(16 * kq + 4 * g + i) * 132 + 16 * wave + c16];
                    S[4 * p + kq][i] = v; }
        } else {
#pragma unroll
            for (int kq = 0; kq < 4; ++kq)
#pragma unroll
                for (int i = 0; i < 4; ++i) { const float v = S[4 * p + kq][i]; T[(16 * kq + 4 * g + i) * 132 + 16 * wave + c16] = v; }
            LDS_BARRIER();
            if (BF) {
#pragma unroll
                for (int i = 0; i < 2; ++i) { const int idx = tid + 512 * i, row = idx >> 4, c8 = idx & 15; const LAS float* tp = T + row * 132 + 8 * c8;
                    u32x4 o; o.x = pk2(tp[0], tp[1]); o.y = pk2(tp[2], tp[3]); o.z = pk2(tp[4], tp[5]); o.w = pk2(tp[6], tp[7]); *(u32x4*)(gb + (size_t)(64 * p + row) * RDV + 8 * c8) = o; }
            } else {
#pragma unroll
                for (int i = 0; i < 4; ++i) { const int idx = tid + 512 * i, row = idx >> 5, c4 = idx & 31; const LAS float* tp = T + row * 132 + 4 * c4; *(f32x4*)(gp + (size_t)(64 * p + row) * RDV + 4 * c4) = (f32x4){tp[0], tp[1], tp[2], tp[3]}; }
            }
        }
    }
    LDS_BARRIER();
}
template <int MODE>
DI void ret_chain_phase(const WG& w, const bf16_t* P, bf16_t* O, const float* state_in, bf16_t* slots, float* outS, int dup) {
    LAS unsigned char* L = w.lds;
    const int ntask = (MODE == 0) ? RNG * 32 : RNG * 32 + DBATCH * 32;
    for (int task = w.bid; task < ntask; task += w.G) {
        const bool smp = task >= RNG * 32; const int ts = smp ? task - RNG * 32 : task, gb = ts >> 5, hh = (ts >> 2) & 7, j = ts & 3;
        const int c_lo = smp ? NCHP + gb : RGRP * gb, nch = smp ? 1 : RGRP;
        const size_t so = ((size_t)gb * RH + hh) * RDK * RDV;
        const int dvw = 128 * j + 16 * w.wave; const float lg2 = ret_lg2(hh), gam64 = __builtin_amdgcn_exp2f(lg2 * 64.f);
        int lane0 = w.lane; asm volatile("" : "+v"(lane0));
        f32x4 S[16];
        if (MODE == 1) { if (smp) ret_state_io<true, false>(L, (void*)(state_in + so + 128 * j), S, w.tid, w.wave); else ret_state_io<true, true>(L, (void*)(slots + so + 128 * j), S, w.tid, w.wave); }
        else {
#pragma unroll
            for (int kt = 0; kt < 16; ++kt) S[kt] = (f32x4){0.f, 0.f, 0.f, 0.f}; }
        u32x4 pq[4], pk[4], pv[2];
        {   const int tid = w.tid;
#pragma unroll
            for (int i = 0; i < 4; ++i) { const int idx = tid + 512 * i, t = idx >> 5, dc = idx & 31; const bf16_t* pr = P + (size_t)(64 * c_lo + t) * RIN + hh * 256 + dc * 8;
                if (MODE == 1) pq[i] = *(const u32x4*)pr; pk[i] = *(const u32x4*)(pr + 2048); }
#pragma unroll
            for (int i = 0; i < 2; ++i) { const int idx = tid + 512 * i, t = idx >> 4, dc = idx & 15; pv[i] = *(const u32x4*)(P + (size_t)(64 * c_lo + t) * RIN + 4096 + hh * 512 + 128 * j + dc * 8); } }
#pragma unroll 1
        for (int cc = 0; cc < nch; ++cc) { const int c = c_lo + cc;
            int tid = w.tid; asm volatile("" : "+v"(tid)); const int ln = tid & 63, c16 = ln & 15, g = ln >> 4;
            LDS_BARRIER();
#pragma unroll
            for (int i = 0; i < 4; ++i) { const int idx = tid + 512 * i, t = idx >> 5, dc = idx & 31;
                if (MODE == 1) *(LAS u32x4*)(L + RC_QX + (t * RC_QS + dc * 8) * 2) = scale8(pq[i], __builtin_amdgcn_exp2f(lg2 * (float)(t + 1)));
                *(LAS u32x4*)(L + RC_KZ + (dc >> 1) * RC_BLK + blk_row(t) + (dc & 1) * 16) = scale8(pk[i], __builtin_amdgcn_exp2f(lg2 * (float)(63 - t))); }
#pragma unroll
            for (int i = 0; i < 2; ++i) { const int idx = tid + 512 * i, t = idx >> 4, dc = idx & 15; *(LAS u32x4*)(L + RC_VT + (dc >> 1) * RC_BLK + blk_row(t) + (dc & 1) * 16) = pv[i]; }
            LDS_BARRIER();
            if (cc + 1 < nch) {
#pragma unroll
                for (int i = 0; i < 4; ++i) { const int idx = tid + 512 * i, t = idx >> 5, dc = idx & 31; const bf16_t* pr = P + (size_t)(64 * (c + 1) + t) * RIN + hh * 256 + dc * 8;
                    if (MODE == 1) pq[i] = *(const u32x4*)pr; pk[i] = *(const u32x4*)(pr + 2048); }
#pragma unroll
                for (int i = 0; i < 2; ++i) { const int idx = tid + 512 * i, t = idx >> 4, dc = idx & 15; pv[i] = *(const u32x4*)(P + (size_t)(64 * (c + 1) + t) * RIN + 4096 + hh * 512 + 128 * j + dc * 8); } }
            const LAS unsigned char* kb = L + RC_KZ + tr_base(ln); const LAS unsigned char* vb = L + RC_VT + tr_base(ln) + w.wave * RC_BLK;
            const bf16x8 vf0 = tr_frag(vb, 0, 0), vf1 = tr_frag(vb, 0, 1);
            if (MODE == 1) {
                const LAS bf16_t* Qx = (const LAS bf16_t*)(L + RC_QX); LAS bf16_t* PT = (LAS bf16_t*)(L + RC_PT);
                const float gm64 = __builtin_amdgcn_exp2f(-64.f * lg2);
#pragma unroll
                for (int q2 = 0; q2 < 2; ++q2) { const int tile = w.wave + 8 * q2, tt = tile >> 2, st = tile & 3; f32x4 d = (f32x4){0.f, 0.f, 0.f, 0.f};
                    if (st <= tt) {
#pragma unroll
                        for (int ks = 0; ks < 8; ++ks) { const bf16x8 af = *(const LAS bf16x8*)(Qx + (16 * tt + c16) * RC_QS + 32 * ks + 8 * g);
                            const bf16x8 bfr = *(const LAS bf16x8*)(L + RC_KZ + (2 * ks + (g >> 1)) * RC_BLK + blk_row(16 * st + c16) + 16 * (g & 1)); d = MFMA16(af, bfr, d); } }
#pragma unroll
                    for (int i = 0; i < 4; ++i) { const int t = 16 * tt + 4 * g + i, sx = 16 * st + c16; PT[t * RC_PS + sx] = f2bf((sx <= t) ? d[i] * gm64 : 0.f); } }
                f32x4 o[4];
#pragma unroll
                for (int tt = 0; tt < 4; ++tt) o[tt] = (f32x4){0.f, 0.f, 0.f, 0.f};
#pragma unroll
                for (int kp = 0; kp < 8; ++kp) { u32x4 sp; sp.x = pk2(S[2 * kp][0], S[2 * kp][1]); sp.y = pk2(S[2 * kp][2], S[2 * kp][3]); sp.z = pk2(S[2 * kp + 1][0], S[2 * kp + 1][1]); sp.w = pk2(S[2 * kp + 1][2], S[2 * kp + 1][3]);
                    const bf16x8 sf = __builtin_bit_cast(bf16x8, sp);
#pragma unroll
                    for (int tt = 0; tt < 4; ++tt) { const LAS bf16_t* qp = Qx + (16 * tt + c16) * RC_QS + 32 * kp + 4 * g; const s16x4 lo = *(const LAS s16x4*)qp, hi = *(const LAS s16x4*)(qp + 16);
                        const bf16x8 af = __builtin_shufflevector(lo, hi, 0, 1, 2, 3, 4, 5, 6, 7); o[tt] = MFMA16(af, sf, o[tt]); } if (kp & 1) asm volatile("" ::: "memory"); }
                LDS_BARRIER();
#pragma unroll
                for (int tt = 0; tt < 4; ++tt) { const bf16x8 p0 = *(const LAS bf16x8*)(PT + (16 * tt + c16) * RC_PS + 8 * g), p1 = *(const LAS bf16x8*)(PT + (16 * tt + c16) * RC_PS + 32 + 8 * g);
                    o[tt] = MFMA16(p0, vf0, o[tt]); o[tt] = MFMA16(p1, vf1, o[tt]); }
                LAS float* os = (LAS float*)(L + RC_OS + w.wave * (64 * RC_OSS * 4));
#pragma unroll
                for (int tt = 0; tt < 4; ++tt)
#pragma unroll
                    for (int i = 0; i < 4; ++i) os[(16 * tt + 4 * g + i) * RC_OSS + c16] = o[tt][i];
                const f32x4 r0 = *(const LAS f32x4*)(os + ln * RC_OSS), r1 = *(const LAS f32x4*)(os + ln * RC_OSS + 4), r2 = *(const LAS f32x4*)(os + ln * RC_OSS + 8), r3 = *(const LAS f32x4*)(os + ln * RC_OSS + 12);
                u32x4 n0, n1; n0.x = pk2(r0.x, r0.y); n0.y = pk2(r0.z, r0.w); n0.z = pk2(r1.x, r1.y); n0.w = pk2(r1.z, r1.w); n1.x = pk2(r2.x, r2.y); n1.y = pk2(r2.z, r2.w); n1.z = pk2(r3.x, r3.y); n1.w = pk2(r3.z, r3.w);
                bf16_t* orow = O + (size_t)(64 * c + ln) * RVD + hh * 512 + dvw;
                if (!dup) { *(u32x4*)orow = n0; *(u32x4*)(orow + 8) = n1; }
            }
            if (MODE == 0 || smp || cc + 1 < nch) {
#pragma unroll
                for (int kt = 0; kt < 16; ++kt) { S[kt] = S[kt] * gam64;
                    const bf16x8 k0 = tr_frag(kb, kt, 0), k1 = tr_frag(kb, kt, 1);
                    S[kt] = MFMA16(k0, vf0, S[kt]); S[kt] = MFMA16(k1, vf1, S[kt]); if ((kt & 3) == 3) asm volatile("" ::: "memory"); }
            }
        }
        if (MODE == 0) ret_state_io<false, true>(L, (void*)(slots + so + 128 * j), S, w.tid, w.wave); else if (smp) ret_state_io<false, false>(L, (void*)(outS + so + 128 * j), S, w.tid, w.wave);
    }
}
DI void ret_prefix_phase(const WG& w, bf16_t* slots, float* outP) {
    constexpr int N8 = RH * RDK * RDV / 8;
    for (int e = w.bid * 512 + w.tid; e < N8; e += w.G * 512) { const int hh = e / (RDK * RDV / 8); const float g512 = __builtin_amdgcn_exp2f(ret_lg2(hh) * (float)(64 * RGRP));
        float carry[8];
#pragma unroll
        for (int q = 0; q < 8; ++q) carry[q] = 0.f;
#pragma unroll 8
        for (int g = 0; g < RNG; ++g) { u32x4* p = (u32x4*)slots + (size_t)g * N8 + e; const u32x4 t = *p;
            u32x4 o; o.x = pk2(carry[0], carry[1]); o.y = pk2(carry[2], carry[3]); o.z = pk2(carry[4], carry[5]); o.w = pk2(carry[6], carry[7]); *p = o;
            const float tv[8] = {bflo(t.x), bfhi(t.x), bflo(t.y), bfhi(t.y), bflo(t.z), bfhi(t.z), bflo(t.w), bfhi(t.w)};
#pragma unroll
            for (int q = 0; q < 8; ++q) carry[q] = carry[q] * g512 + tv[q]; }
        ((f32x4*)outP)[2 * e] = (f32x4){carry[0], carry[1], carry[2], carry[3]}; ((f32x4*)outP)[2 * e + 1] = (f32x4){carry[4], carry[5], carry[6], carry[7]}; }
}
DI void ret_gn_phase(const WG& w, const bf16_t* P, bf16_t* O, const float* gnw, bf16_t* Odst) {
    for (int idx0 = w.gw * 4; idx0 < M * RH; idx0 += w.ngw * 4) {
        u32x4 ov[4], gv[4];
#pragma unroll
        for (int q = 0; q < 4; ++q) { const int idx = idx0 + q, m = idx >> 3, hh = idx & 7; ov[q] = *(const u32x4*)(O + (size_t)m * RVD + hh * 512 + 8 * w.lane); gv[q] = *(const u32x4*)(P + (size_t)m * RIN + 8192 + hh * 512 + 8 * w.lane); }
#pragma unroll
        for (int q = 0; q < 4; ++q) { const int idx = idx0 + q, m = idx >> 3, hh = idx & 7;
            float x[8] = {bflo(ov[q].x), bfhi(ov[q].x), bflo(ov[q].y), bfhi(ov[q].y), bflo(ov[q].z), bfhi(ov[q].z), bflo(ov[q].w), bfhi(ov[q].w)};
            const float gt[8] = {bflo(gv[q].x), bfhi(gv[q].x), bflo(gv[q].y), bfhi(gv[q].y), bflo(gv[q].z), bfhi(gv[q].z), bflo(gv[q].w), bfhi(gv[q].w)};
            float s = 0.f;
#pragma unroll
            for (int e = 0; e < 8; ++e) s += x[e];
            const float mean = wave_sum_fast(s) * (1.f / 512.f); float s2 = 0.f;
#pragma unroll
            for (int e = 0; e < 8; ++e) { x[e] -= mean; s2 += x[e] * x[e]; }
            const float rs = 1.f / sqrtf(wave_sum_fast(s2) * (1.f / 512.f) + 1e-5f);
            const float* gp = gnw + hh * 512 + 8 * w.lane; const f32x4 g0 = *(const f32x4*)gp, g1 = *(const f32x4*)(gp + 4); const float gw8[8] = {g0.x, g0.y, g0.z, g0.w, g1.x, g1.y, g1.z, g1.w};
#pragma unroll
            for (int e = 0; e < 8; ++e) x[e] = x[e] * rs * gw8[e] * (gt[e] / (1.f + __expf(-gt[e])));
            u32x4 o; o.x = pk2(x[0], x[1]); o.y = pk2(x[2], x[3]); o.z = pk2(x[4], x[5]); o.w = pk2(x[6], x[7]); *(u32x4*)(Odst + (size_t)m * RVD + hh * 512 + 8 * w.lane) = o; }
    }
}
constexpr int REC_WT = 0, REC_BHT = 8192, REC_RT = 16384, REC_ARB = 24576, REC_VT = 32768, REC_VK = 40960, REC_AKV = 49152, REC_PL = 57344, REC = 57600;
constexpr int WSEG = 32, WNSEG = NCHP / WSEG;
constexpr size_t SEGBUF = (size_t)WSEG * WH * REC;
constexpr int PP_S = 72;
constexpr int PP_AT = 0, PP_RT = 9216, PP_BT = 18432, PP_KT = 27648, PP_KH = 36864, PP_VT = 46080, PP_AAK = 55296, PP_ARK = 64512, PP_AAB = 73728, PP_X2 = 90112, PP_PART = 106496, PP_X1 = 110592, PP_ARB = 126976, PP_BHT = 136192, PP_MT = 145408;
DI int pswap(int k) { return (k & ~12) | ((k & 4) << 1) | ((k & 8) >> 1); }

DI void copy_tile_pswap(const LAS bf16_t* T, unsigned char* dst, int task) {
    const int row = task >> 2, m = task & 3; const LAS u32x4* sp = (const LAS u32x4*)(T + row * PP_S + 16 * m); const u32x4 a = sp[0], b = sp[1];
    u32x4 o0, o1; o0.x = a.x; o0.y = a.y; o0.z = b.x; o0.w = b.y; o1.x = a.z; o1.y = a.w; o1.z = b.z; o1.w = b.w;
    u32x4* dp = (u32x4*)(dst + row * 128 + 32 * m); dp[0] = o0; dp[1] = o1;
}
DI void copy_tile_pswap_f32(const LAS float* T, unsigned char* dst, int task) {
    const int row = task >> 2, m = task & 3; const LAS f32x4* sp = (const LAS f32x4*)(T + row * 64 + 16 * m); const f32x4 a0 = sp[0], a1 = sp[1], b0 = sp[2], b1 = sp[3];
    u32x4 o0, o1; o0.x = pk2(a0.x, a0.y); o0.y = pk2(a0.z, a0.w); o0.z = pk2(b0.x, b0.y); o0.w = pk2(b0.z, b0.w); o1.x = pk2(a1.x, a1.y); o1.y = pk2(a1.z, a1.w); o1.z = pk2(b1.x, b1.y); o1.w = pk2(b1.z, b1.w);
    u32x4* dp = (u32x4*)(dst + row * 128 + 32 * m); dp[0] = o0; dp[1] = o1;
}
struct RwkvIn { const bf16_t *Rb, *Kb, *Vb, *Ab, *Gb; const float* LW; const float *k_k, *k_a, *r_k, *ln_w, *ln_b; float* bonus; bf16_t* Ob; };

struct PrepRaw { unsigned short rb[8], kb[8], vb[8], ab[8]; float lw[8]; };
DI void prep_load(const WG& w, const RwkvIn& in, int c, int hd, PrepRaw& q) {
    int lane = w.lane; asm volatile("" : "+v"(lane));
#pragma unroll
    for (int i = 0; i < 8; ++i) { const size_t off = (size_t)(64 * c + 8 * w.wave + i) * DM + hd * 64 + lane; q.rb[i] = in.Rb[off]; q.kb[i] = in.Kb[off]; q.vb[i] = in.Vb[off]; q.ab[i] = in.Ab[off]; q.lw[i] = in.LW[off]; }
}
DI void rwkv_prep_pair(const WG& w, const RwkvIn& in, int c, int hd, unsigned char* rec, const PrepRaw& raw, gu32* qctr, volatile LAS unsigned* qw) {
    LAS bf16_t* AT = (LAS bf16_t*)(w.lds + PP_AT); LAS bf16_t* RT2 = (LAS bf16_t*)(w.lds + PP_RT); LAS bf16_t* BT = (LAS bf16_t*)(w.lds + PP_BT); LAS bf16_t* KT = (LAS bf16_t*)(w.lds + PP_KT);
    LAS bf16_t* KHt = (LAS bf16_t*)(w.lds + PP_KH); LAS bf16_t* VtL = (LAS bf16_t*)(w.lds + PP_VT); LAS bf16_t* AAK = (LAS bf16_t*)(w.lds + PP_AAK); LAS bf16_t* ARK = (LAS bf16_t*)(w.lds + PP_ARK);
    LAS float* AAB = (LAS float*)(w.lds + PP_AAB); LAS float* X2 = (LAS float*)(w.lds + PP_X2); LAS float* PART = (LAS float*)(w.lds + PP_PART); LAS float* X1 = (LAS float*)(w.lds + PP_X1); LAS bf16_t* ARBT = (LAS bf16_t*)(w.lds + PP_ARB); LAS bf16_t* BHT_T = (LAS bf16_t*)(w.lds + PP_BHT);
    int lane_ = w.lane; asm volatile("" : "+v"(lane_));
    const int lane = lane_, tg = w.wave, col = hd * 64 + lane, r = lane & 31, h = lane >> 5;
    LDS_BARRIER();
    {
        const float kkc = in.k_k[col], kac = in.k_a[col], rkc = in.r_k[col];
        float rr[8], kp[8], aa[8], lw[8], kk[8], cl[8], bsum[8]; unsigned short vb[8], kb[8];
        float run = 0.f;
#pragma unroll
        for (int i = 0; i < 8; ++i) { rr[i] = bf2f(raw.rb[i]); kb[i] = raw.kb[i]; vb[i] = raw.vb[i]; aa[i] = bf2f(raw.ab[i]); lw[i] = raw.lw[i]; }
#pragma unroll
        for (int i = 0; i < 8; ++i) { const float kr = bf2f(kb[i]);
            const float kkr = kr * kkc; const float ss = wave_sum_fast(kkr * kkr); kk[i] = kkr / fmaxf(sqrtf(ss), 1e-12f); kp[i] = kr * (1.f + (aa[i] - 1.f) * kac);
            bsum[i] = wave_sum_fast(rr[i] * kp[i] * rkc);
            run += lw[i]; cl[i] = run; }
        if (lane < 8) { float bv = bsum[0];
#pragma unroll
            for (int i = 1; i < 8; ++i) bv = (lane == i) ? bsum[i] : bv;
            in.bonus[(size_t)(64 * c + 8 * tg + lane) * WH + hd] = bv; }
        PART[tg * 64 + lane] = run;
        LDS_BARRIER();
        float pre = 0.f, tot = 0.f;
#pragma unroll
        for (int t2 = 0; t2 < 8; ++t2) { const float p = PART[t2 * 64 + lane]; tot += p; if (t2 < tg) pre += p; }
        unsigned short khs[8], bhs[8];
#pragma unroll
        for (int i = 0; i < 8; ++i) { const int t = 8 * tg + i; const float cs = pre + cl[i], csp = cs - lw[i];
            const float e_cs = __expf(cs), e_ncs = __expf(-cs), e_csp = __expf(csp), e_l = __expf(tot - cs); const float b = kk[i] * aa[i];
            const unsigned short rt = f2bf(rr[i] * e_cs);
            AT[t * PP_S + lane] = f2bf(-kk[i] * e_csp); RT2[t * PP_S + lane] = rt; BT[t * PP_S + lane] = f2bf(b * e_ncs); KT[t * PP_S + lane] = f2bf(kp[i] * e_ncs);
            khs[i] = f2bf(kp[i] * e_l); bhs[i] = f2bf(b * e_l); }
        u32x4 kq, vq; kq.x = khs[0] | ((unsigned)khs[1] << 16); kq.y = khs[2] | ((unsigned)khs[3] << 16); kq.z = khs[4] | ((unsigned)khs[5] << 16); kq.w = khs[6] | ((unsigned)khs[7] << 16);
        vq.x = vb[0] | ((unsigned)vb[1] << 16); vq.y = vb[2] | ((unsigned)vb[3] << 16); vq.z = vb[4] | ((unsigned)vb[5] << 16); vq.w = vb[6] | ((unsigned)vb[7] << 16);
        *(LAS u32x4*)(KHt + lane * PP_S + 8 * tg) = kq; *(LAS u32x4*)(VtL + lane * PP_S + 8 * tg) = vq;
        { u32x4 bq; bq.x = bhs[0] | ((unsigned)bhs[1] << 16); bq.y = bhs[2] | ((unsigned)bhs[3] << 16); bq.z = bhs[4] | ((unsigned)bhs[5] << 16); bq.w = bhs[6] | ((unsigned)bhs[7] << 16);
          *(LAS u32x4*)(BHT_T + lane * PP_S + 8 * tg) = bq; }
        if (tg == 0) ((float*)(rec + REC_PL))[lane] = __expf(tot);
    }
    LDS_BARRIER();
    {
        const int pi = tg >> 1, tt = tg & 1; const LAS bf16_t* X = (pi < 2) ? AT : RT2; const LAS bf16_t* Y = (pi & 1) ? KT : BT;
#pragma unroll
        for (int si = 0; si < 2; ++si) { f32x16 d = zero16();
            if (si <= tt) {
#pragma unroll
                for (int ks = 0; ks < 4; ++ks) { const bf16x8 xa = *(const LAS bf16x8*)(X + (32 * tt + r) * PP_S + 16 * ks + 8 * h), yb = *(const LAS bf16x8*)(Y + (32 * si + r) * PP_S + 16 * ks + 8 * h);
                    d = (pi == 0) ? MFMA32(yb, xa, d) : MFMA32(xa, yb, d); } }
            if (pi == 0) {
#pragma unroll
                for (int e = 0; e < 16; ++e) { const int sx = 32 * si + (e & 3) + 8 * (e >> 2) + 4 * h, t = 32 * tt + r; AAB[sx * 64 + t] = (sx < t) ? d[e] : 0.f; }
            } else { const int sx = 32 * si + r;
#pragma unroll
                for (int e = 0; e < 16; ++e) { const int t = 32 * tt + (e & 3) + 8 * (e >> 2) + 4 * h; const bool keep = (pi < 2) ? (sx < t) : (sx <= t); const float val = keep ? d[e] : 0.f;
                    if (pi == 1) AAK[t * PP_S + sx] = f2bf(val); else if (pi == 3) ARK[t * PP_S + sx] = f2bf(val); else ARBT[t * PP_S + sx] = f2bf(val); } } }
    }
    LDS_BARRIER();
    if (tg == 7 && lane == 0) qw[0] = __hip_atomic_fetch_add(qctr, 1u, __ATOMIC_RELAXED, __HIP_MEMORY_SCOPE_AGENT);
    for (int id = tg; id < 12; id += 8) { const int prod = id >> 2, it = (id >> 1) & 1, vt = id & 1; const LAS bf16_t* Am = (prod == 0) ? AAK : (prod == 1 ? ARK : KHt);
        f32x16 d = zero16();
#pragma unroll
        for (int ks = 0; ks < 4; ++ks) { const bf16x8 a = *(const LAS bf16x8*)(Am + (32 * it + r) * PP_S + 16 * ks + 8 * h), b = *(const LAS bf16x8*)(VtL + (32 * vt + r) * PP_S + 16 * ks + 8 * h); d = MFMA32(a, b, d); }
        if (prod == 0) {
#pragma unroll
            for (int e = 0; e < 16; ++e) X2[(32 * it + (e & 3) + 8 * (e >> 2) + 4 * h) * 64 + 32 * vt + r] = d[e];
        } else { u32x4* dst = (u32x4*)(rec + (prod == 1 ? REC_AKV : REC_VK) + ((it * 2 + vt) * 64 + lane) * 32);
            u32x4 o0, o1; o0.x = pk2(d[0], d[1]); o0.y = pk2(d[2], d[3]); o0.z = pk2(d[4], d[5]); o0.w = pk2(d[6], d[7]); o1.x = pk2(d[8], d[9]); o1.y = pk2(d[10], d[11]); o1.z = pk2(d[12], d[13]); o1.w = pk2(d[14], d[15]);
            dst[0] = o0; dst[1] = o1; } }
    LAS bf16_t* MT = (LAS bf16_t*)(w.lds + PP_MT);
    if (tg >= 4) {
        const int b = tg - 4; float y[16]; const bool live = b > (lane >> 4);
        const LAS f32x4* np = (const LAS f32x4*)(AAB + lane * 64 + 16 * b); const f32x4 n0 = np[0], n1 = np[1], n2 = np[2], n3 = np[3];
        const float nv[16] = {n0.x, n0.y, n0.z, n0.w, n1.x, n1.y, n1.z, n1.w, n2.x, n2.y, n2.z, n2.w, n3.x, n3.y, n3.z, n3.w};
#pragma unroll
        for (int i2 = 0; i2 < 16; ++i2) y[i2] = live ? nv[i2] : 0.f;
#pragma unroll
        for (int i2 = 0; i2 < 15; ++i2) { const LAS f32x4* ap = (const LAS f32x4*)(AAB + (16 * b + i2) * 64 + 16 * b); const f32x4 a0 = ap[0], a1 = ap[1], a2 = ap[2], a3 = ap[3];
            const float av[16] = {a0.x, a0.y, a0.z, a0.w, a1.x, a1.y, a1.z, a1.w, a2.x, a2.y, a2.z, a2.w, a3.x, a3.y, a3.z, a3.w};
#pragma unroll
            for (int i3 = i2 + 1; i3 < 16; ++i3) y[i3] += av[i3] * y[i2]; }
#pragma unroll
        for (int i2 = 0; i2 < 16; ++i2) MT[(16 * b + i2) * PP_S + lane] = f2bf(y[i2]);
    }
    LDS_BARRIER();
    LAS bf16_t* YT0 = BT; LAS bf16_t* YT1 = KHt;
    {
        const int b = tg & 3, colw = (tg >> 2) * 64 + lane; float y[16];
#pragma unroll
        for (int i2 = 0; i2 < 16; ++i2) y[i2] = (colw < 64) ? bf2f(AT[(16 * b + i2) * PP_S + colw]) : X2[(16 * b + i2) * 64 + colw - 64];
#pragma unroll
        for (int i2 = 0; i2 < 15; ++i2) { const LAS f32x4* ap = (const LAS f32x4*)(AAB + (16 * b + i2) * 64 + 16 * b); const f32x4 a0 = ap[0], a1 = ap[1], a2 = ap[2], a3 = ap[3];
            const float av[16] = {a0.x, a0.y, a0.z, a0.w, a1.x, a1.y, a1.z, a1.w, a2.x, a2.y, a2.z, a2.w, a3.x, a3.y, a3.z, a3.w};
#pragma unroll
            for (int i3 = i2 + 1; i3 < 16; ++i3) y[i3] += av[i3] * y[i2]; }
        LAS float* yf = (colw < 64) ? X1 + colw : X2 + (colw - 64);
#pragma unroll
        for (int i2 = 0; i2 < 16; ++i2) yf[(16 * b + i2) * 64] = y[i2];
        u32x4 o0, o1; o0.x = pk2(y[0], y[1]); o0.y = pk2(y[2], y[3]); o0.z = pk2(y[4], y[5]); o0.w = pk2(y[6], y[7]); o1.x = pk2(y[8], y[9]); o1.y = pk2(y[10], y[11]); o1.z = pk2(y[12], y[13]); o1.w = pk2(y[14], y[15]);
        LAS u32x4* yp = (LAS u32x4*)(YT0 + colw * PP_S + 16 * b); yp[0] = o0; yp[1] = o1;
    }
    LDS_BARRIER();
    {
        const int rt = tg & 1, ct = tg >> 1; LAS float* Yf = (ct < 2) ? X1 + 32 * ct : X2 + 32 * (ct - 2);
        f32x16 yacc;
#pragma unroll
        for (int e2 = 0; e2 < 16; ++e2) yacc[e2] = Yf[(32 * rt + (e2 & 3) + 8 * (e2 >> 2) + 4 * h) * 64 + r];
        bf16x8 mf[4];
#pragma unroll
        for (int ks = 0; ks < 4; ++ks) mf[ks] = *(const LAS bf16x8*)(MT + (32 * rt + r) * PP_S + 16 * ks + 8 * h);
#pragma unroll
        for (int st = 0; st < 3; ++st) { const LAS bf16_t* src = (st & 1) ? YT1 : YT0; LAS bf16_t* dstt = (st & 1) ? YT0 : YT1;
            f32x16 acc = yacc;
#pragma unroll
            for (int ks = 0; ks < 4; ++ks) { const bf16x8 bfr = *(const LAS bf16x8*)(src + (32 * ct + r) * PP_S + 16 * ks + 8 * h); acc = MFMA32(mf[ks], bfr, acc); }
            if (st < 2) {
#pragma unroll
                for (int gq = 0; gq < 4; ++gq) { u32x2 o; o.x = pk2(acc[4 * gq], acc[4 * gq + 1]); o.y = pk2(acc[4 * gq + 2], acc[4 * gq + 3]); *(LAS u32x2*)(dstt + (32 * ct + r) * PP_S + 32 * rt + 8 * gq + 4 * h) = o; }
                LDS_BARRIER();
            } else if (ct < 2) {
#pragma unroll
                for (int e2 = 0; e2 < 16; ++e2) Yf[(32 * rt + (e2 & 3) + 8 * (e2 >> 2) + 4 * h) * 64 + r] = acc[e2];
            } else { u32x4* dst = (u32x4*)(rec + REC_VT + ((rt * 2 + (ct - 2)) * 64 + lane) * 32); u32x4 o0, o1;
                o0.x = pk2(acc[0], acc[1]); o0.y = pk2(acc[2], acc[3]); o0.z = pk2(acc[4], acc[5]); o0.w = pk2(acc[6], acc[7]); o1.x = pk2(acc[8], acc[9]); o1.y = pk2(acc[10], acc[11]); o1.z = pk2(acc[12], acc[13]); o1.w = pk2(acc[14], acc[15]);
                dst[0] = o0; dst[1] = o1; }
        }
    }
    LDS_BARRIER();
    for (int task = w.tid; task < 1024; task += 512) { const int which = task >> 8, tk = task & 255;
        if (which == 0) copy_tile_pswap(RT2, rec + REC_RT, tk); else if (which == 1) copy_tile_pswap(ARBT, rec + REC_ARB, tk); else if (which == 2) copy_tile_pswap(BHT_T, rec + REC_BHT, tk); else copy_tile_pswap_f32(X1, rec + REC_WT, tk); }
}
DI f32x16 ld_acc_init(const unsigned char* p) { const u32x4 a = ((const u32x4*)p)[0], b = ((const u32x4*)p)[1]; f32x16 o;
    o[0] = bflo(a.x); o[1] = bfhi(a.x); o[2] = bflo(a.y); o[3] = bfhi(a.y); o[4] = bflo(a.z); o[5] = bfhi(a.z); o[6] = bflo(a.w); o[7] = bfhi(a.w);
    o[8] = bflo(b.x); o[9] = bfhi(b.x); o[10] = bflo(b.y); o[11] = bfhi(b.y); o[12] = bflo(b.z); o[13] = bfhi(b.z); o[14] = bflo(b.w); o[15] = bfhi(b.w); return o; }
DI void rwkv_scan_task(int lane, const unsigned char* recs, size_t rec_stride, int nch, int hd, int vh, int row0, const float* s_in, float* s_out, bf16_t* Ob, int dup) {
    const int r = lane & 31, h = lane >> 5, v = 32 * vh + r;
    f32x16 sT[2];
#pragma unroll
    for (int kt = 0; kt < 2; ++kt)
#pragma unroll
        for (int e = 0; e < 16; ++e) sT[kt][e] = s_in ? s_in[v * 64 + 32 * kt + (e & 3) + 8 * (e >> 2) + 4 * h] : 0.f;
#pragma unroll 1
    for (int cc = 0; cc < nch; ++cc) { const unsigned char* rec = recs + (size_t)cc * rec_stride;
        const bf16_t* WTp = (const bf16_t*)(rec + REC_WT); const bf16_t* BHp = (const bf16_t*)(rec + REC_BHT); const bf16_t* RTp = (const bf16_t*)(rec + REC_RT); const bf16_t* ARp = (const bf16_t*)(rec + REC_ARB);
        bf16x8 Sf[2][2], Uf[2][2];
#pragma unroll
        for (int kt = 0; kt < 2; ++kt) { Sf[kt][0] = pack8(sT[kt], 0); Sf[kt][1] = pack8(sT[kt], 1); }
#pragma unroll
        for (int rt = 0; rt < 2; ++rt) { f32x16 u = ld_acc_init(rec + REC_VT + ((rt * 2 + vh) * 64 + lane) * 32);
#pragma unroll
            for (int kt = 0; kt < 2; ++kt)
#pragma unroll
                for (int s2 = 0; s2 < 2; ++s2) { const bf16x8 a = *(const bf16x8*)(WTp + (32 * rt + r) * 64 + 32 * kt + 16 * s2 + 8 * h); u = MFMA32(a, Sf[kt][s2], u); }
            Uf[rt][0] = pack8(u, 0); Uf[rt][1] = pack8(u, 1); }
        f32x16 n[2];
#pragma unroll
        for (int kt = 0; kt < 2; ++kt) { n[kt] = ld_acc_init(rec + REC_VK + ((kt * 2 + vh) * 64 + lane) * 32);
#pragma unroll
            for (int rt = 0; rt < 2; ++rt)
#pragma unroll
                for (int s2 = 0; s2 < 2; ++s2) { const bf16x8 a = *(const bf16x8*)(BHp + (32 * kt + r) * 64 + 32 * rt + 16 * s2 + 8 * h); n[kt] = MFMA32(a, Uf[rt][s2], n[kt]); } }
#pragma unroll
        for (int rt = 0; rt < 2; ++rt) { f32x16 o = ld_acc_init(rec + REC_AKV + ((rt * 2 + vh) * 64 + lane) * 32);
#pragma unroll
            for (int kt = 0; kt < 2; ++kt)
#pragma unroll
                for (int s2 = 0; s2 < 2; ++s2) { const bf16x8 a = *(const bf16x8*)(RTp + (32 * rt + r) * 64 + 32 * kt + 16 * s2 + 8 * h); o = MFMA32(a, Sf[kt][s2], o); }
#pragma unroll
            for (int r2 = 0; r2 < 2; ++r2)
#pragma unroll
                for (int s2 = 0; s2 < 2; ++s2) { const bf16x8 a = *(const bf16x8*)(ARp + (32 * rt + r) * 64 + 32 * r2 + 16 * s2 + 8 * h); o = MFMA32(a, Uf[r2][s2], o); }
#pragma unroll
            for (int e = 0; e < 16; ++e) { const unsigned short ov = f2bf(o[e]); if (!dup) Ob[(size_t)(row0 + 64 * cc + 32 * rt + (e & 3) + 8 * (e >> 2) + 4 * h) * DM + hd * 64 + v] = ov; } }
        const float* pl = (const float*)(rec + REC_PL);
#pragma unroll
        for (int kt = 0; kt < 2; ++kt)
#pragma unroll
            for (int gq = 0; gq < 4; ++gq) { const f32x4 p4 = *(const f32x4*)(pl + 32 * kt + 8 * gq + 4 * h);
#pragma unroll
                for (int i = 0; i < 4; ++i) sT[kt][4 * gq + i] = p4[i] * sT[kt][4 * gq + i] + n[kt][4 * gq + i]; }
    }
#pragma unroll
    for (int kt = 0; kt < 2; ++kt)
#pragma unroll
        for (int e = 0; e < 16; ++e) { if (!dup) s_out[v * 64 + 32 * kt + (e & 3) + 8 * (e >> 2) + 4 * h] = sT[kt][e]; }
}
constexpr int SA_SLOT = 25600  , SA_VT = 16384, SA_VK = 20480, SA_PL = 24576, SX_OFF = 4 * SA_SLOT;
DI void sc_issue(const unsigned char* recs, size_t rec_stride, int nch, int cj, LAS unsigned char* L, int wave, int lane, int vh) {
    const int ca = cj < nch ? cj : nch - 1; const unsigned char* ra = recs + (size_t)ca * rec_stride; LAS unsigned char* sa = L + (cj & 3) * SA_SLOT;
    const int row8 = lane >> 3, c16 = (lane & 7) ^ (row8 & 7);
#pragma unroll
    for (int i = 0; i < 5; ++i) { const int j = (wave - 3) + 5 * i; const unsigned char* src; LAS unsigned char* dst;
        if (j < 16) { const int m = j >> 3, blk = j & 7; src = ra + m * 8192 + (8 * blk + row8) * 128 + c16 * 16; dst = sa + m * 8192 + blk * 1024; }
        else if (j < 24) { const int jj = j - 16, a = jj >> 2, piece = jj & 3; src = ra + REC_VT + a * 8192 + ((piece >> 1) * 2 + vh) * 2048 + (piece & 1) * 1024 + lane * 16; dst = sa + SA_VT + a * 4096 + piece * 1024; }
        else { src = ra + REC_PL + (lane & 15) * 16; dst = sa + SA_PL; }
        __builtin_amdgcn_global_load_lds((const unsigned*)src, (LAS unsigned*)dst, 16, 0, 0); }
}
DI f32x16 unpack_acc(u32x4 a, u32x4 b) { f32x16 o;
    o[0] = bflo(a.x); o[1] = bfhi(a.x); o[2] = bflo(a.y); o[3] = bfhi(a.y); o[4] = bflo(a.z); o[5] = bfhi(a.z); o[6] = bflo(a.w); o[7] = bfhi(a.w);
    o[8] = bflo(b.x); o[9] = bfhi(b.x); o[10] = bflo(b.y); o[11] = bfhi(b.y); o[12] = bflo(b.z); o[13] = bfhi(b.z); o[14] = bflo(b.w); o[15] = bfhi(b.w); return o; }
DI f32x16 ld_acc_init_lds(const LAS unsigned char* p) { return unpack_acc(((const LAS u32x4*)p)[0], ((const LAS u32x4*)p)[1]); }
DI bf16x8 sc_frag(const LAS unsigned char* mat, int row, int cidx) { return *(const LAS bf16x8*)(mat + row * 128 + ((cidx ^ (row & 7)) << 4)); }
DI void rwkv_scan_prompt(const WG& w, const unsigned char* recs, size_t rec_stride, int nch, int hd, int vh, int row0, const float* s_in, float* s_out, bf16_t* Ob, int dup) {
    const int lane = w.lane, wave = w.wave, r = lane & 31, h = lane >> 5, v = 32 * vh + r;
    LAS unsigned char* L = w.lds;
    if (wave == 0) {
        f32x16 sT[2];
#pragma unroll
        for (int kt = 0; kt < 2; ++kt)
#pragma unroll
            for (int e = 0; e < 16; ++e) sT[kt][e] = s_in ? s_in[v * 64 + 32 * kt + (e & 3) + 8 * (e >> 2) + 4 * h] : 0.f;
#pragma unroll
        for (int kt = 0; kt < 2; ++kt)
#pragma unroll
            for (int e = 0; e < 16; ++e) asm volatile("" : "+v"(sT[kt][e]));
        LDS_BARRIER();
#pragma unroll 1
        for (int cc = 0; cc < nch + 2; ++cc) {
            if (cc < nch && dup != 3) { const LAS unsigned char* sa = L + (cc & 3) * SA_SLOT; LAS unsigned char* ex = L + SX_OFF + (cc % 3) * 8192;
                bf16x8 Sf[4], Uf[4];
#pragma unroll
                for (int q = 0; q < 4; ++q) { Sf[q] = pack8(sT[q >> 1], q & 1); *(LAS bf16x8*)(ex + q * 1024 + lane * 16) = Sf[q]; }
                {   bf16x8 fa[2][4]; f32x16 u[2];
#pragma unroll
                    for (int rt = 0; rt < 2; ++rt) { u[rt] = ld_acc_init_lds(sa + SA_VT + rt * 2048 + lane * 32);
#pragma unroll
                        for (int q = 0; q < 4; ++q) fa[rt][q] = sc_frag(sa, 32 * rt + r, 2 * q + h); }
                    __builtin_amdgcn_sched_barrier(0);
#pragma unroll
                    for (int q = 0; q < 4; ++q)
#pragma unroll
                        for (int rt = 0; rt < 2; ++rt) u[rt] = MFMA32(fa[rt][q], Sf[q], u[rt]);
#pragma unroll
                    for (int q = 0; q < 4; ++q) { Uf[q] = pack8(u[q >> 1], q & 1); *(LAS bf16x8*)(ex + 4096 + q * 1024 + lane * 16) = Uf[q]; } }
                f32x16 n[2];
                {   bf16x8 fa[2][4];
#pragma unroll
                    for (int kt = 0; kt < 2; ++kt) { n[kt] = ld_acc_init_lds(sa + SA_VK + kt * 2048 + lane * 32);
#pragma unroll
                        for (int q = 0; q < 4; ++q) fa[kt][q] = sc_frag(sa + 8192, 32 * kt + r, 2 * q + h); }
                    __builtin_amdgcn_sched_barrier(0);
#pragma unroll
                    for (int q = 0; q < 4; ++q)
#pragma unroll
                        for (int kt = 0; kt < 2; ++kt) n[kt] = MFMA32(fa[kt][q], Uf[q], n[kt]); }
                const LAS float* pl = (const LAS float*)(sa + SA_PL);
#pragma unroll
                for (int kt = 0; kt < 2; ++kt)
#pragma unroll
                    for (int gq = 0; gq < 4; ++gq) { const f32x4 p4 = *(const LAS f32x4*)(pl + 32 * kt + 8 * gq + 4 * h);
#pragma unroll
                        for (int i = 0; i < 4; ++i) sT[kt][4 * gq + i] = p4[i] * sT[kt][4 * gq + i] + n[kt][4 * gq + i]; }
            }
            LDS_BARRIER();
        }
        LDS_BARRIER();
#pragma unroll
        for (int kt = 0; kt < 2; ++kt)
#pragma unroll
            for (int e = 0; e < 16; ++e) { if (!dup) s_out[v * 64 + 32 * kt + (e & 3) + 8 * (e >> 2) + 4 * h] = sT[kt][e]; }
    } else if (wave < 3) {
        bf16x8 gr[2][4], gu[2][4]; u32x4 ga[2][2];
        LDS_BARRIER();
#pragma unroll 1
        for (int cc = 0; cc < nch + 2; ++cc) {
            if ((((cc ^ wave) & 1) != 0) && dup != 3) { const int c2 = cc - 2;
                if (c2 >= 0) { const LAS unsigned char* ex = L + SX_OFF + (c2 % 3) * 8192;
                    bf16x8 Sf[4], Uf[4];
#pragma unroll
                    for (int q = 0; q < 4; ++q) { Sf[q] = *(const LAS bf16x8*)(ex + q * 1024 + lane * 16); Uf[q] = *(const LAS bf16x8*)(ex + 4096 + q * 1024 + lane * 16); }
                    f32x16 o[2];
#pragma unroll
                    for (int rt = 0; rt < 2; ++rt) o[rt] = unpack_acc(ga[rt][0], ga[rt][1]);
#pragma unroll
                    for (int q = 0; q < 4; ++q)
#pragma unroll
                        for (int rt = 0; rt < 2; ++rt) o[rt] = MFMA32(gr[rt][q], Sf[q], o[rt]);
#pragma unroll
                    for (int q = 0; q < 4; ++q)
#pragma unroll
                        for (int rt = 0; rt < 2; ++rt) o[rt] = MFMA32(gu[rt][q], Uf[q], o[rt]);
                    bf16_t* op = Ob + (size_t)(row0 + 64 * c2 + 4 * h) * DM + hd * 64 + v;
#pragma unroll
                    for (int rt = 0; rt < 2; ++rt)
#pragma unroll
                        for (int e = 0; e < 16; ++e) { const unsigned short ov = f2bf(o[rt][e]); if (!dup) op[(size_t)(32 * rt + (e & 3) + 8 * (e >> 2)) * DM] = ov; }
                }
                if (cc < nch) { const unsigned char* rec = recs + (size_t)cc * rec_stride;
#pragma unroll
                    for (int rt = 0; rt < 2; ++rt) { const u32x4* ap = (const u32x4*)(rec + REC_AKV + ((rt * 2 + vh) * 64 + lane) * 32); ga[rt][0] = ap[0]; ga[rt][1] = ap[1];
#pragma unroll
                        for (int q = 0; q < 4; ++q) { gr[rt][q] = *(const bf16x8*)(rec + REC_RT + ((32 * rt + r) * 64 + 16 * q + 8 * h) * 2); gu[rt][q] = *(const bf16x8*)(rec + REC_ARB + ((32 * rt + r) * 64 + 16 * q + 8 * h) * 2); } } }
            }
            LDS_BARRIER();
        }
        LDS_BARRIER();
    } else {
        sc_issue(recs, rec_stride, nch, 0, L, wave, lane, vh); sc_issue(recs, rec_stride, nch, 1, L, wave, lane, vh); sc_issue(recs, rec_stride, nch, 2, L, wave, lane, vh); asm volatile("s_waitcnt vmcnt(10)" ::: "memory");
        LDS_BARRIER();
#pragma unroll 1
        for (int cc = 0; cc < nch + 2; ++cc) { sc_issue(recs, rec_stride, nch, cc + 3, L, wave, lane, vh); if (dup != 2) asm volatile("s_waitcnt vmcnt(10)" ::: "memory");
            LDS_BARRIER(); }
        asm volatile("s_waitcnt vmcnt(0)" ::: "memory");
        LDS_BARRIER();
    }
}
DI float sum8_dpp(float v) {
#define DPP_ADD_(ctrl) v += __builtin_bit_cast(float, __builtin_amdgcn_update_dpp(0, __builtin_bit_cast(int, v), ctrl, 0xf, 0xf, true));
    DPP_ADD_(0xB1) DPP_ADD_(0x4E) DPP_ADD_(0x141)
#undef DPP_ADD_
    return v;
}
constexpr int FIN_RPW = 36, FIN_RG_A = (MP - 64 * WSEG) / FIN_RPW  , FIN_RG_B = (MP + FIN_RPW - 1) / FIN_RPW  ;
template <bool EARLY> DI void rwkv_final_phase(const WG& w, const RwkvIn& in, bf16_t* Odst, int gw, int ngw) {
    constexpr int RPW = FIN_RPW, NRG = M / RPW, NE = FIN_RG_A + (NRG - FIN_RG_B), NL = FIN_RG_B - FIN_RG_A;
    for (int task = gw; task < 4 * (EARLY ? NE : NL); task += ngw) { const int cq = task & 3, ix = task >> 2, rg = EARLY ? (ix < FIN_RG_A ? ix : ix - FIN_RG_A + FIN_RG_B) : ix + FIN_RG_A, m0 = rg * RPW, c0 = 512 * cq + 8 * w.lane, hd = c0 >> 6;
        const f32x4 w0 = *(const f32x4*)(in.ln_w + c0), w1 = *(const f32x4*)(in.ln_w + c0 + 4), b0 = *(const f32x4*)(in.ln_b + c0), b1 = *(const f32x4*)(in.ln_b + c0 + 4);
        const float lw8[8] = {w0.x, w0.y, w0.z, w0.w, w1.x, w1.y, w1.z, w1.w}, lb8[8] = {b0.x, b0.y, b0.z, b0.w, b1.x, b1.y, b1.z, b1.w};
#pragma unroll 4
        for (int rr = 0; rr < RPW; ++rr) { const int m = m0 + rr; const size_t off = (size_t)m * DM + c0;
            const u32x4 ov = *(const u32x4*)(in.Ob + off), vv = *(const u32x4*)(in.Vb + off), gv = *(const u32x4*)(in.Gb + off);
            const float bon = in.bonus[(size_t)m * WH + hd];
            float o[8] = {bflo(ov.x), bfhi(ov.x), bflo(ov.y), bfhi(ov.y), bflo(ov.z), bfhi(ov.z), bflo(ov.w), bfhi(ov.w)};
            const float vf[8] = {bflo(vv.x), bfhi(vv.x), bflo(vv.y), bfhi(vv.y), bflo(vv.z), bfhi(vv.z), bflo(vv.w), bfhi(vv.w)};
            const float gf[8] = {bflo(gv.x), bfhi(gv.x), bflo(gv.y), bfhi(gv.y), bflo(gv.z), bfhi(gv.z), bflo(gv.w), bfhi(gv.w)};
            float s1 = 0.f;
#pragma unroll
            for (int e = 0; e < 8; ++e) s1 += o[e];
            const float mean = sum8_dpp(s1) * (1.f / 64.f); float s2 = 0.f;
#pragma unroll
            for (int e = 0; e < 8; ++e) { o[e] -= mean; s2 += o[e] * o[e]; }
            const float rs = 1.f / sqrtf(sum8_dpp(s2) * (1.f / 64.f) + 64e-5f);
#pragma unroll
            for (int e = 0; e < 8; ++e) o[e] = (o[e] * rs * lw8[e] + lb8[e] + bon * vf[e]) * gf[e];
            u32x4 r; r.x = pk2(o[0], o[1]); r.y = pk2(o[2], o[3]); r.z = pk2(o[4], o[5]); r.w = pk2(o[6], o[7]); *(u32x4*)(Odst + off) = r; }
    }
}
DI void rwkv_phi(const WG& w, const RwkvIn& in, int k, unsigned char* seg0, unsigned char* seg1, unsigned char* sbuf, const float* st_in, float* outP, float* outS, int dup, gu32* qctr, volatile LAS unsigned* qw) {
    if (k >= 1 && w.bid < 64) {
        const int sg = k - 1, hd = w.bid >> 1, vh = w.bid & 1; const unsigned char* sb = (sg & 1) ? seg1 : seg0; float* st = outP + (size_t)hd * 4096;
        rwkv_scan_prompt(w, sb + (size_t)hd * REC, (size_t)WH * REC, WSEG, hd, vh, 64 * WSEG * sg, sg == 0 ? nullptr : st, st, in.Ob, dup);
    }
    {
        const int nseg = (k < WNSEG) ? WSEG * WH : 0, nsmp = (k == 1 || k == 2) ? 512 : 0, lo = (k - 1) * 512, ntot = nseg + nsmp;
        unsigned char* sb = (k & 1) ? seg1 : seg0;
#define PAIR_OF(q, cvar, hvar, rvar) { if ((q) < nseg) { cvar = WSEG * k + ((q) >> 5); hvar = (q) & 31; rvar = sb + (size_t)(q) * REC; } else { const int p_ = lo + (q) - nseg; cvar = NCHP + (p_ >> 5); hvar = p_ & 31; rvar = sbuf + (size_t)p_ * REC; } }
#define Q_FETCH(var) { if (w.tid == 0) qw[0] = __hip_atomic_fetch_add(qctr, 1u, __ATOMIC_RELAXED, __HIP_MEMORY_SCOPE_AGENT); LDS_BARRIER(); var = (int)qw[0]; LDS_BARRIER(); }
        if (ntot > 0) {
            PrepRaw cur, nxt; int q, qn; Q_FETCH(q) Q_FETCH(qn)
            if (q < ntot) { int c0, h0; unsigned char* r0; PAIR_OF(q, c0, h0, r0) (void)r0; prep_load(w, in, c0, h0, cur); }
#pragma unroll 1
            while (q < ntot) { int cc_, hh_; unsigned char* rr_; PAIR_OF(q, cc_, hh_, rr_)
                if (qn < ntot) { int c1, h1; unsigned char* r1; PAIR_OF(qn, c1, h1, r1) (void)r1; prep_load(w, in, c1, h1, nxt); }
                rwkv_prep_pair(w, in, cc_, hh_, rr_, cur, qctr, qw);
                const int q2 = (int)qw[0];
                cur = nxt; q = qn; qn = q2; }
        }
#undef Q_FETCH
#undef PAIR_OF
    }
    if (k == 3) { const int nb = w.G, b0 = w.bid;
        for (int id = b0 * 8 + w.wave; id < DBATCH * WH * 2; id += nb * 8) { const int p = id >> 1, vh = id & 1, b = p >> 5, hd = p & 31;
            rwkv_scan_task(w.lane, sbuf + (size_t)p * REC, 0, 1, hd, vh, MP + 64 * b, st_in + (size_t)p * 4096, outS + (size_t)p * 4096, in.Ob, dup); } }
    if (k == WNSEG && w.bid >= 64 && !dup) rwkv_final_phase<true>(w, in, in.Ob, (w.bid - 64) * 8 + w.wave, (w.G - 64) * 8);
}
constexpr size_t MiB = (size_t)1 << 20;
constexpr size_t WS_CTL = 0, CTL_ZERO_BYTES = 1 * MiB;
constexpr size_t WS_WUP = 1 * MiB, WS_WDN = 33 * MiB, WS_WMIX = 65 * MiB, WS_H = 129 * MiB, WS_BIG = 201 * MiB, WS_SS = WS_BIG + 777 * MiB, WS_WUP2 = WS_SS + 23 * MiB, WS_END = WS_WUP2 + 32 * MiB;
constexpr size_t U72 = 72 * MiB;
constexpr int CW_BAR = 4096, CW_QUEUE = 16384, CW_SPLIT = 65536;
constexpr int LDS_BYTES = 163840, LDSCTL_OFF = LDS_BYTES - 512, MISC_OFF = LDSCTL_OFF + 320;
constexpr int NPHASE = 36;

constexpr size_t O_Y = 0, O_KP = (size_t)M * DM, O_VP = O_KP + 65536, O_KS = O_VP + 65536, O_VS = O_KS + 2097152, O_RP = O_VS + 2097152, O_RS = O_RP + 1048576,
                 O_WP = O_RS + 33554432, O_WS = O_WP + 131072, O_SHP = O_WS + 4194304, O_SHS = O_SHP + 2048, O_END = O_SHS + 65536;

struct Args { const float* in[34]; float* out; unsigned char* ws; int ph_lo, ph_hi, dup, pad; };

DI void up_convert(const WG& w, const Args& a, int layer, int b0, int nb, int part = 0) { convert_w(w, a.in[32] + (size_t)layer * DM * DFF, DM, DFF, (bf16_t*)(a.ws + ((layer & 1) ? WS_WUP2 : WS_WUP)), DM, DFF, a.in[8] + (size_t)layer * DM, b0, nb, part); }
DI void dn_convert(const WG& w, const Args& a, int layer, int b0, int nb, int part = 0) { convert_w(w, a.in[33] + (size_t)layer * DFF * DM, DFF, DM, (bf16_t*)(a.ws + WS_WDN), DFF, DM, nullptr, b0, nb, part); }
DI void attn_convert(const WG& w, const Args& a, int j, int layer, int b0, int nb, int part = 0) {
    convert_w(w, a.in[10] + (size_t)j * DM * AQKV, DM, AQKV, (bf16_t*)(a.ws + WS_WMIX), DM, AQKV, a.in[7] + (size_t)layer * DM, b0, nb, part);
    convert_w(w, a.in[12] + (size_t)j * DM * DM, DM, DM, (bf16_t*)(a.ws + WS_WMIX + 10 * MiB), DM, DM, nullptr, b0, nb, part);
}
DI void ret_convert(const WG& w, const Args& a, int b0, int nb, int part = 0) {
    convert_w(w, a.in[13], DM, RIN, (bf16_t*)(a.ws + WS_WMIX), DM, RIN, a.in[7] + 1 * DM, b0, nb, part); convert_w(w, a.in[15], RVD, DM, (bf16_t*)(a.ws + WS_WMIX + 48 * MiB), RVD, DM, nullptr, b0, nb, part);
}
DI void rwkv_convert(const WG& w, const Args& a, int b0, int nb, int part = 0) {
    unsigned char* WMIX = a.ws + WS_WMIX;
#pragma unroll 1
    for (int z = 0; z < 3; ++z) convert_w(w, a.in[17] + (size_t)z * DM * DM, DM, DM, (bf16_t*)(WMIX + (size_t)z * 8 * MiB), DM, DM, nullptr, b0, nb, part);
    convert_w(w, a.in[18], DM, DM, (bf16_t*)(WMIX + 24 * MiB), DM, DM, nullptr, b0, nb, part);
    convert_w(w, a.in[20], DM, 96, (bf16_t*)(WMIX + 32 * MiB), DM, 256, nullptr, b0, nb, part); convert_w(w, a.in[23], DM, 96, (bf16_t*)(WMIX + 33 * MiB), DM, 256, nullptr, b0, nb, part); convert_w(w, a.in[25], DM, 256, (bf16_t*)(WMIX + 34 * MiB), DM, 256, nullptr, b0, nb, part);
    convert_w(w, a.in[21], 96, DM, (bf16_t*)(WMIX + 35 * MiB), 256, DM, nullptr, b0, nb, part); convert_w(w, a.in[24], 96, DM, (bf16_t*)(WMIX + 36 * MiB), 256, DM, nullptr, b0, nb, part); convert_w(w, a.in[26], 256, DM, (bf16_t*)(WMIX + 37 * MiB), 256, DM, nullptr, b0, nb, part);
}

__global__ void __launch_bounds__(512, 2) fwd_kernel(Args args) {
    extern __shared__ __attribute__((aligned(16))) unsigned char lds_raw[];
    WG w; w.lds = (LAS unsigned char*)lds_raw; w.tid = threadIdx.x; w.lane = w.tid & 63; w.wave = __builtin_amdgcn_readfirstlane(w.tid >> 6);
    w.G = gridDim.x; w.bid = blockIdx.x; w.gw = w.bid * 8 + w.wave; w.ngw = w.G * 8;
    volatile LAS unsigned* MISC = (volatile LAS unsigned*)(w.lds + MISC_OFF);
    for (int u = w.tid; u < (LDS_BYTES - LDSCTL_OFF) / 4; u += 512) ((LAS unsigned*)(w.lds + LDSCTL_OFF))[u] = 0u;
    __syncthreads();
    unsigned char* ws = args.ws; gu32* ctl = (gu32*)(ws + WS_CTL);
    XcdBarrier bar; bar.bar = (unsigned*)(ctl + CW_BAR); bar.x = 0; bar.st = nullptr;
#if !MK_PER_PHASE
    bar = xcd_barrier_post((unsigned*)(ctl + CW_BAR), MISC + 8, w.wave);
#endif
    const int lo = args.ph_lo, hi = args.ph_hi;
    bf16_t* XBO = args.dup ? (bf16_t*)(ws + WS_BIG + 432 * MiB) : (bf16_t*)(ws + WS_H); const size_t ssd = args.dup ? ((WS_BIG + 504 * MiB) - WS_SS) / 4 : 0;
    bf16_t* XB = (bf16_t*)(ws + WS_H);
    float* SS = (float*)(ws + WS_SS);
    bf16_t* WUP = (bf16_t*)(ws + WS_WUP); bf16_t* WUP2 = (bf16_t*)(ws + WS_WUP2); bf16_t* WDN = (bf16_t*)(ws + WS_WDN); unsigned char* WMIX = ws + WS_WMIX; unsigned char* BIG = ws + WS_BIG;
    const float* norm_mix = args.in[7];
    int ph = 0;
#if MK_PER_PHASE
#define SEAM() do { } while (0)
#else
#define SEAM() xcd_barrier(bar, w.wave)
#endif
#define PH_BEGIN if (ph >= lo && ph < hi) { { const int l_ = lane_now(); w.lane = l_; w.tid = w.wave * 64 + l_; }
#define PH_END   if (ph + 1 < hi) SEAM(); } ++ph;
#define GEMM_LDS ((PG8_LAS unsigned char*)w.lds)
#define SSQ(s) (SS + (size_t)(s) * M * 32)
#define RSTAB ((const LAS float*)(w.lds + pg8::RSTAB_OFF))
#define SK_SLAB ((float*)(BIG + 300 * MiB))
#define SK_CNT ((unsigned*)(ctl + CW_SPLIT + (size_t)(ph * 16 + (args.dup & 15)) * 256))
#define SK_SETUP if (w.tid == 0) { volatile LAS unsigned long long* skp_ = (volatile LAS unsigned long long*)(w.lds + pg8::SK_LDS_OFF); skp_[0] = (unsigned long long)SK_SLAB; }
#define GEMM_RESID_SK(Aexpr, Wexpr, Kdim, ssq_, nsl_) { pg8::Gemm g{Aexpr, Wexpr, M, DM, Kdim, 0, 0}; pg8::Order S; S.init_full_rounds(M, DM, w.G, w.bid); pg8::EpiResid E{nullptr, nullptr, XBO, ssq_}; pg8::gemm_phase<pg8::EpiResid>(GEMM_LDS, g, S, E, w.wave); \
        pg8::OrderSK S2; S2.init(M, DM, w.G, w.bid, nsl_); pg8::Unit u2; if (!(args.dup & 32) && S2.next(0, u2, (Kdim) / 64)) { SK_SETUP const int st_ = w.bid % (w.G >> 2), ks_ = w.bid / (w.G >> 2); pg8::EpiSlab E2{(const LAS unsigned*)(w.lds + pg8::SK_LDS_OFF), st_ * 4 + ks_}; \
            pg8::gemm_phase<pg8::EpiSlab, true, true, true, pg8::OrderSK>(GEMM_LDS, g, S2, E2, w.wave); pg8::sk_reduce(w.lds, SK_SLAB, SK_CNT, u2, st_, ks_, nsl_, XBO, ssq_, w.wave); } }
#define TAIL_SK 192
#define TAIL_B0 64
#define MLP_PHASES(s_in, nsl_, wup_, tail_stmt) \
    PH_BEGIN { pg8::Gemm g{XB, wup_, M, DFF, DM, 0, 0}; pg8::Order S; S.init(M, DFF, 1, w.G, w.bid); pg8::fill_rs_table(w.lds, S, SSQ(s_in), w.tid); pg8::EpiRelu2 E{(bf16_t*)BIG, DFF, RSTAB}; pg8::gemm_phase<pg8::EpiRelu2>(GEMM_LDS, g, S, E, w.wave); } PH_END \
    PH_BEGIN { GEMM_RESID_SK((bf16_t*)BIG, WDN, DFF, SSQ((s_in) + 1) + ssd, nsl_) if (!(args.dup & 16)) { tail_stmt } } PH_END
#define ATTN_PHASES(j, resP_, resS_, s_in, tail_stmt) { \
    bf16_t* Qb = (bf16_t*)BIG; bf16_t* Kb = (bf16_t*)(BIG + 72 * MiB); bf16_t* Vb = (bf16_t*)(BIG + 81 * MiB); bf16_t* AO = (bf16_t*)(BIG + 90 * MiB); \
    const float* ck = args.in[2] + (size_t)(j) * 1048576; const float* cv = args.in[3] + (size_t)(j) * 1048576; \
    float* kS = args.out + O_KS + (size_t)(j) * 1048576; float* vS = args.out + O_VS + (size_t)(j) * 1048576; \
    PH_BEGIN { pg8::Gemm g{XB, (bf16_t*)WMIX, M, AQKV, DM, 0, 0}; pg8::Order S; S.init(M, AQKV, 1, w.G, w.bid); pg8::fill_rs_table(w.lds, S, SSQ(s_in), w.tid); pg8::EpiAttnQKV E{Qb, args.out, O_KP + (size_t)(j) * 32768, O_KS + (size_t)(j) * 1048576, RSTAB}; pg8::gemm_phase<pg8::EpiAttnQKV>(GEMM_LDS, g, S, E, w.wave); } PH_END \
    PH_BEGIN attn_phase(w, Qb, Kb, Vb, ck, cv, args.in[11] + (j) * AH, AO); cache_shift(w, ck, cv, kS, vS); PH_END \
    PH_BEGIN { pg8::Gemm g{AO, (bf16_t*)(WMIX + 10 * MiB), M, DM, DM, 0, 0}; pg8::Order S; S.init(M, DM, 1, w.G, w.bid); pg8::EpiResid E{resP_, resS_, XBO, SSQ((s_in) + 1) + ssd}; pg8::gemm_phase<pg8::EpiResid>(GEMM_LDS, g, S, E, w.wave); tail_stmt } PH_END }

    PH_BEGIN rows0(w, args.in[0], args.in[1], XB, SSQ(0)); attn_convert(w, args, 0, 0, 0, 0); up_convert(w, args, 0, 0, 0); PH_END
    ATTN_PHASES(0, args.in[0], args.in[1], 0, dn_convert(w, args, 0, TAIL_B0, w.G - TAIL_B0); up_convert(w, args, 1, TAIL_B0, w.G - TAIL_B0);)
    MLP_PHASES(1, 3, WUP, ret_convert(w, args, TAIL_SK, w.G - TAIL_SK);)
    {
        bf16_t* P = (bf16_t*)BIG; bf16_t* RO = (bf16_t*)(BIG + 432 * MiB);
        PH_BEGIN { pg8::Gemm g{XB, (bf16_t*)WMIX, M, RIN, DM, 0, 0}; pg8::Order S; S.init(M, RIN, 1, w.G, w.bid); pg8::fill_rs_table(w.lds, S, SSQ(2), w.tid); pg8::EpiRetProj E{P, RSTAB}; pg8::gemm_phase<pg8::EpiRetProj>(GEMM_LDS, g, S, E, w.wave); } PH_END
        bf16_t* slots = (bf16_t*)(BIG + 576 * MiB);
        PH_BEGIN ret_chain_phase<0>(w, P, RO, args.in[4], slots, args.out + O_RS, 0); PH_END
        PH_BEGIN ret_prefix_phase(w, slots, args.out + O_RP); PH_END
        PH_BEGIN ret_chain_phase<1>(w, P, RO, args.in[4], slots, args.out + O_RS, args.dup); PH_END
        PH_BEGIN ret_gn_phase(w, P, RO, args.in[14], args.dup ? (bf16_t*)(BIG + 576 * MiB) : RO); PH_END
        PH_BEGIN { GEMM_RESID_SK(RO, (bf16_t*)(WMIX + 48 * MiB), RVD, SSQ(3) + ssd, 3) dn_convert(w, args, 1, TAIL_SK, w.G - TAIL_SK); } PH_END
    }
    MLP_PHASES(3, 3, WUP2, rwkv_convert(w, args, TAIL_SK, w.G - TAIL_SK); up_convert(w, args, 2, TAIL_SK, w.G - TAIL_SK);)
    {
        bf16_t* XL = (bf16_t*)BIG; bf16_t* Rb = (bf16_t*)(BIG + 432 * MiB); bf16_t* L1 = (bf16_t*)(BIG + 648 * MiB);
        float* LW = (float*)BIG; bf16_t* Ab = (bf16_t*)(BIG + 144 * MiB); bf16_t* Gb = (bf16_t*)(BIG + 216 * MiB);
        unsigned char* seg0 = BIG + 288 * MiB; unsigned char* seg1 = BIG + 345 * MiB; float* bonus = (float*)(BIG + 402 * MiB); unsigned char* sbuf = BIG + 648 * MiB;
        bf16_t* Ob = (bf16_t*)(BIG + 705 * MiB);
        RwkvIn rin{Rb, Rb + (size_t)M * DM, Rb + (size_t)2 * M * DM, Ab, Gb, LW, args.in[27], args.in[28], args.in[29], args.in[30], args.in[31], bonus, Ob};
        PH_BEGIN lerp_rows(w, XB, SSQ(4), norm_mix + 2 * DM, args.in[6], args.in[16], XL, args.out + O_SHP, args.out + O_SHS); PH_END
        PH_BEGIN { { pg8::Gemm g{XL, (bf16_t*)WMIX, M, DM, DM, U72, 8 * MiB}; pg8::Order S; S.init(M, DM, 3, w.G, w.bid); pg8::EpiAct E{Rb, DM, (size_t)M * DM, 0, (const LAS float*)nullptr}; pg8::gemm_phase<pg8::EpiAct>(GEMM_LDS, g, S, E, w.wave); }
                   { pg8::Gemm g{XL + (size_t)3 * M * DM, (bf16_t*)(WMIX + 32 * MiB), M, 256, DM, U72, 1 * MiB}; pg8::Order S; S.init(M, 256, 3, w.G, w.bid); pg8::EpiAct E{L1, 256, (size_t)M * 256, 2 | (0 << 4) | (3 << 8), (const LAS float*)nullptr}; pg8::gemm_phase<pg8::EpiAct>(GEMM_LDS, g, S, E, w.wave); } } PH_END
        PH_BEGIN { int k2 = 256; asm volatile("" : "+s"(k2));     pg8::Gemm g{L1, (bf16_t*)(WMIX + 35 * MiB), M, DM, k2, (size_t)M * 256 * 2, 1 * MiB}; pg8::Order S; S.init(M, DM, 3, w.G, w.bid); pg8::EpiRwkv2 E{LW, Ab, args.in[19], args.in[22]}; pg8::gemm_phase<pg8::EpiRwkv2>(GEMM_LDS, g, S, E, w.wave); } PH_END
#pragma unroll 1
        for (int k = 0; k < 9; ++k) { PH_BEGIN rwkv_phi(w, rin, k, seg0, seg1, sbuf, args.in[5], args.out + O_WP, args.out + O_WS, args.dup, ctl + CW_QUEUE + 64 * (k + 16 * (args.dup & 15)), MISC + 16); PH_END }
        PH_BEGIN rwkv_final_phase<false>(w, rin, args.dup ? (bf16_t*)(BIG + 576 * MiB) : Ob, w.gw, w.ngw); PH_END
        PH_BEGIN { pg8::Gemm g{Ob, (bf16_t*)(WMIX + 24 * MiB), M, DM, DM, 0, 0}; pg8::Order S; S.init(M, DM, 1, w.G, w.bid); pg8::EpiResid E{nullptr, nullptr, XBO, SSQ(5) + ssd}; pg8::gemm_phase<pg8::EpiResid>(GEMM_LDS, g, S, E, w.wave); dn_convert(w, args, 2, TAIL_B0, w.G - TAIL_B0); up_convert(w, args, 3, TAIL_B0, w.G - TAIL_B0); } PH_END
    }
    MLP_PHASES(5, 3, WUP, attn_convert(w, args, 1, 3, TAIL_SK, w.G - TAIL_SK);)
    ATTN_PHASES(1, (const float*)nullptr, (const float*)nullptr, 6, dn_convert(w, args, 3, TAIL_B0, w.G - TAIL_B0);)
    PH_BEGIN { pg8::Gemm g{XB, WUP2, M, DFF, DM, 0, 0}; pg8::Order S; S.init(M, DFF, 1, w.G, w.bid); pg8::fill_rs_table(w.lds, S, SSQ(7), w.tid); pg8::EpiRelu2 E{(bf16_t*)BIG, DFF, RSTAB}; pg8::gemm_phase<pg8::EpiRelu2>(GEMM_LDS, g, S, E, w.wave); } PH_END
    PH_BEGIN { GEMM_RESID_SK((bf16_t*)BIG, WDN, DFF, SSQ(8) + ssd, 3) } PH_END
    PH_BEGIN final_norm(w, XB, SSQ(8), args.in[9], args.out); PH_END
}

extern "C" void kernel_launch(void* const* d_in, const int* in_sizes, int n_in, void* d_out, int out_size, void* d_ws, size_t ws_size, hipStream_t stream) {
    static int grid = 0;
    if (grid == 0) {
        if (n_in != 34 || (size_t)out_size != O_END || ws_size < WS_END) { fprintf(stderr, "kernel_launch: unexpected shapes: n_in %d out %d ws %zu (need %zu)\n", n_in, out_size, ws_size, (size_t)WS_END); grid = -1; return; }
        int dev = 0, cus = 0;
        if (hipGetDevice(&dev) != hipSuccess || hipDeviceGetAttribute(&cus, hipDeviceAttributeMultiprocessorCount, dev) != hipSuccess) { grid = -1; return; }
        if (hipFuncSetAttribute((const void*)fwd_kernel, hipFuncAttributeMaxDynamicSharedMemorySize, LDS_BYTES) != hipSuccess) { fprintf(stderr, "kernel_launch: hipFuncSetAttribute failed\n"); grid = -1; return; }
        int per_cu = 0;
        if (hipOccupancyMaxActiveBlocksPerMultiprocessor(&per_cu, (const void*)fwd_kernel, 512, LDS_BYTES) != hipSuccess || per_cu < 1) { fprintf(stderr, "kernel_launch: occupancy query reports %d\n", per_cu); }
        (void)hipGetLastError();
        grid = cus;
    }
    if (grid < 0) return;
    (void)hipMemsetAsync((char*)d_ws + WS_CTL, 0, CTL_ZERO_BYTES, stream);
    Args a{};
    for (int i = 0; i < 34; ++i) a.in[i] = (const float*)d_in[i];
    a.out = (float*)d_out; a.ws = (unsigned char*)d_ws;
#if MK_PER_PHASE
    static const unsigned char REP[NPHASE] = { 1 };
    for (int p = 0; p < NPHASE; ++p) for (int r = 0; r < REP[p]; ++r) { a.ph_lo = p; a.ph_hi = p + 1; a.dup = (r == 0) ? 0 : 1; hipLaunchKernelGGL(fwd_kernel, dim3(grid), dim3(512), LDS_BYTES, stream, a); }
#else
    a.ph_lo = 0; a.ph_hi = NPHASE;
    hipLaunchKernelGGL(fwd_kernel, dim3(grid), dim3(512), LDS_BYTES, stream, a);
#endif
}
```

```cpp
#include <hip/hip_runtime.h>
#include <cstdio>
#include <cstdint>

#ifndef MK_PER_PHASE
#define MK_PER_PHASE 0
#endif

#define GAS __attribute__((address_space(1)))
#define LAS __attribute__((address_space(3)))
#define DI __device__ __forceinline__
typedef unsigned short bf16_t;
typedef short bf16x8 __attribute__((ext_vector_type(8)));
typedef short s16x4 __attribute__((ext_vector_type(4)));
typedef float f32x2 __attribute__((ext_vector_type(2)));
typedef float f32x4 __attribute__((ext_vector_type(4)));
typedef float f32x16 __attribute__((ext_vector_type(16)));
typedef unsigned u32x2 __attribute__((ext_vector_type(2)));
typedef unsigned u32x4 __attribute__((ext_vector_type(4)));
typedef __bf16 bf16x2_t __attribute__((ext_vector_type(2)));
typedef GAS unsigned gu32;

DI unsigned pk2(float lo, float hi) { f32x2 v = {lo, hi}; bf16x2_t b = __builtin_convertvector(v, bf16x2_t); return __builtin_bit_cast(unsigned, b); }
DI float bf2f(unsigned short u) { return __builtin_bit_cast(float, (unsigned)u << 16); }
DI float bflo(unsigned u) { return __builtin_bit_cast(float, u << 16); }
DI float bfhi(unsigned u) { return __builtin_bit_cast(float, u & 0xffff0000u); }
DI unsigned short f2bf(float f) { return (unsigned short)(pk2(f, 0.f) & 0xffffu); }
DI float wave_sum(float v) {
#pragma unroll
    for (int o = 1; o < 64; o <<= 1) v += __shfl_xor(v, o);
    return v;
}
DI float wave_sum_fast(float v) {
#define DPP_ADD_(ctrl) v += __builtin_bit_cast(float, __builtin_amdgcn_update_dpp(0, __builtin_bit_cast(int, v), ctrl, 0xf, 0xf, true));
    DPP_ADD_(0xB1) DPP_ADD_(0x4E) DPP_ADD_(0x141) DPP_ADD_(0x140)
#undef DPP_ADD_
    const int iv = __builtin_bit_cast(int, v);
    return (__builtin_bit_cast(float, __builtin_amdgcn_readlane(iv, 0)) + __builtin_bit_cast(float, __builtin_amdgcn_readlane(iv, 16))) + (__builtin_bit_cast(float, __builtin_amdgcn_readlane(iv, 32)) + __builtin_bit_cast(float, __builtin_amdgcn_readlane(iv, 48)));
}
DI float wave_max(float v) {
#pragma unroll
    for (int o = 1; o < 64; o <<= 1) v = fmaxf(v, __shfl_xor(v, o));
    return v;
}
DI void st16_wt(void* p, u32x4 v) { asm volatile("global_store_dwordx4 %0, %1, off sc1\n\ts_nop 1" :: "v"(p), "v"(v) : "memory"); }
DI void st8_wt(void* p, u32x2 v) { asm volatile("global_store_dwordx2 %0, %1, off sc1\n\ts_nop 1" :: "v"(p), "v"(v) : "memory"); }
DI int lane_now() { int l_; asm volatile("v_mbcnt_lo_u32_b32 %0, -1, 0\n\tv_mbcnt_hi_u32_b32 %0, -1, %0" : "=v"(l_)); return l_; }
#define MFMA32(a, b, c) __builtin_amdgcn_mfma_f32_32x32x16_bf16((a), (b), (c), 0, 0, 0)
#define LDS_WAIT() asm volatile("s_waitcnt lgkmcnt(0)" ::: "memory")
#define VM_WAIT() asm volatile("s_waitcnt vmcnt(0)" ::: "memory")
#define LDS_BARRIER() asm volatile("s_waitcnt lgkmcnt(0)\n\ts_barrier" ::: "memory")

constexpr int DM = 2048, SEQ = 16384, DBATCH = 32, DSEQ = 64, PAST = 4096;
constexpr int MP = SEQ, MS = DBATCH * DSEQ, M = MP + MS;
constexpr int NCHP = SEQ / 64, NCH = M / 64;
constexpr int DFF = 8192;
constexpr int AH = 32, AKV = 4, AHD = 64, AQKV = 2560, AWIN = 128;
constexpr int RH = 8, RDK = 256, RDV = 512, RIN = 12288, RVD = RH * RDV;
constexpr int WH = 32, WN = 64;
constexpr float NORM_EPS = 1e-5f;

namespace pg8 {
#define PG8_LAS __attribute__((address_space(3)))
#define PG8_GAS __attribute__((address_space(1)))
constexpr int BM = 256, BK = 64, HALF = 128, HTB = HALF * BK * 2  , STAGE_BYTES = 8 * HTB, NXCD = 8, WGM = 8;
__host__ __device__ __forceinline__ int lds_byte(int r, int c) { const int st = (r >> 4) * 2 + (c >> 5), rr = r & 15, cc = c & 31, ob = rr * 64 + cc * 2; return st * 1024 + (ob ^ (((ob >> 9) & 1) << 5)); }
__host__ __device__ __forceinline__ void stage_rc(int b, int& R, int& C) { const int st = b / 1024, sb = b % 1024, swz = sb ^ (((sb >> 9) & 1) << 5); R = (st >> 1) * 16 + swz / 64; C = (st & 1) * 32 + (swz % 64) / 2; }
__host__ __device__ __forceinline__ int perm32(int rho) { const int n = rho >> 4, i = rho & 15; return 8 * (i >> 2) + 4 * n + (i & 3); }

struct Unit { int pm, pn, z, i, ks, k0, nk; };
struct Gemm { const bf16_t* A; const bf16_t* Bt; int M, N, K; size_t zA, zB; };
constexpr int SK_LDS_OFF = 163840 - 512 + 320 + 96;

struct Order {
    int nM, nN, nz, per, G, c; long tot;
    __device__ __forceinline__ void init(int M, int N, int nz_, int G_, int c_) { nM = M / BM; nN = N / BM; nz = nz_; per = nM * nN; G = G_; c = c_; tot = (long)per * nz; }
    __device__ __forceinline__ bool split_ok() const { const int rem = per % G; return nz == 1 && rem > 0 && rem * 4 == G; }
    __device__ __forceinline__ void init_full_rounds(int M, int N, int G_, int c_) { init(M, N, 1, G_, c_); if (split_ok()) tot = (long)(per / G) * G; }
    __device__ __forceinline__ void map(long L, Unit& u) const {
        u.z = (int)(L / per); int wgid = (int)(L % per);
        { const int q = per / NXCD, r = per % NXCD, xcd = wgid % NXCD, off = wgid / NXCD; wgid = (xcd < r ? xcd * (q + 1) : r * (q + 1) + (xcd - r) * q) + off; }
        const int nig = WGM * nN, gid = wgid / nig, fm = gid * WGM, gsz = (nM - fm) < WGM ? (nM - fm) : WGM;
        u.pm = fm + ((wgid % nig) % gsz); u.pn = (wgid % nig) / gsz;
    }
    __device__ __forceinline__ bool next(int i, Unit& u) const {
        const long L = (long)i * G + c; if (L >= tot) return false;
        u.i = i; u.ks = 0; map(L, u); return true;
    }
};
struct OrderSK {
    Order o; int G, c, nsl;
    __device__ __forceinline__ void init(int M, int N, int G_, int c_, int nsl_) { o.init(M, N, 1, G_, c_); G = G_; c = c_; nsl = nsl_; }
    __device__ __forceinline__ bool next(int i, Unit& u, int nt_all) const {
        const int rem = G >> 2;
        if (i != 0 || !o.split_ok() || c >= rem * nsl) return false;
        u.i = o.per / G; u.ks = c / rem; o.map((long)u.i * G + c % rem, u);
        const int it = nt_all >> 1, b0 = (it * u.ks + nsl - 1) / nsl, b1 = (it * (u.ks + 1) + nsl - 1) / nsl; u.k0 = 2 * b0; u.nk = 2 * (b1 - b0); return true;
    }
    __device__ __forceinline__ bool next(int i, Unit& u) const { return false; }
};
template <class Epi, bool ALIGN_EPI = true, bool SP2 = true, bool SPLITK = false, class Ord = Order>
__device__ __forceinline__ void gemm_phase(PG8_LAS unsigned char* lds, const Gemm g, const Ord& S, const Epi& E, int wave_id) {
    const int wid = wave_id, lane = lane_now(), tid = wid * 64 + lane, wr = wid >> 2, wc = wid & 3, fr = lane & 15, fq = lane >> 4;
    const int K = g.K; int nt = K / BK;
    unsigned voffA[2], voffB[2];
#pragma unroll
    for (int i = 0; i < 2; ++i) { int R, C; stage_rc(tid * 16 + i * 8192, R, C); const int Rb = Epi::PERM ? ((R & ~31) + perm32(R & 31)) : R;
        voffA[i] = (unsigned)(R * K + C) * 2u; voffB[i] = (unsigned)(Rb * K + C) * 2u; }
    const size_t kstep = (size_t)(BK * 2);
    const size_t hstep = (size_t)HALF * K * 2;
    const size_t tstep = 2 * hstep;
    const unsigned ldsw = (unsigned)wid * 1024u;
    const int aoff = lds_byte(wr * 64 + fr, fq * 8), boff = lds_byte(wc * 32 + fr, fq * 8);
#define PG8_SA(b, h) (((b) * 2 + (h)) * HTB)
#define PG8_SB(b, h) ((4 + (b) * 2 + (h)) * HTB)
#define PG8_STAGE(bufoff, gbase, voff) do { _Pragma("unroll") for (int _i = 0; _i < 2; ++_i) \
        __builtin_amdgcn_global_load_lds((const unsigned*)((const char*)(gbase) + (voff)[_i]), (PG8_LAS unsigned*)(lds + (bufoff) + ldsw + _i * 8192), 16, 0, 0); } while (0)
#define PG8_LDA(dst, b, h) do { _Pragma("unroll") for (int m = 0; m < 4; ++m) _Pragma("unroll") for (int k = 0; k < 2; ++k) dst[m][k] = *(const PG8_LAS bf16x8*)(lds + PG8_SA(b, h) + aoff + m * 2048 + k * 1024); } while (0)
#define PG8_LDB(dst, b, h) do { _Pragma("unroll") for (int n = 0; n < 2; ++n) _Pragma("unroll") for (int k = 0; k < 2; ++k) dst[n][k] = *(const PG8_LAS bf16x8*)(lds + PG8_SB(b, h) + boff + n * 2048 + k * 1024); } while (0)
#define PG8_MMA(ai, bj, At, Bt) do { __builtin_amdgcn_s_setprio(1); _Pragma("unroll") for (int m = 0; m < 4; ++m) _Pragma("unroll") for (int n = 0; n < 2; ++n) _Pragma("unroll") for (int k = 0; k < 2; ++k) \
        acc[ai][bj][m][n] = __builtin_amdgcn_mfma_f32_16x16x32_bf16(Bt[n][k], At[m][k], acc[ai][bj][m][n], 0, 0, 0); __builtin_amdgcn_s_setprio(0); } while (0)
#define PG8_WAIT_V(n) asm volatile("s_waitcnt vmcnt(" #n ")" ::: "memory")
#define PG8_WAIT_L(n) asm volatile("s_waitcnt lgkmcnt(" #n ")" ::: "memory")
#define PG8_BAR __builtin_amdgcn_s_barrier()
#define PG8_SCHED __builtin_amdgcn_sched_barrier(0)
    Unit cur, nxt; int ui = 0;
    if constexpr (SPLITK) { if (!S.next(0, cur, nt)) return; nt = cur.nk; asm volatile("" : "+s"(nt)); }
    else { if (!S.next(0, cur)) return; }
    f32x4 acc[2][2][4][2];
#pragma unroll
    for (int a = 0; a < 2; ++a)
#pragma unroll
        for (int b = 0; b < 2; ++b)
#pragma unroll
            for (int m = 0; m < 4; ++m)
#pragma unroll
                for (int n = 0; n < 2; ++n) acc[a][b][m][n] = (f32x4){0.f, 0.f, 0.f, 0.f};
    bf16x8 At[4][2], B0[2][2], B1[2][2];
#define PG8_KOFF(u) (SPLITK ? (size_t)(u).k0 * kstep : (size_t)0)
    const char* cA = (const char*)g.A + (size_t)cur.z * g.zA + (size_t)cur.pm * tstep + PG8_KOFF(cur); const char* cB = (const char*)g.Bt + (size_t)cur.z * g.zB + (size_t)cur.pn * tstep + PG8_KOFF(cur);
    if constexpr (SP2) {
        PG8_STAGE(PG8_SB(0, 0), cB, voffB); PG8_STAGE(PG8_SB(0, 1), cB + hstep, voffB); PG8_STAGE(PG8_SA(0, 0), cA, voffA); PG8_STAGE(PG8_SA(0, 1), cA + hstep, voffA);
        if (wr == 1) PG8_BAR;
        PG8_WAIT_V(2); PG8_BAR;
        PG8_STAGE(PG8_SB(1, 0), cB + kstep, voffB); PG8_STAGE(PG8_SA(1, 0), cA + kstep, voffA); PG8_STAGE(PG8_SB(1, 1), cB + hstep + kstep, voffB);
        PG8_WAIT_V(6); PG8_BAR;
    } else {
        PG8_STAGE(PG8_SB(0, 0), cB, voffB); PG8_STAGE(PG8_SA(0, 0), cA, voffA); PG8_STAGE(PG8_SB(0, 1), cB + hstep, voffB); PG8_STAGE(PG8_SA(0, 1), cA + hstep, voffA);
        if (wr == 1) PG8_BAR;
        PG8_WAIT_V(4); PG8_BAR;
        PG8_STAGE(PG8_SB(1, 0), cB + kstep, voffB); PG8_STAGE(PG8_SA(1, 0), cA + kstep, voffA); PG8_STAGE(PG8_SB(1, 1), cB + hstep + kstep, voffB);
        PG8_WAIT_V(6); PG8_BAR;
    }
    for (;;) {
        const bool has_next = S.next(ui + 1, nxt);
        const char* nA = has_next ? (const char*)g.A + (size_t)nxt.z * g.zA + (size_t)nxt.pm * tstep : cA; const char* nB = has_next ? (const char*)g.Bt + (size_t)nxt.z * g.zB + (size_t)nxt.pn * tstep : cB;
        for (int t = 0; t < nt; t += 2) {
            const bool last = (t == nt - 2);
            const char* a1 = cA + (size_t)(t + 1) * kstep;
            const char* a2 = last ? nA : cA + (size_t)(t + 2) * kstep; const char* b2 = last ? nB : cB + (size_t)(t + 2) * kstep;
            const char* a3 = a2 + kstep; const char* b3 = b2 + kstep;
            if constexpr (SP2) {
            PG8_LDB(B0, 0, 0); PG8_LDB(B1, 0, 1); PG8_SCHED; PG8_LDA(At, 0, 0); PG8_STAGE(PG8_SA(1, 1), a1 + hstep, voffA);
            PG8_WAIT_V(8); PG8_WAIT_L(0); PG8_BAR; PG8_MMA(0, 0, At, B0); PG8_MMA(0, 1, At, B1); PG8_BAR; PG8_SCHED;
            PG8_LDA(At, 0, 1); PG8_STAGE(PG8_SB(0, 0), b2, voffB); PG8_STAGE(PG8_SB(0, 1), b2 + hstep, voffB); PG8_STAGE(PG8_SA(0, 0), a2, voffA);
            PG8_WAIT_V(8); PG8_WAIT_L(0); PG8_BAR; PG8_MMA(1, 0, At, B0); PG8_MMA(1, 1, At, B1); PG8_BAR; PG8_SCHED;
            PG8_LDB(B0, 1, 0); PG8_LDB(B1, 1, 1); PG8_SCHED; PG8_LDA(At, 1, 0); PG8_STAGE(PG8_SA(0, 1), a2 + hstep, voffA);
            PG8_WAIT_V(8); PG8_WAIT_L(0); PG8_BAR; PG8_MMA(0, 0, At, B0); PG8_MMA(0, 1, At, B1); PG8_BAR; PG8_SCHED;
            PG8_LDA(At, 1, 1); PG8_STAGE(PG8_SB(1, 0), b3, voffB); PG8_STAGE(PG8_SB(1, 1), b3 + hstep, voffB); PG8_STAGE(PG8_SA(1, 0), a3, voffA);
            PG8_WAIT_V(8); PG8_WAIT_L(0); PG8_BAR; PG8_MMA(1, 0, At, B0); PG8_MMA(1, 1, At, B1); PG8_BAR; PG8_SCHED;
            } else {
            PG8_LDB(B0, 0, 0); PG8_SCHED; PG8_LDA(At, 0, 0); PG8_STAGE(PG8_SA(1, 1), a1 + hstep, voffA);
            PG8_WAIT_L(8); PG8_BAR; PG8_WAIT_L(0); PG8_MMA(0, 0, At, B0); PG8_BAR; PG8_SCHED;
            PG8_LDB(B1, 0, 1); PG8_STAGE(PG8_SB(0, 0), b2, voffB);
            PG8_BAR; PG8_WAIT_L(0); PG8_MMA(0, 1, At, B1); PG8_BAR;
            PG8_LDA(At, 0, 1); PG8_STAGE(PG8_SA(0, 0), a2, voffA);
            PG8_BAR; PG8_WAIT_L(0); PG8_MMA(1, 0, At, B0); PG8_BAR; PG8_SCHED;
            PG8_STAGE(PG8_SB(0, 1), b2 + hstep, voffB);
            PG8_WAIT_V(6); PG8_BAR; PG8_MMA(1, 1, At, B1); PG8_BAR;
            PG8_LDB(B0, 1, 0); PG8_SCHED; PG8_LDA(At, 1, 0); PG8_STAGE(PG8_SA(0, 1), a2 + hstep, voffA);
            PG8_WAIT_L(8); PG8_BAR; PG8_WAIT_L(0); PG8_MMA(0, 0, At, B0); PG8_BAR; PG8_SCHED;
            PG8_LDB(B1, 1, 1); PG8_STAGE(PG8_SB(1, 0), b3, voffB);
            PG8_BAR; PG8_WAIT_L(0); PG8_MMA(0, 1, At, B1); PG8_BAR;
            PG8_LDA(At, 1, 1); PG8_STAGE(PG8_SA(1, 0), a3, voffA);
            PG8_BAR; PG8_WAIT_L(0); PG8_MMA(1, 0, At, B0); PG8_BAR; PG8_SCHED;
            PG8_STAGE(PG8_SB(1, 1), b3 + hstep, voffB);
            PG8_WAIT_V(6); PG8_BAR; PG8_MMA(1, 1, At, B1); PG8_BAR;
            }
        }
        if constexpr (ALIGN_EPI) { if (wr == 0) PG8_BAR; }
        E(acc, cur, wr, wc, fr, fq);
        if (!has_next) break;
#pragma unroll
        for (int a = 0; a < 2; ++a)
#pragma unroll
            for (int b = 0; b < 2; ++b)
#pragma unroll
                for (int m = 0; m < 4; ++m)
#pragma unroll
                    for (int n = 0; n < 2; ++n) acc[a][b][m][n] = (f32x4){0.f, 0.f, 0.f, 0.f};
        cur = nxt; cA = nA; cB = nB; ++ui;
        if constexpr (ALIGN_EPI) { if (wr == 1) PG8_BAR; }
    }
    PG8_WAIT_V(0);
    if constexpr (!ALIGN_EPI) { if (wr == 0) PG8_BAR; }
    PG8_BAR;
#undef PG8_KOFF
#undef PG8_SA
#undef PG8_SB
#undef PG8_STAGE
#undef PG8_LDA
#undef PG8_LDB
#undef PG8_MMA
#undef PG8_WAIT_V
#undef PG8_WAIT_L
#undef PG8_BAR
#undef PG8_SCHED
}
}
namespace pg8 {
DI float act_apply(float x, int act) {
    if (act == 1) { const float r = fmaxf(x, 0.f); return r * r; }
    if (act == 2) { return 1.f - 2.f / (__expf(2.f * x) + 1.f); }
    if (act == 3) { return 1.f / (1.f + __expf(-x)); }
    return x;
}
constexpr int RSTAB_OFF = 131072, RSTAB_MAX = 16;
DI void fill_rs_table(LAS unsigned char* lds, const Order& S, const float* ps, int tid) {
    LAS float* T = (LAS float*)(lds + RSTAB_OFF); Unit u;
    for (int i = 0; i < RSTAB_MAX && S.next(i, u); ++i) { const int row = tid >> 1, hf = tid & 1; const float* p = ps + (size_t)(u.pm * BM + row) * 32 + 16 * hf;
        const f32x4 a = *(const f32x4*)p, b = *(const f32x4*)(p + 4), c = *(const f32x4*)(p + 8), d = *(const f32x4*)(p + 12);
        float sx = (((a.x + a.y) + (a.z + a.w)) + ((b.x + b.y) + (b.z + b.w))) + (((c.x + c.y) + (c.z + c.w)) + ((d.x + d.y) + (d.z + d.w)));
        sx += __shfl_xor(sx, 1); if (hf == 0) T[i * 256 + row] = 1.f / sqrtf(sx * (1.f / DM) + NORM_EPS); }
    asm volatile("s_waitcnt lgkmcnt(0)\n\ts_barrier" ::: "memory");
}
DI float rs_row(const LAS float* T, const Unit& u, int row) { return T[u.i * 256 + (row & 255)]; }
struct EpiAct {
    static constexpr bool PERM = true;
    bf16_t* O; int ldc; size_t zO; int acts; const LAS float* ss;
    DI void operator()(const f32x4 (&acc)[2][2][4][2], const Unit& u, int wr, int wc, int fr_, int fq) const {
        int fr = fr_; asm volatile("" : "+v"(fr));
        const int row0 = u.pm * BM + wr * 64 + fr, col0 = u.pn * BM + wc * 32 + 8 * fq, act = (acts >> (4 * u.z)) & 15;
        bf16_t* base = O + (size_t)u.z * zO;
#pragma unroll
        for (int ai = 0; ai < 2; ++ai)
#pragma unroll
            for (int m = 0; m < 4; ++m) { bf16_t* rowp = base + (size_t)(row0 + ai * HALF + m * 16) * ldc + col0; const float rs = ss ? rs_row(ss, u, row0 + ai * HALF + m * 16) : 1.f;
#pragma unroll
                for (int bj = 0; bj < 2; ++bj) { f32x4 v0 = acc[ai][bj][m][0] * rs, v1 = acc[ai][bj][m][1] * rs;
                    if (act) {
#pragma unroll
                        for (int j = 0; j < 4; ++j) { v0[j] = act_apply(v0[j], act); v1[j] = act_apply(v1[j], act); } }
                    u32x4 w; w.x = pk2(v0[0], v0[1]); w.y = pk2(v0[2], v0[3]); w.z = pk2(v1[0], v1[1]); w.w = pk2(v1[2], v1[3]);
                    *(u32x4*)(rowp + bj * HALF) = w; } }
    }
};
struct EpiRelu2 {
    static constexpr bool PERM = true;
    bf16_t* O; int ldc; const LAS float* ss;
    DI void operator()(const f32x4 (&acc)[2][2][4][2], const Unit& u, int wr, int wc, int fr_, int fq) const {
        int fr = fr_; asm volatile("" : "+v"(fr));
        const int row0 = u.pm * BM + wr * 64 + fr, col0 = u.pn * BM + wc * 32 + 8 * fq;
#pragma unroll
        for (int ai = 0; ai < 2; ++ai)
#pragma unroll
            for (int m = 0; m < 4; ++m) { bf16_t* rowp = O + (size_t)(row0 + ai * HALF + m * 16) * ldc + col0; const float rs = rs_row(ss, u, row0 + ai * HALF + m * 16);
#pragma unroll
                for (int bj = 0; bj < 2; ++bj) { f32x4 v0 = acc[ai][bj][m][0] * rs, v1 = acc[ai][bj][m][1] * rs;
#pragma unroll
                    for (int j = 0; j < 4; ++j) { const float a = fmaxf(v0[j], 0.f), b = fmaxf(v1[j], 0.f); v0[j] = a * a; v1[j] = b * b; }
                    u32x4 w; w.x = pk2(v0[0], v0[1]); w.y = pk2(v0[2], v0[3]); w.z = pk2(v1[0], v1[1]); w.w = pk2(v1[2], v1[3]);
                    *(u32x4*)(rowp + bj * HALF) = w; } }
    }
};
struct EpiResid {
    static constexpr bool PERM = true;
    const float* resP; const float* resS; bf16_t* XB; float* SS;
    DI void operator()(const f32x4 (&acc)[2][2][4][2], const Unit& u, int wr, int wc, int fr_, int fq) const {
        int fr = fr_; asm volatile("" : "+v"(fr));
        const int row0 = u.pm * BM + wr * 64 + fr, col0 = u.pn * BM + wc * 32 + 8 * fq;
        const bool pr = u.pm < MP / BM; const float* rb = pr ? resP : resS; const int rsub = pr ? 0 : MP;
#pragma unroll
        for (int ai = 0; ai < 2; ++ai)
#pragma unroll
            for (int m = 0; m < 4; ++m) { const int row = row0 + ai * HALF + m * 16; bf16_t* xp = XB + (size_t)row * DM + col0;
                float sq = 0.f;
#pragma unroll
                for (int bj = 0; bj < 2; ++bj) { f32x4 r0, r1;
                    if (resP) { const float* rp = rb + (size_t)(row - rsub) * DM + col0 + bj * HALF; r0 = *(const f32x4*)rp; r1 = *(const f32x4*)(rp + 4); }
                    else { const u32x4 xv = *(const u32x4*)(xp + bj * HALF); r0 = (f32x4){bflo(xv.x), bfhi(xv.x), bflo(xv.y), bfhi(xv.y)}; r1 = (f32x4){bflo(xv.z), bfhi(xv.z), bflo(xv.w), bfhi(xv.w)}; }
                    r0 = r0 + acc[ai][bj][m][0]; r1 = r1 + acc[ai][bj][m][1];
                    u32x4 wv; wv.x = pk2(r0[0], r0[1]); wv.y = pk2(r0[2], r0[3]); wv.z = pk2(r1[0], r1[1]); wv.w = pk2(r1[2], r1[3]); *(u32x4*)(xp + bj * HALF) = wv;
                    sq += (r0[0] * r0[0] + r0[1] * r0[1]) + (r0[2] * r0[2] + r0[3] * r0[3]) + (r1[0] * r1[0] + r1[1] * r1[1]) + (r1[2] * r1[2] + r1[3] * r1[3]); }
                sq += __shfl_xor(sq, 16); sq += __shfl_xor(sq, 32);
                if (fq == 0) SS[(size_t)row * 32 + u.pn * 4 + wc] = sq; }
    }
};
struct EpiSlab {
    static constexpr bool PERM = true;
    const LAS unsigned* skp; int slot;
    DI void operator()(const f32x4 (&acc)[2][2][4][2], const Unit& u, int wr, int wc, int fr, int fq) const {
        int tid2 = (wr * 4 + wc) * 64 + lane_now(); asm volatile("" : "+v"(tid2));
        const unsigned long long pb = ((unsigned long long)(unsigned)__builtin_amdgcn_readfirstlane((int)skp[1]) << 32) | (unsigned)__builtin_amdgcn_readfirstlane((int)skp[0]);
        GAS char* p = (GAS char*)pb + (size_t)slot * 262144; const unsigned voff = (unsigned)tid2 * 16u;
#pragma unroll
        for (int q = 0; q < 32; ++q) *(GAS f32x4*)(p + q * 8192 + voff) = acc[q >> 4][(q >> 3) & 1][(q >> 1) & 3][q & 1];
    }
};
DI void sk_reduce(unsigned char LAS* lds, float* slabs, unsigned* cnts, const Unit& u, int st, int ks, int nsl, bf16_t* XB, float* SS, int wave_id) {
    const int lane = lane_now(), tid = wave_id * 64 + lane, wr = wave_id >> 2, wc = wave_id & 3, fr = lane & 15, fq = lane >> 4;
    if (tid == 0) {
        unsigned* cnt = cnts + st * 4;
        __builtin_amdgcn_fence(__ATOMIC_RELEASE, "agent"); asm volatile("s_waitcnt vmcnt(0)" ::: "memory");
        (void)__hip_atomic_fetch_add(cnt, 1u, __ATOMIC_RELAXED, __HIP_MEMORY_SCOPE_AGENT);
        unsigned sp = 0; while (__hip_atomic_load(cnt, __ATOMIC_RELAXED, __HIP_MEMORY_SCOPE_AGENT) < (unsigned)nsl && ++sp < (1u << 24)) __builtin_amdgcn_s_sleep(1);
        __builtin_amdgcn_fence(__ATOMIC_ACQUIRE, "agent"); asm volatile("s_waitcnt vmcnt(0)" ::: "memory");
    }
    __syncthreads();
    const GAS char* p = (const GAS char*)slabs + (size_t)st * (4 * 262144); const unsigned voff = (unsigned)tid * 16u;
    const int rowb = u.pm * BM + wr * 64 + fr, col0 = u.pn * BM + wc * 32 + 8 * fq;
#pragma unroll 1
    for (int cm = ks; cm < 8; cm += nsl) { const int ai = cm >> 2, m = cm & 3, row = rowb + ai * HALF + m * 16; bf16_t* xp = XB + (size_t)row * DM + col0;
        f32x4 v[2][2][4]; u32x4 xv[2];
#pragma unroll
        for (int bj = 0; bj < 2; ++bj) { xv[bj] = *(const u32x4*)(xp + bj * HALF);
#pragma unroll
            for (int n = 0; n < 2; ++n)
#pragma unroll
                for (int sl = 0; sl < 4; ++sl) v[bj][n][sl] = (sl < nsl) ? *(const GAS f32x4*)(p + (size_t)sl * 262144 + (((ai * 2 + bj) * 4 + m) * 2 + n) * 8192 + voff) : (f32x4){0.f, 0.f, 0.f, 0.f}; }
        float sq = 0.f;
#pragma unroll
        for (int bj = 0; bj < 2; ++bj) {
            f32x4 r0 = (f32x4){bflo(xv[bj].x), bfhi(xv[bj].x), bflo(xv[bj].y), bfhi(xv[bj].y)}, r1 = (f32x4){bflo(xv[bj].z), bfhi(xv[bj].z), bflo(xv[bj].w), bfhi(xv[bj].w)};
            r0 = r0 + (((v[bj][0][0] + v[bj][0][1]) + v[bj][0][2]) + v[bj][0][3]); r1 = r1 + (((v[bj][1][0] + v[bj][1][1]) + v[bj][1][2]) + v[bj][1][3]);
            u32x4 wv; wv.x = pk2(r0[0], r0[1]); wv.y = pk2(r0[2], r0[3]); wv.z = pk2(r1[0], r1[1]); wv.w = pk2(r1[2], r1[3]); *(u32x4*)(xp + bj * HALF) = wv;
            sq += (r0[0] * r0[0] + r0[1] * r0[1]) + (r0[2] * r0[2] + r0[3] * r0[3]) + (r1[0] * r1[0] + r1[1] * r1[1]) + (r1[2] * r1[2] + r1[3] * r1[3]); }
        sq += __shfl_xor(sq, 16); sq += __shfl_xor(sq, 32);
        if (fq == 0) SS[(size_t)row * 32 + u.pn * 4 + wc] = sq; }
}
DI int tok_pos(int row) { return row < MP ? row : PAST + (row & 63); }
DI void sincos_rev(int pos, float inv, float& c, float& s) {
    double r = (double)pos * (double)inv * 0.15915494309189535; r = r - __builtin_floor(r); const float f = (float)r;
    s = __builtin_amdgcn_sinf(f); c = __builtin_amdgcn_cosf(f);
}
struct EpiAttnQKV {
    static constexpr bool PERM = true;
    bf16_t* Qb; float* outf; size_t okP, okS; const LAS float* ss;
    DI void operator()(const f32x4 (&acc)[2][2][4][2], const Unit& u, int wr, int wc, int fr_, int fq) const {
        int fr = fr_; asm volatile("" : "+v"(fr));
        const int row0 = u.pm * BM + wr * 64 + fr, cl = wc * 32 + 8 * fq;
        const bool rot = (u.pn < 9) && ((wc & 1) == 0) && (fq < 2);
        float inv[8];
#pragma unroll
        for (int j = 0; j < 8; ++j) inv[j] = __builtin_amdgcn_exp2f(-(float)j * 2.3664461f);
        const float qs = (u.pn < 8) ? 0.18033688f : 1.f;
        const size_t ooff = (u.pn < 8) ? (size_t)0 : (u.pn == 8 ? (size_t)M * DM : (size_t)M * DM + (size_t)M * 256); bf16_t* ob = Qb + ooff; const int ldo = (u.pn < 8) ? DM : 256, ocol = (u.pn < 8) ? u.pn * BM + cl : cl;
        float* cP = outf + okP + (u.pn == 9 ? 65536 : 0); float* cS = outf + okS + (u.pn == 9 ? 2097152 : 0);
#pragma unroll
        for (int ai = 0; ai < 2; ++ai)
#pragma unroll
            for (int m = 0; m < 4; ++m) { const int row = row0 + ai * HALF + m * 16; const int pos = tok_pos(row);
                const float rs = rs_row(ss, u, row);
                f32x4 p0 = acc[ai][0][m][0] * rs, p1 = acc[ai][0][m][1] * rs, q0 = acc[ai][1][m][0] * rs, q1 = acc[ai][1][m][1] * rs;
                if (rot) {
#define ROPE_J(j, pv, qv, e) { float c_, s_; sincos_rev(pos, inv[j], c_, s_); const float ya = __shfl_xor(pv[e], 16), yb = __shfl_xor(qv[e], 16); \
                        pv[e] = (fq == 0) ? pv[e] * c_ - ya * s_ : pv[e] * c_ + ya * s_; qv[e] = (fq == 0) ? qv[e] * c_ - yb * s_ : qv[e] * c_ + yb * s_; }
                    ROPE_J(0, p0, q0, 0) ROPE_J(1, p0, q0, 1) ROPE_J(2, p0, q0, 2) ROPE_J(3, p0, q0, 3) ROPE_J(4, p1, q1, 0) ROPE_J(5, p1, q1, 1) ROPE_J(6, p1, q1, 2) ROPE_J(7, p1, q1, 3)
#undef ROPE_J
                }
                { u32x4 wv; wv.x = pk2(p0[0] * qs, p0[1] * qs); wv.y = pk2(p0[2] * qs, p0[3] * qs); wv.z = pk2(p1[0] * qs, p1[1] * qs); wv.w = pk2(p1[2] * qs, p1[3] * qs);
                  *(u32x4*)(ob + (size_t)row * ldo + ocol) = wv;
                  wv.x = pk2(q0[0] * qs, q0[1] * qs); wv.y = pk2(q0[2] * qs, q0[3] * qs); wv.z = pk2(q1[0] * qs, q1[1] * qs); wv.w = pk2(q1[2] * qs, q1[3] * qs);
                  *(u32x4*)(ob + (size_t)row * ldo + ocol + HALF) = wv; }
                if (u.pn >= 8) {
                    float* cp = nullptr;
                    if (row >= MP) cp = cS + ((size_t)((row - MP) >> 6) * AWIN + 64 + (row & 63)) * 256; else if (row >= MP - AWIN) cp = cP + (size_t)(row - (MP - AWIN)) * 256;
                    if (cp) { *(f32x4*)(cp + cl) = p0; *(f32x4*)(cp + cl + 4) = p1; *(f32x4*)(cp + cl + HALF) = q0; *(f32x4*)(cp + cl + HALF + 4) = q1; }
                } }
    }
};
struct EpiRetProj {
    static constexpr bool PERM = true;
    bf16_t* P; const LAS float* ss;
    DI void operator()(const f32x4 (&acc)[2][2][4][2], const Unit& u, int wr, int wc, int fr_, int fq) const {
        int fr = fr_; asm volatile("" : "+v"(fr));
        const int row0 = u.pm * BM + wr * 64 + fr, cl = wc * 32 + 8 * fq; const bool rot = u.pn < 16; const float sc = (u.pn >= 8 && u.pn < 16) ? 0.0625f : 1.f;
        float inv[8];
#pragma unroll
        for (int j = 0; j < 8; ++j) inv[j] = __builtin_amdgcn_exp2f(-(float)(cl + j) * 0.10381025f);
#pragma unroll
        for (int ai = 0; ai < 2; ++ai)
#pragma unroll
            for (int m = 0; m < 4; ++m) { const int row = row0 + ai * HALF + m * 16; const int pos = tok_pos(row);
                const float rs = rs_row(ss, u, row);
                f32x4 a0 = acc[ai][0][m][0] * rs, a1 = acc[ai][0][m][1] * rs, b0 = acc[ai][1][m][0] * rs, b1 = acc[ai][1][m][1] * rs;
                if (rot) {
                    float x1[8] = {a0[0], a0[1], a0[2], a0[3], a1[0], a1[1], a1[2], a1[3]}, x2[8] = {b0[0], b0[1], b0[2], b0[3], b1[0], b1[1], b1[2], b1[3]};
#pragma unroll
                    for (int j = 0; j < 8; ++j) { float c, s; sincos_rev(pos, inv[j], c, s); const float p = x1[j], q = x2[j]; x1[j] = (p * c - q * s) * sc; x2[j] = (q * c + p * s) * sc; }
                    a0 = (f32x4){x1[0], x1[1], x1[2], x1[3]}; a1 = (f32x4){x1[4], x1[5], x1[6], x1[7]}; b0 = (f32x4){x2[0], x2[1], x2[2], x2[3]}; b1 = (f32x4){x2[4], x2[5], x2[6], x2[7]};
                }
                bf16_t* rowp = P + (size_t)row * RIN + u.pn * BM + cl;
                u32x4 w; w.x = pk2(a0[0], a0[1]); w.y = pk2(a0[2], a0[3]); w.z = pk2(a1[0], a1[1]); w.w = pk2(a1[2], a1[3]); *(u32x4*)rowp = w;
                w.x = pk2(b0[0], b0[1]); w.y = pk2(b0[2], b0[3]); w.z = pk2(b1[0], b1[1]); w.w = pk2(b1[2], b1[3]); *(u32x4*)(rowp + HALF) = w; }
    }
};
struct EpiRwkv2 {
    static constexpr bool PERM = true;
    float* LW; bf16_t* Ab; const float* w0; const float* a0;
    DI void operator()(const f32x4 (&acc)[2][2][4][2], const Unit& u, int wr, int wc, int fr_, int fq) const {
        int fr = fr_; asm volatile("" : "+v"(fr));
        const int row0 = u.pm * BM + wr * 64 + fr, col0 = u.pn * BM + wc * 32 + 8 * fq;
        const float* bp = (u.z == 0) ? w0 : a0; bf16_t* ob = Ab + (u.z == 2 ? (size_t)M * DM : (size_t)0);
#pragma unroll
        for (int bj = 0; bj < 2; ++bj)
#pragma unroll
            for (int n = 0; n < 2; ++n) { const int col = col0 + bj * HALF + 4 * n;
                f32x4 bias = (f32x4){0.f, 0.f, 0.f, 0.f}; if (u.z < 2) bias = *(const f32x4*)(bp + col);
#pragma unroll
                for (int ai = 0; ai < 2; ++ai)
#pragma unroll
                    for (int m = 0; m < 4; ++m) { const int row = row0 + ai * HALF + m * 16; f32x4 x = acc[ai][bj][m][n] + bias;
                        if (u.z == 0) {
#pragma unroll
                            for (int j = 0; j < 4; ++j) { const float y = -x[j]; const float sp = fmaxf(y, 0.f) + __logf(1.f + __expf(-fabsf(y))); x[j] = -__expf(-sp - 0.5f); }
                            *(f32x4*)(LW + (size_t)row * DM + col) = x;
                        } else {
                            if (u.z == 1) {
#pragma unroll
                                for (int j = 0; j < 4; ++j) x[j] = 1.f / (1.f + __expf(-x[j])); }
                            u32x2 wv; wv.x = pk2(x[0], x[1]); wv.y = pk2(x[2], x[3]); *(u32x2*)(ob + (size_t)row * DM + col) = wv;
                        } }
                asm volatile("" ::: "memory"); }
    }
};
}
#define XB_TMO      128
#define XB_XCNT(j)  (256  + 64 * (j))
#define XB_XSUB(j)  (1280 + 64 * (j))
#define XB_XGEN(j)  (2304 + 64 * (j))
#define XB_TOP      3328
#define XB_TOPGEN   3392
#define XCD_BAR_WORDS 3456
#define XB_SPIN_CAP (1u << 18)

__device__ __forceinline__ unsigned xb_ld(unsigned* p)              { return __hip_atomic_load(p, __ATOMIC_RELAXED, __HIP_MEMORY_SCOPE_AGENT); }
__device__ __forceinline__ unsigned xb_add(unsigned* p, unsigned v) { return __hip_atomic_fetch_add(p, v, __ATOMIC_RELAXED, __HIP_MEMORY_SCOPE_AGENT); }
__device__ __forceinline__ unsigned xb_xcc_id() { return (unsigned)__builtin_amdgcn_s_getreg((3 << 11) | 20) & 0xFu; }
#define XB_SPIN(cond, bar) do { unsigned _sp = 0; while (cond) { __builtin_amdgcn_s_sleep(1); \
    if ((++_sp & 255u) == 0u) { if (xb_ld(&(bar)[XB_TMO])) break; if (_sp > XB_SPIN_CAP) { atomicAdd(&(bar)[XB_TMO], 1u); break; } } } } while (0)

struct XcdBarrier {
    unsigned* bar; unsigned x;
    volatile LAS unsigned* st;
};

__device__ __forceinline__ XcdBarrier xcd_barrier_post(unsigned* bar, volatile LAS unsigned* st, int wave_id) {
    XcdBarrier b; b.bar = bar; b.x = xb_xcc_id(); b.st = st;
    if (wave_id == 0 && lane_now() == 0) (void)xb_add(&bar[XB_XCNT(b.x)], 1u);
    return b;
}
__device__ __forceinline__ void xcd_barrier_complete(unsigned* bar, unsigned x, unsigned& nloc, unsigned& nx) {
    const unsigned G = gridDim.x * gridDim.y * gridDim.z;
    unsigned sum, cnt, mine, sp = 0u;
    for (;;) {
        sum = 0u; cnt = 0u; mine = 0u;
#pragma unroll
        for (unsigned j = 0; j < 16; ++j) { const unsigned c = xb_ld(&bar[XB_XCNT(j)]); sum += c; cnt += (c > 0u) ? 1u : 0u; mine = (j == x) ? c : mine; }
        if (sum == G) break;
        __builtin_amdgcn_s_sleep(1);
        if ((++sp & 255u) == 0u) { if (xb_ld(&bar[XB_TMO])) break; if (sp > XB_SPIN_CAP) { atomicAdd(&bar[XB_TMO], 1u); break; } }
    }
    nloc = mine > 0u ? mine : 1u; nx = cnt > 0u ? cnt : 1u;
}

__device__ __forceinline__ void xcd_barrier(const XcdBarrier& b, int wave_id) {
    asm volatile("s_waitcnt vmcnt(0)" ::: "memory");
    __syncthreads();
    if (wave_id == 0 && lane_now() == 0) {
        unsigned* bar = b.bar;
        __builtin_amdgcn_s_waitcnt(0);
        unsigned nloc = b.st[0], nx = b.st[1];
        if (nloc == 0u) { xcd_barrier_complete(bar, b.x, nloc, nx); b.st[0] = nloc; b.st[1] = nx; }
        const unsigned old = xb_add(&bar[XB_XSUB(b.x)], 1u);
        const unsigned gen = old / nloc;
        if (old + 1u == (gen + 1u) * nloc) {
            __builtin_amdgcn_fence(__ATOMIC_RELEASE, "agent");
            asm volatile("s_waitcnt vmcnt(0)" ::: "memory");
            const unsigned og = xb_add(&bar[XB_TOP], 1u);
            const unsigned tg = og / nx;
            if (og + 1u == (tg + 1u) * nx) xb_add(&bar[XB_TOPGEN], 1u);
            else XB_SPIN(xb_ld(&bar[XB_TOPGEN]) == tg, bar);
            __builtin_amdgcn_fence(__ATOMIC_ACQUIRE, "agent");
            xb_add(&bar[XB_XGEN(b.x)], 1u);
            asm volatile("s_waitcnt vmcnt(0)" ::: "memory");
        } else {
            XB_SPIN(xb_ld(&bar[XB_XGEN(b.x)]) == gen, bar);
            __builtin_amdgcn_fence(__ATOMIC_ACQUIRE, "agent");
            asm volatile("s_waitcnt vmcnt(0)" ::: "memory");
        }
    }
    __syncthreads();
}
struct WG { LAS unsigned char* lds; int tid, lane, wave, gw, ngw, G, bid; };

DI void convert_w(const WG& w, const float* W, int Kv, int Nv, bf16_t* WT, int Kp, int Np, const float* gain = nullptr, int b0 = 0, int nb = 0, int part = 0) {
    const int nkt = Kp / 128, nnt = Np / 128, nall = nkt * nnt; if (nb == 0) nb = w.G;
    if (w.bid < b0 || w.bid >= b0 + nb) return;
    const int tcut = (nall * 5) >> 3, ntile = (part == 1) ? tcut : nall;
    int tile = ((part == 2) ? tcut : 0) + (w.bid - b0); if (tile >= ntile) return;
    int tid = w.tid; asm volatile("" : "+v"(tid)); const int lane = tid & 63, wv = tid >> 6;
    f32x4 r0[8], r1[8], r2[8], r3[8]; float g0[8], g1[8], g2[8], g3[8]; int it = 0;
#define CW_LOAD(dst, gd, tl) { const int k0_ = ((tl) % nkt) * 128, n0_ = ((tl) / nkt) * 128; _Pragma("unroll") for (int i = 0; i < 8; ++i) { const int k = k0_ + 16 * wv + 2 * i + (lane >> 5), n = n0_ + 4 * (lane & 31); \
        f32x4 x_ = (f32x4){0.f, 0.f, 0.f, 0.f}; float g_ = 1.f; if (k < Kv && n < Nv) { x_ = *(const f32x4*)(W + (size_t)k * Nv + n); if (gain) g_ = gain[k]; } dst[i] = x_; gd[i] = g_; } }
#define CW_STEP(cur, gc, pf, gp) { const int k0 = (tile % nkt) * 128, n0 = (tile / nkt) * 128; LAS float* T = (LAS float*)w.lds + (it & 1) * (128 * 129 + 64); const int tp_ = tile + 3 * nb; \
        if (tp_ < ntile) CW_LOAD(pf, gp, tp_) \
        _Pragma("unroll") for (int i = 0; i < 8; ++i) { const int kk = 16 * wv + 2 * i + (lane >> 5); LAS float* tp = T + kk * 129 + 4 * (lane & 31); tp[0] = cur[i].x * gc[i]; tp[1] = cur[i].y * gc[i]; tp[2] = cur[i].z * gc[i]; tp[3] = cur[i].w * gc[i]; } \
        LDS_BARRIER(); \
        _Pragma("unroll") for (int i = 0; i < 4; ++i) { const int nn = 16 * wv + 4 * i + (lane >> 4), kj = 8 * (lane & 15); const LAS float* sp = T + kj * 129 + nn; \
            u32x4 o; o.x = pk2(sp[0], sp[129]); o.y = pk2(sp[2 * 129], sp[3 * 129]); o.z = pk2(sp[4 * 129], sp[5 * 129]); o.w = pk2(sp[6 * 129], sp[7 * 129]); \
            *(u32x4*)(WT + (size_t)(n0 + nn) * Kp + k0 + kj) = o; } \
        ++it; tile += nb; }
    CW_LOAD(r0, g0, tile)
    if (tile + nb < ntile) CW_LOAD(r1, g1, tile + nb)
    if (tile + 2 * nb < ntile) CW_LOAD(r2, g2, tile + 2 * nb)
    LDS_BARRIER();
    for (;;) {
        CW_STEP(r0, g0, r3, g3) if (tile >= ntile) break;
        CW_STEP(r1, g1, r0, g0) if (tile >= ntile) break;
        CW_STEP(r2, g2, r1, g1) if (tile >= ntile) break;
        CW_STEP(r3, g3, r2, g2) if (tile >= ntile) break;
    }
#undef CW_LOAD
#undef CW_STEP
    LDS_BARRIER();
}

DI void rows0(const WG& w, const float* xp, const float* xs, bf16_t* XB, float* SS) {
    for (int m = w.gw; m < M; m += w.ngw) {
        const float* xr = (m < MP) ? xp + (size_t)m * DM : xs + (size_t)(m - MP) * DM;
        f32x4 v[8]; float s = 0.f;
#pragma unroll
        for (int j = 0; j < 8; ++j) { v[j] = ((const f32x4*)xr)[w.lane + 64 * j]; s += (v[j].x * v[j].x + v[j].y * v[j].y) + (v[j].z * v[j].z + v[j].w * v[j].w); }
        s = wave_sum_fast(s); if (w.lane < 32) SS[(size_t)m * 32 + w.lane] = (w.lane == 0) ? s : 0.f;
#pragma unroll
        for (int j = 0; j < 8; ++j) { u32x2 o; o.x = pk2(v[j].x, v[j].y); o.y = pk2(v[j].z, v[j].w); ((u32x2*)(XB + (size_t)m * DM))[w.lane + 64 * j] = o; }
    }
}
DI float rs_of_row(const float* ps, int m, int lane) { const float v = (lane < 32) ? ps[(size_t)m * 32 + lane] : 0.f; return 1.f / sqrtf(wave_sum_fast(v) * (1.f / DM) + NORM_EPS); }
DI void norm_rows(const WG& w, const float* xp, const float* xs, const float* gain, bf16_t* H, float* shp, float* shs) {
    for (int m = w.gw; m < M; m += w.ngw) {
        const float* xr = (m < MP) ? xp + (size_t)m * DM : xs + (size_t)(m - MP) * DM;
        f32x4 v[8]; float s = 0.f;
#pragma unroll
        for (int j = 0; j < 8; ++j) { v[j] = ((const f32x4*)xr)[w.lane + 64 * j]; s += (v[j].x * v[j].x + v[j].y * v[j].y) + (v[j].z * v[j].z + v[j].w * v[j].w); }
        const float rs = 1.f / sqrtf(wave_sum_fast(s) * (1.f / DM) + NORM_EPS);
        float* sh = nullptr;
        if (shp && m == MP - 1) sh = shp; else if (shs && m >= MP && (m & 63) == 63) sh = shs + (size_t)((m - MP) >> 6) * DM;
#pragma unroll
        for (int j = 0; j < 8; ++j) { const f32x4 g = ((const f32x4*)gain)[w.lane + 64 * j]; const f32x4 y = v[j] * rs * g;
            u32x2 o; o.x = pk2(y.x, y.y); o.y = pk2(y.z, y.w); ((u32x2*)(H + (size_t)m * DM))[w.lane + 64 * j] = o;
            if (sh) ((f32x4*)sh)[w.lane + 64 * j] = y; }
    }
}
DI void final_norm(const WG& w, const bf16_t* XB, const float* SS, const float* gain, float* Y) {
    for (int m = w.gw; m < M; m += w.ngw) { const float rs = rs_of_row(SS, m, w.lane);
#pragma unroll
        for (int j = 0; j < 4; ++j) { const int c0 = 8 * (w.lane + 64 * j); const u32x4 xv = *(const u32x4*)(XB + (size_t)m * DM + c0);
            const f32x4 g0 = *(const f32x4*)(gain + c0), g1 = *(const f32x4*)(gain + c0 + 4);
            *(f32x4*)(Y + (size_t)m * DM + c0) = (f32x4){bflo(xv.x), bfhi(xv.x), bflo(xv.y), bfhi(xv.y)} * rs * g0; *(f32x4*)(Y + (size_t)m * DM + c0 + 4) = (f32x4){bflo(xv.z), bfhi(xv.z), bflo(xv.w), bfhi(xv.w)} * rs * g1; } }
}
DI void lerp_rows(const WG& w, const bf16_t* XB, const float* SS, const float* gain, const float* shift_state, const float* mu, bf16_t* XL, float* shp, float* shs) {
    constexpr int RPW = 36;
    for (int task = w.gw; task < 4 * (M / RPW); task += w.ngw) { const int cq = task & 3, m0 = (task >> 2) * RPW, c0 = 512 * cq + 8 * w.lane;
        float gg[8], mm[6][8], hp[8];
        { const f32x4 g0 = *(const f32x4*)(gain + c0), g1 = *(const f32x4*)(gain + c0 + 4); gg[0] = g0.x; gg[1] = g0.y; gg[2] = g0.z; gg[3] = g0.w; gg[4] = g1.x; gg[5] = g1.y; gg[6] = g1.z; gg[7] = g1.w; }
#pragma unroll
        for (int i = 0; i < 6; ++i) { const int mrow = (i == 1) ? 2 : (i == 2) ? 3 : (i == 3) ? 1 : i;
            const float* mp = mu + (size_t)mrow * DM + c0; const f32x4 a = *(const f32x4*)mp, b = *(const f32x4*)(mp + 4); mm[i][0] = a.x; mm[i][1] = a.y; mm[i][2] = a.z; mm[i][3] = a.w; mm[i][4] = b.x; mm[i][5] = b.y; mm[i][6] = b.z; mm[i][7] = b.w; }
        { const bool first0 = (m0 == 0) || (m0 >= MP && (m0 & 63) == 0);
            if (!first0) { const float rsp = rs_of_row(SS, m0 - 1, w.lane); const u32x4 pv = *(const u32x4*)(XB + (size_t)(m0 - 1) * DM + c0);
                hp[0] = bflo(pv.x); hp[1] = bfhi(pv.x); hp[2] = bflo(pv.y); hp[3] = bfhi(pv.y); hp[4] = bflo(pv.z); hp[5] = bfhi(pv.z); hp[6] = bflo(pv.w); hp[7] = bfhi(pv.w);
#pragma unroll
                for (int e = 0; e < 8; ++e) hp[e] *= rsp * gg[e]; }
            else {
#pragma unroll
                for (int e = 0; e < 8; ++e) hp[e] = 0.f; } }
#pragma unroll 2
        for (int rr = 0; rr < RPW; ++rr) { const int m = m0 + rr;
            const float rs = rs_of_row(SS, m, w.lane); const u32x4 hv = *(const u32x4*)(XB + (size_t)m * DM + c0);
            float h[8] = {bflo(hv.x), bfhi(hv.x), bflo(hv.y), bfhi(hv.y), bflo(hv.z), bfhi(hv.z), bflo(hv.w), bfhi(hv.w)};
#pragma unroll
            for (int e = 0; e < 8; ++e) h[e] *= rs * gg[e];
            if (m == 0) {
#pragma unroll
                for (int e = 0; e < 8; ++e) hp[e] = 0.f;
            } else if (m >= MP && (m & 63) == 0) { const float* sp = shift_state + (size_t)((m - MP) >> 6) * DM + c0; const f32x4 s0 = *(const f32x4*)sp, s1 = *(const f32x4*)(sp + 4);
                hp[0] = s0.x; hp[1] = s0.y; hp[2] = s0.z; hp[3] = s0.w; hp[4] = s1.x; hp[5] = s1.y; hp[6] = s1.z; hp[7] = s1.w; }
            float* sh = nullptr; if (m == MP - 1) sh = shp; else if (m >= MP && (m & 63) == 63) sh = shs + (size_t)((m - MP) >> 6) * DM;
            if (sh) { *(f32x4*)(sh + c0) = (f32x4){h[0], h[1], h[2], h[3]}; *(f32x4*)(sh + c0 + 4) = (f32x4){h[4], h[5], h[6], h[7]}; }
#pragma unroll
            for (int i = 0; i < 6; ++i) { float o[8];
#pragma unroll
                for (int e = 0; e < 8; ++e) o[e] = h[e] + (hp[e] - h[e]) * mm[i][e];
                u32x4 ov; ov.x = pk2(o[0], o[1]); ov.y = pk2(o[2], o[3]); ov.z = pk2(o[4], o[5]); ov.w = pk2(o[6], o[7]);
                *(u32x4*)(XL + ((size_t)i * M + m) * DM + c0) = ov; }
#pragma unroll
            for (int e = 0; e < 8; ++e) hp[e] = h[e];
        }
    }
}
constexpr int AT_KS = 72, AT_VS = 196;
constexpr int AT_V_OFF = 192 * AT_KS * 2;
DI u32x4 ld8_f32_as_bf16(const float* p) { const f32x4 a = *(const f32x4*)p, b = *(const f32x4*)(p + 4); u32x4 o; o.x = pk2(a.x, a.y); o.y = pk2(a.z, a.w); o.z = pk2(b.x, b.y); o.w = pk2(b.z, b.w); return o; }
DI bf16x8 pack8(const f32x16& x, int s) {
    u32x4 p; p.x = pk2(x[8 * s], x[8 * s + 1]); p.y = pk2(x[8 * s + 2], x[8 * s + 3]); p.z = pk2(x[8 * s + 4], x[8 * s + 5]); p.w = pk2(x[8 * s + 6], x[8 * s + 7]);
    return __builtin_bit_cast(bf16x8, p);
}
DI bf16x8 ld_perm_frag(const LAS bf16_t* p) {
    const s16x4 lo = *(const LAS s16x4*)p, hi = *(const LAS s16x4*)(p + 8); return __builtin_shufflevector(lo, hi, 0, 1, 2, 3, 4, 5, 6, 7);
}
DI f32x16 zero16() { f32x16 z; for (int i = 0; i < 16; ++i) z[i] = 0.f; return z; }

typedef short v4i16_t __attribute__((ext_vector_type(4)));
DI s16x4 ds_tr(const LAS unsigned char* p) { return __builtin_bit_cast(s16x4, __builtin_amdgcn_ds_read_tr16_b64_v4i16((LAS v4i16_t*)p)); }
constexpr int AT_VB = 9344;
DI void attn_load_kv(const bf16_t* Kb, const bf16_t* Vb, const float* ck, const float* cv, int c, int g, int tid, u32x4 (&pk)[3], u32x4 (&pv)[3]) {
#pragma unroll
    for (int i = 0; i < 3; ++i) { const int idx = tid + 512 * i, sl = idx >> 3, dc = idx & 7;
        u32x4 kv = {0u, 0u, 0u, 0u}, vv = {0u, 0u, 0u, 0u};
        if (c < NCHP) { const int tok = 64 * (c - 2) + sl; if (tok >= 0) { kv = *(const u32x4*)(Kb + (size_t)tok * 256 + g * 64 + dc * 8); vv = *(const u32x4*)(Vb + (size_t)tok * 256 + g * 64 + dc * 8); } }
        else { const int b = c - NCHP;
            if (sl < AWIN) { const size_t o = (((size_t)b * AWIN + sl) * AKV + g) * AHD + dc * 8; kv = ld8_f32_as_bf16(ck + o); vv = ld8_f32_as_bf16(cv + o); }
            else { const int tok = MP + 64 * b + (sl - AWIN); kv = *(const u32x4*)(Kb + (size_t)tok * 256 + g * 64 + dc * 8); vv = *(const u32x4*)(Vb + (size_t)tok * 256 + g * 64 + dc * 8); } }
        pk[i] = kv; pv[i] = vv; }
}
DI void attn_load_q(const bf16_t* Qb, int c, int qh, int hq, int r, int h, bf16x8 (&qf)[4]) {
#pragma unroll
    for (int sx = 0; sx < 4; ++sx) qf[sx] = *(const bf16x8*)(Qb + (size_t)(64 * c + 32 * qh + r) * DM + hq * 64 + 16 * sx + 8 * h);
}
DI void attn_phase(const WG& w, const bf16_t* Qb, const bf16_t* Kb, const bf16_t* Vb, const float* ck, const float* cv, const float* sinks, bf16_t* AO) {
    LAS bf16_t* Ks = (LAS bf16_t*)(w.lds); LAS unsigned char* Vl = w.lds + AT_V_OFF;
    const int NU = NCH * AKV;
    u32x4 pk[3], pv[3]; bf16x8 qn[4];
    if (w.bid < NU) { const int c = w.bid >> 2, g = w.bid & 3; attn_load_kv(Kb, Vb, ck, cv, c, g, w.tid, pk, pv); attn_load_q(Qb, c, 0, g * 8 + w.wave, w.lane & 31, w.lane >> 5, qn); }
#pragma unroll 1
    for (int u = w.bid; u < NU; u += w.G) {
        const int c = u >> 2, g = u & 3, un = u + w.G, cn = un >> 2, gn = un & 3;
        int tid = w.tid; asm volatile("" : "+v"(tid)); const int lane = tid & 63, r = lane & 31, h = lane >> 5;
        LDS_BARRIER();
#pragma unroll
        for (int i = 0; i < 3; ++i) { const int idx = tid + 512 * i, sl = idx >> 3, dc = idx & 7;
            *(LAS u32x4*)(Ks + sl * AT_KS + dc * 8) = pk[i];
            *(LAS u32x4*)(Vl + (dc >> 1) * AT_VB + 32 * sl + 128 * (sl >> 3) + (dc & 1) * 16) = pv[i]; }
        LDS_BARRIER();
        const int hq = g * 8 + w.wave; const float sink2 = sinks[hq] * 1.4426950408889634f;
        const int i0 = (c < NCHP) ? (c == 0 ? 4 : (c == 1 ? 2 : 0)) : 0;
        const LAS unsigned char* vbase = Vl + ((lane >> 4) & 1) * AT_VB + 128 * h + 32 * ((lane & 15) >> 2) + 8 * (lane & 3);
#pragma unroll 1
        for (int qh = 0; qh < 2; ++qh) {
            bf16x8 qf[4];
#pragma unroll
            for (int sx = 0; sx < 4; ++sx) qf[sx] = qn[sx];
            if (qh == 0) { attn_load_q(Qb, c, 1, hq, r, h, qn); if (un < NU) attn_load_kv(Kb, Vb, ck, cv, cn, gn, tid, pk, pv); }
            else if (un < NU) attn_load_q(Qb, cn, 0, gn * 8 + w.wave, r, h, qn);
            const int qrow = 64 * c + 32 * qh + r;
            float mx = sink2;
#pragma unroll
            for (int i = 0; i < 6; ++i) if (i >= i0) { f32x16 t = zero16();
#pragma unroll
                for (int sx = 0; sx < 4; ++sx) { const bf16x8 kf = *(const LAS bf16x8*)(Ks + (32 * i + r) * AT_KS + 16 * sx + 8 * h); t = MFMA32(kf, qf[sx], t); }
#pragma unroll
                for (int e = 0; e < 16; ++e) mx = fmaxf(mx, t[e]); }
            mx = fmaxf(mx, __shfl_xor(mx, 32));
            float sum = 0.f; bf16x8 pf[6][2];
#pragma unroll
            for (int i = 0; i < 6; ++i) if (i >= i0) { f32x16 t = zero16();
#pragma unroll
                for (int sx = 0; sx < 4; ++sx) { const bf16x8 kf = *(const LAS bf16x8*)(Ks + (32 * i + r) * AT_KS + 16 * sx + 8 * h); t = MFMA32(kf, qf[sx], t); }
#pragma unroll
                for (int e = 0; e < 16; ++e) { t[e] = __builtin_amdgcn_exp2f(t[e] - mx); sum += t[e]; }
                pf[i][0] = pack8(t, 0); pf[i][1] = pack8(t, 1); }
            sum += __shfl_xor(sum, 32);
            const float inv = 1.f / (sum + __builtin_amdgcn_exp2f(sink2 - mx));
            f32x16 ot[2]; ot[0] = zero16(); ot[1] = zero16();
#pragma unroll
            for (int i = 0; i < 6; ++i) if (i >= i0) {
#pragma unroll
                for (int s2 = 0; s2 < 2; ++s2) {
#pragma unroll
                    for (int dt = 0; dt < 2; ++dt) { const LAS unsigned char* vp = vbase + dt * (2 * AT_VB) + i * 1536 + s2 * 768; const s16x4 lo = ds_tr(vp), hi = ds_tr(vp + 384);
                        const bf16x8 vf = __builtin_shufflevector(lo, hi, 0, 1, 2, 3, 4, 5, 6, 7); ot[dt] = MFMA32(vf, pf[i][s2], ot[dt]); } } }
#pragma unroll
            for (int dt = 0; dt < 2; ++dt)
#pragma unroll
                for (int gq = 0; gq < 4; ++gq) { u32x2 o; o.x = pk2(ot[dt][4 * gq] * inv, ot[dt][4 * gq + 1] * inv); o.y = pk2(ot[dt][4 * gq + 2] * inv, ot[dt][4 * gq + 3] * inv);
                    *(u32x2*)(AO + (size_t)qrow * DM + hq * 64 + 32 * dt + 8 * gq + 4 * h) = o; }
        }
    }
}
DI void cache_shift(const WG& w, const float* ck, const float* cv, float* kS, float* vS) {
    const int n4 = DBATCH * 64 * 256 / 4;
    for (int i = w.bid * 512 + w.tid; i < n4; i += w.G * 512) { const int b = i / (64 * 64), rem = i % (64 * 64);
        ((f32x4*)kS)[(size_t)b * (128 * 64) + rem] = ((const f32x4*)ck)[(size_t)b * (128 * 64) + 64 * 64 + rem];
        ((f32x4*)vS)[(size_t)b * (128 * 64) + rem] = ((const f32x4*)cv)[(size_t)b * (128 * 64) + 64 * 64 + rem]; }
}

DI float ret_lg2(int hh) { return __log2f(1.f - __builtin_amdgcn_exp2f(-5.f - (float)hh)); }
constexpr int RI_KS = 264, RI_VS = 68, RI_V_OFF = 64 * RI_KS * 2;
DI void ret_intra_phase(const WG& w, const bf16_t* P, bf16_t* O) {
    LAS bf16_t* Ks = (LAS bf16_t*)(w.lds); LAS bf16_t* Vt = (LAS bf16_t*)(w.lds + RI_V_OFF);
    const int lane = w.lane, r = lane & 31, h = lane >> 5, tt = w.wave & 1, dvq = w.wave >> 1;
    for (int u = w.bid; u < NCH * RH; u += w.G) {
        const int c = u >> 3, hh = u & 7; const float lg2 = ret_lg2(hh);
        LDS_BARRIER();
#pragma unroll
        for (int i = 0; i < 4; ++i) { const int idx = w.tid + 512 * i, s = idx >> 5, dc = idx & 31;
            *(LAS u32x4*)(Ks + s * RI_KS + dc * 8) = *(const u32x4*)(P + (size_t)(64 * c + s) * RIN + 2048 + hh * 256 + dc * 8); }
#pragma unroll
        for (int i = 0; i < 8; ++i) { const int idx = w.tid + 512 * i, s = idx >> 6, dc = idx & 63;
            const u32x4 vv = *(const u32x4*)(P + (size_t)(64 * c + s) * RIN + 4096 + hh * 512 + dc * 8); const unsigned e[4] = {vv.x, vv.y, vv.z, vv.w};
#pragma unroll
            for (int j = 0; j < 4; ++j) { Vt[(dc * 8 + 2 * j) * RI_VS + s] = (bf16_t)(e[j] & 0xffffu); Vt[(dc * 8 + 2 * j + 1) * RI_VS + s] = (bf16_t)(e[j] >> 16); } }
        LDS_BARRIER();
        const int qrow = 64 * c + 32 * tt + r;
        f32x16 st[2]; st[0] = zero16(); st[1] = zero16();
#pragma unroll 4
        for (int ks = 0; ks < 16; ++ks) { const bf16x8 qf = *(const bf16x8*)(P + (size_t)qrow * RIN + hh * 256 + 16 * ks + 8 * h);
#pragma unroll
            for (int si = 0; si < 2; ++si) if (si <= tt) { const bf16x8 kf = *(const LAS bf16x8*)(Ks + (32 * si + r) * RI_KS + 16 * ks + 8 * h); st[si] = MFMA32(kf, qf, st[si]); } }
        const int t = 32 * tt + r;
#pragma unroll
        for (int si = 0; si < 2; ++si)
#pragma unroll
            for (int e = 0; e < 16; ++e) { const int s = 32 * si + (e & 3) + 8 * (e >> 2) + 4 * h; st[si][e] = (s <= t) ? st[si][e] * __builtin_amdgcn_exp2f(lg2 * (float)(t - s)) : 0.f; }
        f32x16 ot[4];
#pragma unroll
        for (int d = 0; d < 4; ++d) ot[d] = zero16();
#pragma unroll
        for (int si = 0; si < 2; ++si) if (si <= tt) {
#pragma unroll
            for (int s2 = 0; s2 < 2; ++s2) { const bf16x8 pf = pack8(st[si], s2);
#pragma unroll
                for (int d = 0; d < 4; ++d) { const bf16x8 vf = ld_perm_frag(Vt + (128 * dvq + 32 * d + r) * RI_VS + 32 * si + 16 * s2 + 4 * h); ot[d] = MFMA32(vf, pf, ot[d]); } } }
#pragma unroll
        for (int d = 0; d < 4; ++d)
#pragma unroll
            for (int gq = 0; gq < 4; ++gq) { u32x2 o; o.x = pk2(ot[d][4 * gq], ot[d][4 * gq + 1]); o.y = pk2(ot[d][4 * gq + 2], ot[d][4 * gq + 3]);
                *(u32x2*)(O + (size_t)qrow * RVD + hh * 512 + 128 * dvq + 32 * d + 8 * gq + 4 * h) = o; }
    }
}
constexpr int RC_QS = 264, RC_QX = 0, RC_KZ = 33792, RC_VT = 82944, RC_OS = 107520, RC_OSS = 20, RC_BLK = 3072, RC_PT = 148480, RC_PS = 72;
constexpr int RGRP = 8, RNG = NCHP / RGRP;
#define MFMA16(a, b, c) __builtin_amdgcn_mfma_f32_16x16x32_bf16((a), (b), (c), 0, 0, 0)
DI unsigned blk_row(unsigned r) { return 32u * r + 128u * (r >> 3); }
DI unsigned tr_base(unsigned lane) { const unsigned g = lane >> 4, q = (lane & 15) >> 2, p = lane & 3; return blk_row(8 * g + q) + 8 * p; }
DI bf16x8 tr_frag(const LAS unsigned char* base_lane, int c, int ks) {
    const s16x4 lo = ds_tr(base_lane + c * RC_BLK + ks * 1536), hi = ds_tr(base_lane + c * RC_BLK + ks * 1536 + 128); return __builtin_shufflevector(lo, hi, 0, 1, 2, 3, 4, 5, 6, 7);
}
DI u32x4 scale8(u32x4 v, float s) { u32x4 o; o.x = pk2(bflo(v.x) * s, bfhi(v.x) * s); o.y = pk2(bflo(v.y) * s, bfhi(v.y) * s); o.z = pk2(bflo(v.z) * s, bfhi(v.z) * s); o.w = pk2(bflo(v.w) * s, bfhi(v.w) * s); return o; }
template <bool LOAD, bool BF> DI void ret_state_io(LAS unsigned char* L, void* gpv  , f32x4 (&S)[16], int tid, int wave) {
    LAS float* T = (LAS float*)(L + RC_QX); const int lane = tid & 63, c16 = lane & 15, g = lane >> 4; float* gp = (float*)gpv; bf16_t* gb = (bf16_t*)gpv;
#pragma unroll
    for (int p = 0; p < 4; ++p) {
        LDS_BARRIER();
        if (LOAD) {
            if (BF) {
#pragma unroll
                for (int i = 0; i < 2; ++i) { const int idx = tid + 512 * i, row = idx >> 4, c8 = idx & 15; const u32x4 v = *(const u32x4*)(gb + (size_t)(64 * p + row) * RDV + 8 * c8); LAS float* tp = T + row * 132 + 8 * c8;
                    tp[0] = bflo(v.x); tp[1] = bfhi(v.x); tp[2] = bflo(v.y); tp[3] = bfhi(v.y); tp[4] = bflo(v.z); tp[5] = bfhi(v.z); tp[6] = bflo(v.w); tp[7] = bfhi(v.w); }
            } else {
#pragma unroll
                for (int i = 0; i < 4; ++i) { const int idx = tid + 512 * i, row = idx >> 5, c4 = idx & 31; const f32x4 v = *(const f32x4*)(gp + (size_t)(64 * p + row) * RDV + 4 * c4); LAS float* tp = T + row * 132 + 4 * c4; tp[0] = v.x; tp[1] = v.y; tp[2] = v.z; tp[3] = v.w; }
            }
            LDS_BARRIER();
#pragma unroll
            for (int kq = 0; kq < 4; ++kq)
#pragma unroll
                for (int i = 0; i < 4; ++i) { const float v = T[(16 * kq + 4 * g + i) * 132 + 16 * wave + c16];
                    S[4 * p + kq][i] = v; }
        } else {
#pragma unroll
            for (int kq = 0; kq < 4; ++kq)
#pragma unroll
                for (int i = 0; i < 4; ++i) { const float v = S[4 * p + kq][i]; T[(16 * kq + 4 * g + i) * 132 + 16 * wave + c16] = v; }
            LDS_BARRIER();
            if (BF) {
#pragma unroll
                for (int i = 0; i < 2; ++i) { const int idx = tid + 512 * i, row = idx >> 4, c8 = idx & 15; const LAS float* tp = T + row * 132 + 8 * c8;
                    u32x4 o; o.x = pk2(tp[0], tp[1]); o.y = pk2(tp[2], tp[3]); o.z = pk2(tp[4], tp[5]); o.w = pk2(tp[6], tp[7]); *(u32x4*)(gb + (size_t)(64 * p + row) * RDV + 8 * c8) = o; }
            } else {
#pragma unroll
                for (int i = 0; i < 4; ++i) { const int idx = tid + 512 * i, row = idx >> 5, c4 = idx & 31; const LAS float* tp = T + row * 132 + 4 * c4; *(f32x4*)(gp + (size_t)(64 * p + row) * RDV + 4 * c4) = (f32x4){tp[0], tp[1], tp[2], tp[3]}; }
            }
        }
    }
    LDS_BARRIER();
}
template <int MODE>
DI void ret_chain_phase(const WG& w, const bf16_t* P, bf16_t* O, const float* state_in, bf16_t* slots, float* outS, int dup) {
    LAS unsigned char* L = w.lds;
    const int ntask = (MODE == 0) ? RNG * 32 : RNG * 32 + DBATCH * 32;
    for (int task = w.bid; task < ntask; task += w.G) {
        const bool smp = task >= RNG * 32; const int ts = smp ? task - RNG * 32 : task, gb = ts >> 5, hh = (ts >> 2) & 7, j = ts & 3;
        const int c_lo = smp ? NCHP + gb : RGRP * gb, nch = smp ? 1 : RGRP;
        const size_t so = ((size_t)gb * RH + hh) * RDK * RDV;
        const int dvw = 128 * j + 16 * w.wave; const float lg2 = ret_lg2(hh), gam64 = __builtin_amdgcn_exp2f(lg2 * 64.f);
        int lane0 = w.lane; asm volatile("" : "+v"(lane0));
        f32x4 S[16];
        if (MODE == 1) { if (smp) ret_state_io<true, false>(L, (void*)(state_in + so + 128 * j), S, w.tid, w.wave); else ret_state_io<true, true>(L, (void*)(slots + so + 128 * j), S, w.tid, w.wave); }
        else {
#pragma unroll
            for (int kt = 0; kt < 16; ++kt) S[kt] = (f32x4){0.f, 0.f, 0.f, 0.f}; }
        u32x4 pq[4], pk[4], pv[2];
        {   const int tid = w.tid;
#pragma unroll
            for (int i = 0; i < 4; ++i) { const int idx = tid + 512 * i, t = idx >> 5, dc = idx & 31; const bf16_t* pr = P + (size_t)(64 * c_lo + t) * RIN + hh * 256 + dc * 8;
                if (MODE == 1) pq[i] = *(const u32x4*)pr; pk[i] = *(const u32x4*)(pr + 2048); }
#pragma unroll
            for (int i = 0; i < 2; ++i) { const int idx = tid + 512 * i, t = idx >> 4, dc = idx & 15; pv[i] = *(const u32x4*)(P + (size_t)(64 * c_lo + t) * RIN + 4096 + hh * 512 + 128 * j + dc * 8); } }
#pragma unroll 1
        for (int cc = 0; cc < nch; ++cc) { const int c = c_lo + cc;
            int tid = w.tid; asm volatile("" : "+v"(tid)); const int ln = tid & 63, c16 = ln & 15, g = ln >> 4;
            LDS_BARRIER();
#pragma unroll
            for (int i = 0; i < 4; ++i) { const int idx = tid + 512 * i, t = idx >> 5, dc = idx & 31;
                if (MODE == 1) *(LAS u32x4*)(L + RC_QX + (t * RC_QS + dc * 8) * 2) = scale8(pq[i], __builtin_amdgcn_exp2f(lg2 * (float)(t + 1)));
                *(LAS u32x4*)(L + RC_KZ + (dc >> 1) * RC_BLK + blk_row(t) + (dc & 1) * 16) = scale8(pk[i], __builtin_amdgcn_exp2f(lg2 * (float)(63 - t))); }
#pragma unroll
            for (int i = 0; i < 2; ++i) { const int idx = tid + 512 * i, t = idx >> 4, dc = idx & 15; *(LAS u32x4*)(L + RC_VT + (dc >> 1) * RC_BLK + blk_row(t) + (dc & 1) * 16) = pv[i]; }
            LDS_BARRIER();
            if (cc + 1 < nch) {
#pragma unroll
                for (int i = 0; i < 4; ++i) { const int idx = tid + 512 * i, t = idx >> 5, dc = idx & 31; const bf16_t* pr = P + (size_t)(64 * (c + 1) + t) * RIN + hh * 256 + dc * 8;
                    if (MODE == 1) pq[i] = *(const u32x4*)pr; pk[i] = *(const u32x4*)(pr + 2048); }
#pragma unroll
                for (int i = 0; i < 2; ++i) { const int idx = tid + 512 * i, t = idx >> 4, dc = idx & 15; pv[i] = *(const u32x4*)(P + (size_t)(64 * (c + 1) + t) * RIN + 4096 + hh * 512 + 128 * j + dc * 8); } }
            const LAS unsigned char* kb = L + RC_KZ + tr_base(ln); const LAS unsigned char* vb = L + RC_VT + tr_base(ln) + w.wave * RC_BLK;
            const bf16x8 vf0 = tr_frag(vb, 0, 0), vf1 = tr_frag(vb, 0, 1);
            if (MODE == 1) {
                const LAS bf16_t* Qx = (const LAS bf16_t*)(L + RC_QX); LAS bf16_t* PT = (LAS bf16_t*)(L + RC_PT);
                const float gm64 = __builtin_amdgcn_exp2f(-64.f * lg2);
#pragma unroll
                for (int q2 = 0; q2 < 2; ++q2) { const int tile = w.wave + 8 * q2, tt = tile >> 2, st = tile & 3; f32x4 d = (f32x4){0.f, 0.f, 0.f, 0.f};
                    if (st <= tt) {
#pragma unroll
                        for (int ks = 0; ks < 8; ++ks) { const bf16x8 af = *(const LAS bf16x8*)(Qx + (16 * tt + c16) * RC_QS + 32 * ks + 8 * g);
                            const bf16x8 bfr = *(const LAS bf16x8*)(L + RC_KZ + (2 * ks + (g >> 1)) * RC_BLK + blk_row(16 * st + c16) + 16 * (g & 1)); d = MFMA16(af, bfr, d); } }
#pragma unroll
                    for (int i = 0; i < 4; ++i) { const int t = 16 * tt + 4 * g + i, sx = 16 * st + c16; PT[t * RC_PS + sx] = f2bf((sx <= t) ? d[i] * gm64 : 0.f); } }
                f32x4 o[4];
#pragma unroll
                for (int tt = 0; tt < 4; ++tt) o[tt] = (f32x4){0.f, 0.f, 0.f, 0.f};
#pragma unroll
                for (int kp = 0; kp < 8; ++kp) { u32x4 sp; sp.x = pk2(S[2 * kp][0], S[2 * kp][1]); sp.y = pk2(S[2 * kp][2], S[2 * kp][3]); sp.z = pk2(S[2 * kp + 1][0], S[2 * kp + 1][1]); sp.w = pk2(S[2 * kp + 1][2], S[2 * kp + 1][3]);
                    const bf16x8 sf = __builtin_bit_cast(bf16x8, sp);
#pragma unroll
                    for (int tt = 0; tt < 4; ++tt) { const LAS bf16_t* qp = Qx + (16 * tt + c16) * RC_QS + 32 * kp + 4 * g; const s16x4 lo = *(const LAS s16x4*)qp, hi = *(const LAS s16x4*)(qp + 16);
                        const bf16x8 af = __builtin_shufflevector(lo, hi, 0, 1, 2, 3, 4, 5, 6, 7); o[tt] = MFMA16(af, sf, o[tt]); } if (kp & 1) asm volatile("" ::: "memory"); }
                LDS_BARRIER();
#pragma unroll
                for (int tt = 0; tt < 4; ++tt) { const bf16x8 p0 = *(const LAS bf16x8*)(PT + (16 * tt + c16) * RC_PS + 8 * g), p1 = *(const LAS bf16x8*)(PT + (16 * tt + c16) * RC_PS + 32 + 8 * g);
                    o[tt] = MFMA16(p0, vf0, o[tt]); o[tt] = MFMA16(p1, vf1, o[tt]); }
                LAS float* os = (LAS float*)(L + RC_OS + w.wave * (64 * RC_OSS * 4));
#pragma unroll
                for (int tt = 0; tt < 4; ++tt)
#pragma unroll
                    for (int i = 0; i < 4; ++i) os[(16 * tt + 4 * g + i) * RC_OSS + c16] = o[tt][i];
                const f32x4 r0 = *(const LAS f32x4*)(os + ln * RC_OSS), r1 = *(const LAS f32x4*)(os + ln * RC_OSS + 4), r2 = *(const LAS f32x4*)(os + ln * RC_OSS + 8), r3 = *(const LAS f32x4*)(os + ln * RC_OSS + 12);
                u32x4 n0, n1; n0.x = pk2(r0.x, r0.y); n0.y = pk2(r0.z, r0.w); n0.z = pk2(r1.x, r1.y); n0.w = pk2(r1.z, r1.w); n1.x = pk2(r2.x, r2.y); n1.y = pk2(r2.z, r2.w); n1.z = pk2(r3.x, r3.y); n1.w = pk2(r3.z, r3.w);
                bf16_t* orow = O + (size_t)(64 * c + ln) * RVD + hh * 512 + dvw;
                if (!dup) { *(u32x4*)orow = n0; *(u32x4*)(orow + 8) = n1; }
            }
            if (MODE == 0 || smp || cc + 1 < nch) {
#pragma unroll
                for (int kt = 0; kt < 16; ++kt) { S[kt] = S[kt] * gam64;
                    const bf16x8 k0 = tr_frag(kb, kt, 0), k1 = tr_frag(kb, kt, 1);
                    S[kt] = MFMA16(k0, vf0, S[kt]); S[kt] = MFMA16(k1, vf1, S[kt]); if ((kt & 3) == 3) asm volatile("" ::: "memory"); }
            }
        }
        if (MODE == 0) ret_state_io<false, true>(L, (void*)(slots + so + 128 * j), S, w.tid, w.wave); else if (smp) ret_state_io<false, false>(L, (void*)(outS + so + 128 * j), S, w.tid, w.wave);
    }
}
DI void ret_prefix_phase(const WG& w, bf16_t* slots, float* outP) {
    constexpr int N8 = RH * RDK * RDV / 8;
    for (int e = w.bid * 512 + w.tid; e < N8; e += w.G * 512) { const int hh = e / (RDK * RDV / 8); const float g512 = __builtin_amdgcn_exp2f(ret_lg2(hh) * (float)(64 * RGRP));
        float carry[8];
#pragma unroll
        for (int q = 0; q < 8; ++q) carry[q] = 0.f;
#pragma unroll 8
        for (int g = 0; g < RNG; ++g) { u32x4* p = (u32x4*)slots + (size_t)g * N8 + e; const u32x4 t = *p;
            u32x4 o; o.x = pk2(carry[0], carry[1]); o.y = pk2(carry[2], carry[3]); o.z = pk2(carry[4], carry[5]); o.w = pk2(carry[6], carry[7]); *p = o;
            const float tv[8] = {bflo(t.x), bfhi(t.x), bflo(t.y), bfhi(t.y), bflo(t.z), bfhi(t.z), bflo(t.w), bfhi(t.w)};
#pragma unroll
            for (int q = 0; q < 8; ++q) carry[q] = carry[q] * g512 + tv[q]; }
        ((f32x4*)outP)[2 * e] = (f32x4){carry[0], carry[1], carry[2], carry[3]}; ((f32x4*)outP)[2 * e + 1] = (f32x4){carry[4], carry[5], carry[6], carry[7]}; }
}
DI void ret_gn_phase(const WG& w, const bf16_t* P, bf16_t* O, const float* gnw, bf16_t* Odst) {
    for (int idx0 = w.gw * 4; idx0 < M * RH; idx0 += w.ngw * 4) {
        u32x4 ov[4], gv[4];
#pragma unroll
        for (int q = 0; q < 4; ++q) { const int idx = idx0 + q, m = idx >> 3, hh = idx & 7; ov[q] = *(const u32x4*)(O + (size_t)m * RVD + hh * 512 + 8 * w.lane); gv[q] = *(const u32x4*)(P + (size_t)m * RIN + 8192 + hh * 512 + 8 * w.lane); }
#pragma unroll
        for (int q = 0; q < 4; ++q) { const int idx = idx0 + q, m = idx >> 3, hh = idx & 7;
            float x[8] = {bflo(ov[q].x), bfhi(ov[q].x), bflo(ov[q].y), bfhi(ov[q].y), bflo(ov[q].z), bfhi(ov[q].z), bflo(ov[q].w), bfhi(ov[q].w)};
            const float gt[8] = {bflo(gv[q].x), bfhi(gv[q].x), bflo(gv[q].y), bfhi(gv[q].y), bflo(gv[q].z), bfhi(gv[q].z), bflo(gv[q].w), bfhi(gv[q].w)};
            float s = 0.f;
#pragma unroll
            for (int e = 0; e < 8; ++e) s += x[e];
            const float mean = wave_sum_fast(s) * (1.f / 512.f); float s2 = 0.f;
#pragma unroll
            for (int e = 0; e < 8; ++e) { x[e] -= mean; s2 += x[e] * x[e]; }
            const float rs = 1.f / sqrtf(wave_sum_fast(s2) * (1.f / 512.f) + 1e-5f);
            const float* gp = gnw + hh * 512 + 8 * w.lane; const f32x4 g0 = *(const f32x4*)gp, g1 = *(const f32x4*)(gp + 4); const float gw8[8] = {g0.x, g0.y, g0.z, g0.w, g1.x, g1.y, g1.z, g1.w};
#pragma unroll
            for (int e = 0; e < 8; ++e) x[e] = x[e] * rs * gw8[e] * (gt[e] / (1.f + __expf(-gt[e])));
            u32x4 o; o.x = pk2(x[0], x[1]); o.y = pk2(x[2], x[3]); o.z = pk2(x[4], x[5]); o.w = pk2(x[6], x[7]); *(u32x4*)(Odst + (size_t)m * RVD + hh * 512 + 8 * w.lane) = o; }
    }
}
constexpr int REC_WT = 0, REC_BHT = 8192, REC_RT = 16384, REC_ARB = 24576, REC_VT = 32768, REC_VK = 40960, REC_AKV = 49152, REC_PL = 57344, REC = 57600;
constexpr int WSEG = 32, WNSEG = NCHP / WSEG;
constexpr size_t SEGBUF = (size_t)WSEG * WH * REC;
constexpr int PP_S = 72;
constexpr int PP_AT = 0, PP_RT = 9216, PP_BT = 18432, PP_KT = 27648, PP_KH = 36864, PP_VT = 46080, PP_AAK = 55296, PP_ARK = 64512, PP_AAB = 73728, PP_X2 = 90112, PP_PART = 106496, PP_X1 = 110592, PP_ARB = 126976, PP_BHT = 136192, PP_MT = 145408;
DI int pswap(int k) { return (k & ~12) | ((k & 4) << 1) | ((k & 8) >> 1); }

DI void copy_tile_pswap(const LAS bf16_t* T, unsigned char* dst, int task) {
    const int row = task >> 2, m = task & 3; const LAS u32x4* sp = (const LAS u32x4*)(T + row * PP_S + 16 * m); const u32x4 a = sp[0], b = sp[1];
    u32x4 o0, o1; o0.x = a.x; o0.y = a.y; o0.z = b.x; o0.w = b.y; o1.x = a.z; o1.y = a.w; o1.z = b.z; o1.w = b.w;
    u32x4* dp = (u32x4*)(dst + row * 128 + 32 * m); dp[0] = o0; dp[1] = o1;
}
DI void copy_tile_pswap_f32(const LAS float* T, unsigned char* dst, int task) {
    const int row = task >> 2, m = task & 3; const LAS f32x4* sp = (const LAS f32x4*)(T + row * 64 + 16 * m); const f32x4 a0 = sp[0], a1 = sp[1], b0 = sp[2], b1 = sp[3];
    u32x4 o0, o1; o0.x = pk2(a0.x, a0.y); o0.y = pk2(a0.z, a0.w); o0.z = pk2(b0.x, b0.y); o0.w = pk2(b0.z, b0.w); o1.x = pk2(a1.x, a1.y); o1.y = pk2(a1.z, a1.w); o1.z = pk2(b1.x, b1.y); o1.w = pk2(b1.z, b1.w);
    u32x4* dp = (u32x4*)(dst + row * 128 + 32 * m); dp[0] = o0; dp[1] = o1;
}
struct RwkvIn { const bf16_t *Rb, *Kb, *Vb, *Ab, *Gb; const float* LW; const float *k_k, *k_a, *r_k, *ln_w, *ln_b; float* bonus; bf16_t* Ob; };

struct PrepRaw { unsigned short rb[8], kb[8], vb[8], ab[8]; float lw[8]; };
DI void prep_load(const WG& w, const RwkvIn& in, int c, int hd, PrepRaw& q) {
    int lane = w.lane; asm volatile("" : "+v"(lane));
#pragma unroll
    for (int i = 0; i < 8; ++i) { const size_t off = (size_t)(64 * c + 8 * w.wave + i) * DM + hd * 64 + lane; q.rb[i] = in.Rb[off]; q.kb[i] = in.Kb[off]; q.vb[i] = in.Vb[off]; q.ab[i] = in.Ab[off]; q.lw[i] = in.LW[off]; }
}
DI void rwkv_prep_pair(const WG& w, const RwkvIn& in, int c, int hd, unsigned char* rec, const PrepRaw& raw, gu32* qctr, volatile LAS unsigned* qw) {
    LAS bf16_t* AT = (LAS bf16_t*)(w.lds + PP_AT); LAS bf16_t* RT2 = (LAS bf16_t*)(w.lds + PP_RT); LAS bf16_t* BT = (LAS bf16_t*)(w.lds + PP_BT); LAS bf16_t* KT = (LAS bf16_t*)(w.lds + PP_KT);
    LAS bf16_t* KHt = (LAS bf16_t*)(w.lds + PP_KH); LAS bf16_t* VtL = (LAS bf16_t*)(w.lds + PP_VT); LAS bf16_t* AAK = (LAS bf16_t*)(w.lds + PP_AAK); LAS bf16_t* ARK = (LAS bf16_t*)(w.lds + PP_ARK);
    LAS float* AAB = (LAS float*)(w.lds + PP_AAB); LAS float* X2 = (LAS float*)(w.lds + PP_X2); LAS float* PART = (LAS float*)(w.lds + PP_PART); LAS float* X1 = (LAS float*)(w.lds + PP_X1); LAS bf16_t* ARBT = (LAS bf16_t*)(w.lds + PP_ARB); LAS bf16_t* BHT_T = (LAS bf16_t*)(w.lds + PP_BHT);
    int lane_ = w.lane; asm volatile("" : "+v"(lane_));
    const int lane = lane_, tg = w.wave, col = hd * 64 + lane, r = lane & 31, h = lane >> 5;
    LDS_BARRIER();
    {
        const float kkc = in.k_k[col], kac = in.k_a[col], rkc = in.r_k[col];
        float rr[8], kp[8], aa[8], lw[8], kk[8], cl[8], bsum[8]; unsigned short vb[8], kb[8];
        float run = 0.f;
#pragma unroll
        for (int i = 0; i < 8; ++i) { rr[i] = bf2f(raw.rb[i]); kb[i] = raw.kb[i]; vb[i] = raw.vb[i]; aa[i] = bf2f(raw.ab[i]); lw[i] = raw.lw[i]; }
#pragma unroll
        for (int i = 0; i < 8; ++i) { const float kr = bf2f(kb[i]);
            const float kkr = kr * kkc; const float ss = wave_sum_fast(kkr * kkr); kk[i] = kkr / fmaxf(sqrtf(ss), 1e-12f); kp[i] = kr * (1.f + (aa[i] - 1.f) * kac);
            bsum[i] = wave_sum_fast(rr[i] * kp[i] * rkc);
            run += lw[i]; cl[i] = run; }
        if (lane < 8) { float bv = bsum[0];
#pragma unroll
            for (int i = 1; i < 8; ++i) bv = (lane == i) ? bsum[i] : bv;
            in.bonus[(size_t)(64 * c + 8 * tg + lane) * WH + hd] = bv; }
        PART[tg * 64 + lane] = run;
        LDS_BARRIER();
        float pre = 0.f, tot = 0.f;
#pragma unroll
        for (int t2 = 0; t2 < 8; ++t2) { const float p = PART[t2 * 64 + lane]; tot += p; if (t2 < tg) pre += p; }
        unsigned short khs[8], bhs[8];
#pragma unroll
        for (int i = 0; i < 8; ++i) { const int t = 8 * tg + i; const float cs = pre + cl[i], csp = cs - lw[i];
            const float e_cs = __expf(cs), e_ncs = __expf(-cs), e_csp = __expf(csp), e_l = __expf(tot - cs); const float b = kk[i] * aa[i];
            const unsigned short rt = f2bf(rr[i] * e_cs);
            AT[t * PP_S + lane] = f2bf(-kk[i] * e_csp); RT2[t * PP_S + lane] = rt; BT[t * PP_S + lane] = f2bf(b * e_ncs); KT[t * PP_S + lane] = f2bf(kp[i] * e_ncs);
            khs[i] = f2bf(kp[i] * e_l); bhs[i] = f2bf(b * e_l); }
        u32x4 kq, vq; kq.x = khs[0] | ((unsigned)khs[1] << 16); kq.y = khs[2] | ((unsigned)khs[3] << 16); kq.z = khs[4] | ((unsigned)khs[5] << 16); kq.w = khs[6] | ((unsigned)khs[7] << 16);
        vq.x = vb[0] | ((unsigned)vb[1] << 16); vq.y = vb[2] | ((unsigned)vb[3] << 16); vq.z = vb[4] | ((unsigned)vb[5] << 16); vq.w = vb[6] | ((unsigned)vb[7] << 16);
        *(LAS u32x4*)(KHt + lane * PP_S + 8 * tg) = kq; *(LAS u32x4*)(VtL + lane * PP_S + 8 * tg) = vq;
        { u32x4 bq; bq.x = bhs[0] | ((unsigned)bhs[1] << 16); bq.y = bhs[2] | ((unsigned)bhs[3] << 16); bq.z = bhs[4] | ((unsigned)bhs[5] << 16); bq.w = bhs[6] | ((unsigned)bhs[7] << 16);
          *(LAS u32x4*)(BHT_T + lane * PP_S + 8 * tg) = bq; }
        if (tg == 0) ((float*)(rec + REC_PL))[lane] = __expf(tot);
    }
    LDS_BARRIER();
    {
        const int pi = tg >> 1, tt = tg & 1; const LAS bf16_t* X = (pi < 2) ? AT : RT2; const LAS bf16_t* Y = (pi & 1) ? KT : BT;
#pragma unroll
        for (int si = 0; si < 2; ++si) { f32x16 d = zero16();
            if (si <= tt) {
#pragma unroll
                for (int ks = 0; ks < 4; ++ks) { const bf16x8 xa = *(const LAS bf16x8*)(X + (32 * tt + r) * PP_S + 16 * ks + 8 * h), yb = *(const LAS bf16x8*)(Y + (32 * si + r) * PP_S + 16 * ks + 8 * h);
                    d = (pi == 0) ? MFMA32(yb, xa, d) : MFMA32(xa, yb, d); } }
            if (pi == 0) {
#pragma unroll
                for (int e = 0; e < 16; ++e) { const int sx = 32 * si + (e & 3) + 8 * (e >> 2) + 4 * h, t = 32 * tt + r; AAB[sx * 64 + t] = (sx < t) ? d[e] : 0.f; }
            } else { const int sx = 32 * si + r;
#pragma unroll
                for (int e = 0; e < 16; ++e) { const int t = 32 * tt + (e & 3) + 8 * (e >> 2) + 4 * h; const bool keep = (pi < 2) ? (sx < t) : (sx <= t); const float val = keep ? d[e] : 0.f;
                    if (pi == 1) AAK[t * PP_S + sx] = f2bf(val); else if (pi == 3) ARK[t * PP_S + sx] = f2bf(val); else ARBT[t * PP_S + sx] = f2bf(val); } } }
    }
    LDS_BARRIER();
    if (tg == 7 && lane == 0) qw[0] = __hip_atomic_fetch_add(qctr, 1u, __ATOMIC_RELAXED, __HIP_MEMORY_SCOPE_AGENT);
    for (int id = tg; id < 12; id += 8) { const int prod = id >> 2, it = (id >> 1) & 1, vt = id & 1; const LAS bf16_t* Am = (prod == 0) ? AAK : (prod == 1 ? ARK : KHt);
        f32x16 d = zero16();
#pragma unroll
        for (int ks = 0; ks < 4; ++ks) { const bf16x8 a = *(const LAS bf16x8*)(Am + (32 * it + r) * PP_S + 16 * ks + 8 * h), b = *(const LAS bf16x8*)(VtL + (32 * vt + r) * PP_S + 16 * ks + 8 * h); d = MFMA32(a, b, d); }
        if (prod == 0) {
#pragma unroll
            for (int e = 0; e < 16; ++e) X2[(32 * it + (e & 3) + 8 * (e >> 2) + 4 * h) * 64 + 32 * vt + r] = d[e];
        } else { u32x4* dst = (u32x4*)(rec + (prod == 1 ? REC_AKV : REC_VK) + ((it * 2 + vt) * 64 + lane) * 32);
            u32x4 o0, o1; o0.x = pk2(d[0], d[1]); o0.y = pk2(d[2], d[3]); o0.z = pk2(d[4], d[5]); o0.w = pk2(d[6], d[7]); o1.x = pk2(d[8], d[9]); o1.y = pk2(d[10], d[11]); o1.z = pk2(d[12], d[13]); o1.w = pk2(d[14], d[15]);
            dst[0] = o0; dst[1] = o1; } }
    LAS bf16_t* MT = (LAS bf16_t*)(w.lds + PP_MT);
    if (tg >= 4) {
        const int b = tg - 4; float y[16]; const bool live = b > (lane >> 4);
        const LAS f32x4* np = (const LAS f32x4*)(AAB + lane * 64 + 16 * b); const f32x4 n0 = np[0], n1 = np[1], n2 = np[2], n3 = np[3];
        const float nv[16] = {n0.x, n0.y, n0.z, n0.w, n1.x, n1.y, n1.z, n1.w, n2.x, n2.y, n2.z, n2.w, n3.x, n3.y, n3.z, n3.w};
#pragma unroll
        for (int i2 = 0; i2 < 16; ++i2) y[i2] = live ? nv[i2] : 0.f;
#pragma unroll
        for (int i2 = 0; i2 < 15; ++i2) { const LAS f32x4* ap = (const LAS f32x4*)(AAB + (16 * b + i2) * 64 + 16 * b); const f32x4 a0 = ap[0], a1 = ap[1], a2 = ap[2], a3 = ap[3];
            const float av[16] = {a0.x, a0.y, a0.z, a0.w, a1.x, a1.y, a1.z, a1.w, a2.x, a2.y, a2.z, a2.w, a3.x, a3.y, a3.z, a3.w};
#pragma unroll
            for (int i3 = i2 + 1; i3 < 16; ++i3) y[i3] += av[i3] * y[i2]; }
#pragma unroll
        for (int i2 = 0; i2 < 16; ++i2) MT[(16 * b + i2) * PP_S + lane] = f2bf(y[i2]);
    }
    LDS_BARRIER();
    LAS bf16_t* YT0 = BT; LAS bf16_t* YT1 = KHt;
    {
        const int b = tg & 3, colw = (tg >> 2) * 64 + lane; float y[16];
#pragma unroll
        for (int i2 = 0; i2 < 16; ++i2) y[i2] = (colw < 64) ? bf2f(AT[(16 * b + i2) * PP_S + colw]) : X2[(16 * b + i2) * 64 + colw - 64];
#pragma unroll
        for (int i2 = 0; i2 < 15; ++i2) { const LAS f32x4* ap = (const LAS f32x4*)(AAB + (16 * b + i2) * 64 + 16 * b); const f32x4 a0 = ap[0], a1 = ap[1], a2 = ap[2], a3 = ap[3];
            const float av[16] = {a0.x, a0.y, a0.z, a0.w, a1.x, a1.y, a1.z, a1.w, a2.x, a2.y, a2.z, a2.w, a3.x, a3.y, a3.z, a3.w};
#pragma unroll
            for (int i3 = i2 + 1; i3 < 16; ++i3) y[i3] += av[i3] * y[i2]; }
        LAS float* yf = (colw < 64) ? X1 + colw : X2 + (colw - 64);
#pragma unroll
        for (int i2 = 0; i2 < 16; ++i2) yf[(16 * b + i2) * 64] = y[i2];
        u32x4 o0, o1; o0.x = pk2(y[0], y[1]); o0.y = pk2(y[2], y[3]); o0.z = pk2(y[4], y[5]); o0.w = pk2(y[6], y[7]); o1.x = pk2(y[8], y[9]); o1.y = pk2(y[10], y[11]); o1.z = pk2(y[12], y[13]); o1.w = pk2(y[14], y[15]);
        LAS u32x4* yp = (LAS u32x4*)(YT0 + colw * PP_S + 16 * b); yp[0] = o0; yp[1] = o1;
    }
    LDS_BARRIER();
    {
        const int rt = tg & 1, ct = tg >> 1; LAS float* Yf = (ct < 2) ? X1 + 32 * ct : X2 + 32 * (ct - 2);
        f32x16 yacc;
#pragma unroll
        for (int e2 = 0; e2 < 16; ++e2) yacc[e2] = Yf[(32 * rt + (e2 & 3) + 8 * (e2 >> 2) + 4 * h) * 64 + r];
        bf16x8 mf[4];
#pragma unroll
        for (int ks = 0; ks < 4; ++ks) mf[ks] = *(const LAS bf16x8*)(MT + (32 * rt + r) * PP_S + 16 * ks + 8 * h);
#pragma unroll
        for (int st = 0; st < 3; ++st) { const LAS bf16_t* src = (st & 1) ? YT1 : YT0; LAS bf16_t* dstt = (st & 1) ? YT0 : YT1;
            f32x16 acc = yacc;
#pragma unroll
            for (int ks = 0; ks < 4; ++ks) { const bf16x8 bfr = *(const LAS bf16x8*)(src + (32 * ct + r) * PP_S + 16 * ks + 8 * h); acc = MFMA32(mf[ks], bfr, acc); }
            if (st < 2) {
#pragma unroll
                for (int gq = 0; gq < 4; ++gq) { u32x2 o; o.x = pk2(acc[4 * gq], acc[4 * gq + 1]); o.y = pk2(acc[4 * gq + 2], acc[4 * gq + 3]); *(LAS u32x2*)(dstt + (32 * ct + r) * PP_S + 32 * rt + 8 * gq + 4 * h) = o; }
                LDS_BARRIER();
            } else if (ct < 2) {
#pragma unroll
                for (int e2 = 0; e2 < 16; ++e2) Yf[(32 * rt + (e2 & 3) + 8 * (e2 >> 2) + 4 * h) * 64 + r] = acc[e2];
            } else { u32x4* dst = (u32x4*)(rec + REC_VT + ((rt * 2 + (ct - 2)) * 64 + lane) * 32); u32x4 o0, o1;
                o0.x = pk2(acc[0], acc[1]); o0.y = pk2(acc[2], acc[3]); o0.z = pk2(acc[4], acc[5]); o0.w = pk2(acc[6], acc[7]); o1.x = pk2(acc[8], acc[9]); o1.y = pk2(acc[10], acc[11]); o1.z = pk2(acc[12], acc[13]); o1.w = pk2(acc[14], acc[15]);
                dst[0] = o0; dst[1] = o1; }
        }
    }
    LDS_BARRIER();
    for (int task = w.tid; task < 1024; task += 512) { const int which = task >> 8, tk = task & 255;
        if (which == 0) copy_tile_pswap(RT2, rec + REC_RT, tk); else if (which == 1) copy_tile_pswap(ARBT, rec + REC_ARB, tk); else if (which == 2) copy_tile_pswap(BHT_T, rec + REC_BHT, tk); else copy_tile_pswap_f32(X1, rec + REC_WT, tk); }
}
DI f32x16 ld_acc_init(const unsigned char* p) { const u32x4 a = ((const u32x4*)p)[0], b = ((const u32x4*)p)[1]; f32x16 o;
    o[0] = bflo(a.x); o[1] = bfhi(a.x); o[2] = bflo(a.y); o[3] = bfhi(a.y); o[4] = bflo(a.z); o[5] = bfhi(a.z); o[6] = bflo(a.w); o[7] = bfhi(a.w);
    o[8] = bflo(b.x); o[9] = bfhi(b.x); o[10] = bflo(b.y); o[11] = bfhi(b.y); o[12] = bflo(b.z); o[13] = bfhi(b.z); o[14] = bflo(b.w); o[15] = bfhi(b.w); return o; }
DI void rwkv_scan_task(int lane, const unsigned char* recs, size_t rec_stride, int nch, int hd, int vh, int row0, const float* s_in, float* s_out, bf16_t* Ob, int dup) {
    const int r = lane & 31, h = lane >> 5, v = 32 * vh + r;
    f32x16 sT[2];
#pragma unroll
    for (int kt = 0; kt < 2; ++kt)
#pragma unroll
        for (int e = 0; e < 16; ++e) sT[kt][e] = s_in ? s_in[v * 64 + 32 * kt + (e & 3) + 8 * (e >> 2) + 4 * h] : 0.f;
#pragma unroll 1
    for (int cc = 0; cc < nch; ++cc) { const unsigned char* rec = recs + (size_t)cc * rec_stride;
        const bf16_t* WTp = (const bf16_t*)(rec + REC_WT); const bf16_t* BHp = (const bf16_t*)(rec + REC_BHT); const bf16_t* RTp = (const bf16_t*)(rec + REC_RT); const bf16_t* ARp = (const bf16_t*)(rec + REC_ARB);
        bf16x8 Sf[2][2], Uf[2][2];
#pragma unroll
        for (int kt = 0; kt < 2; ++kt) { Sf[kt][0] = pack8(sT[kt], 0); Sf[kt][1] = pack8(sT[kt], 1); }
#pragma unroll
        for (int rt = 0; rt < 2; ++rt) { f32x16 u = ld_acc_init(rec + REC_VT + ((rt * 2 + vh) * 64 + lane) * 32);
#pragma unroll
            for (int kt = 0; kt < 2; ++kt)
#pragma unroll
                for (int s2 = 0; s2 < 2; ++s2) { const bf16x8 a = *(const bf16x8*)(WTp + (32 * rt + r) * 64 + 32 * kt + 16 * s2 + 8 * h); u = MFMA32(a, Sf[kt][s2], u); }
            Uf[rt][0] = pack8(u, 0); Uf[rt][1] = pack8(u, 1); }
        f32x16 n[2];
#pragma unroll
        for (int kt = 0; kt < 2; ++kt) { n[kt] = ld_acc_init(rec + REC_VK + ((kt * 2 + vh) * 64 + lane) * 32);
#pragma unroll
            for (int rt = 0; rt < 2; ++rt)
#pragma unroll
                for (int s2 = 0; s2 < 2; ++s2) { const bf16x8 a = *(const bf16x8*)(BHp + (32 * kt + r) * 64 + 32 * rt + 16 * s2 + 8 * h); n[kt] = MFMA32(a, Uf[rt][s2], n[kt]); } }
#pragma unroll
        for (int rt = 0; rt < 2; ++rt) { f32x16 o = ld_acc_init(rec + REC_AKV + ((rt * 2 + vh) * 64 + lane) * 32);
#pragma unroll
            for (int kt = 0; kt < 2; ++kt)
#pragma unroll
                for (int s2 = 0; s2 < 2; ++s2) { const bf16x8 a = *(const bf16x8*)(RTp + (32 * rt + r) * 64 + 32 * kt + 16 * s2 + 8 * h); o = MFMA32(a, Sf[kt][s2], o); }
#pragma unroll
            for (int r2 = 0; r2 < 2; ++r2)
#pragma unroll
                for (int s2 = 0; s2 < 2; ++s2) { const bf16x8 a = *(const bf16x8*)(ARp + (32 * rt + r) * 64 + 32 * r2 + 16 * s2 + 8 * h); o = MFMA32(a, Uf[r2][s2], o); }
#pragma unroll
            for (int e = 0; e < 16; ++e) { const unsigned short ov = f2bf(o[e]); if (!dup) Ob[(size_t)(row0 + 64 * cc + 32 * rt + (e & 3) + 8 * (e >> 2) + 4 * h) * DM + hd * 64 + v] = ov; } }
        const float* pl = (const float*)(rec + REC_PL);
#pragma unroll
        for (int kt = 0; kt < 2; ++kt)
#pragma unroll
            for (int gq = 0; gq < 4; ++gq) { const f32x4 p4 = *(const f32x4*)(pl + 32 * kt + 8 * gq + 4 * h);
#pragma unroll
                for (int i = 0; i < 4; ++i) sT[kt][4 * gq + i] = p4[i] * sT[kt][4 * gq + i] + n[kt][4 * gq + i]; }
    }
#pragma unroll
    for (int kt = 0; kt < 2; ++kt)
#pragma unroll
        for (int e = 0; e < 16; ++e) { if (!dup) s_out[v * 64 + 32 * kt + (e & 3) + 8 * (e >> 2) + 4 * h] = sT[kt][e]; }
}
constexpr int SA_SLOT = 25600  , SA_VT = 16384, SA_VK = 20480, SA_PL = 24576, SX_OFF = 4 * SA_SLOT;
DI void sc_issue(const unsigned char* recs, size_t rec_stride, int nch, int cj, LAS unsigned char* L, int wave, int lane, int vh) {
    const int ca = cj < nch ? cj : nch - 1; const unsigned char* ra = recs + (size_t)ca * rec_stride; LAS unsigned char* sa = L + (cj & 3) * SA_SLOT;
    const int row8 = lane >> 3, c16 = (lane & 7) ^ (row8 & 7);
#pragma unroll
    for (int i = 0; i < 5; ++i) { const int j = (wave - 3) + 5 * i; const unsigned char* src; LAS unsigned char* dst;
        if (j < 16) { const int m = j >> 3, blk = j & 7; src = ra + m * 8192 + (8 * blk + row8) * 128 + c16 * 16; dst = sa + m * 8192 + blk * 1024; }
        else if (j < 24) { const int jj = j - 16, a = jj >> 2, piece = jj & 3; src = ra + REC_VT + a * 8192 + ((piece >> 1) * 2 + vh) * 2048 + (piece & 1) * 1024 + lane * 16; dst = sa + SA_VT + a * 4096 + piece * 1024; }
        else { src = ra + REC_PL + (lane & 15) * 16; dst = sa + SA_PL; }
        __builtin_amdgcn_global_load_lds((const unsigned*)src, (LAS unsigned*)dst, 16, 0, 0); }
}
DI f32x16 unpack_acc(u32x4 a, u32x4 b) { f32x16 o;
    o[0] = bflo(a.x); o[1] = bfhi(a.x); o[2] = bflo(a.y); o[3] = bfhi(a.y); o[4] = bflo(a.z); o[5] = bfhi(a.z); o[6] = bflo(a.w); o[7] = bfhi(a.w);
    o[8] = bflo(b.x); o[9] = bfhi(b.x); o[10] = bflo(b.y); o[11] = bfhi(b.y); o[12] = bflo(b.z); o[13] = bfhi(b.z); o[14] = bflo(b.w); o[15] = bfhi(b.w); return o; }
DI f32x16 ld_acc_init_lds(const LAS unsigned char* p) { return unpack_acc(((const LAS u32x4*)p)[0], ((const LAS u32x4*)p)[1]); }
DI bf16x8 sc_frag(const LAS unsigned char* mat, int row, int cidx) { return *(const LAS bf16x8*)(mat + row * 128 + ((cidx ^ (row & 7)) << 4)); }
DI void rwkv_scan_prompt(const WG& w, const unsigned char* recs, size_t rec_stride, int nch, int hd, int vh, int row0, const float* s_in, float* s_out, bf16_t* Ob, int dup) {
    const int lane = w.lane, wave = w.wave, r = lane & 31, h = lane >> 5, v = 32 * vh + r;
    LAS unsigned char* L = w.lds;
    if (wave == 0) {
        f32x16 sT[2];
#pragma unroll
        for (int kt = 0; kt < 2; ++kt)
#pragma unroll
            for (int e = 0; e < 16; ++e) sT[kt][e] = s_in ? s_in[v * 64 + 32 * kt + (e & 3) + 8 * (e >> 2) + 4 * h] : 0.f;
#pragma unroll
        for (int kt = 0; kt < 2; ++kt)
#pragma unroll
            for (int e = 0; e < 16; ++e) asm volatile("" : "+v"(sT[kt][e]));
        LDS_BARRIER();
#pragma unroll 1
        for (int cc = 0; cc < nch + 2; ++cc) {
            if (cc < nch && dup != 3) { const LAS unsigned char* sa = L + (cc & 3) * SA_SLOT; LAS unsigned char* ex = L + SX_OFF + (cc % 3) * 8192;
                bf16x8 Sf[4], Uf[4];
#pragma unroll
                for (int q = 0; q < 4; ++q) { Sf[q] = pack8(sT[q >> 1], q & 1); *(LAS bf16x8*)(ex + q * 1024 + lane * 16) = Sf[q]; }
                {   bf16x8 fa[2][4]; f32x16 u[2];
#pragma unroll
                    for (int rt = 0; rt < 2; ++rt) { u[rt] = ld_acc_init_lds(sa + SA_VT + rt * 2048 + lane * 32);
#pragma unroll
                        for (int q = 0; q < 4; ++q) fa[rt][q] = sc_frag(sa, 32 * rt + r, 2 * q + h); }
                    __builtin_amdgcn_sched_barrier(0);
#pragma unroll
                    for (int q = 0; q < 4; ++q)
#pragma unroll
                        for (int rt = 0; rt < 2; ++rt) u[rt] = MFMA32(fa[rt][q], Sf[q], u[rt]);
#pragma unroll
                    for (int q = 0; q < 4; ++q) { Uf[q] = pack8(u[q >> 1], q & 1); *(LAS bf16x8*)(ex + 4096 + q * 1024 + lane * 16) = Uf[q]; } }
                f32x16 n[2];
                {   bf16x8 fa[2][4];
#pragma unroll
                    for (int kt = 0; kt < 2; ++kt) { n[kt] = ld_acc_init_lds(sa + SA_VK + kt * 2048 + lane * 32);
#pragma unroll
                        for (int q = 0; q < 4; ++q) fa[kt][q] = sc_frag(sa + 8192, 32 * kt + r, 2 * q + h); }
                    __builtin_amdgcn_sched_barrier(0);
#pragma unroll
                    for (int q = 0; q < 4; ++q)
#pragma unroll
                        for (int kt = 0; kt < 2; ++kt) n[kt] = MFMA32(fa[kt][q], Uf[q], n[kt]); }
                const LAS float* pl = (const LAS float*)(sa + SA_PL);
#pragma unroll
                for (int kt = 0; kt < 2; ++kt)
#pragma unroll
                    for (int gq = 0; gq < 4; ++gq) { const f32x4 p4 = *(const LAS f32x4*)(pl + 32 * kt + 8 * gq + 4 * h);
#pragma unroll
                        for (int i = 0; i < 4; ++i) sT[kt][4 * gq + i] = p4[i] * sT[kt][4 * gq + i] + n[kt][4 * gq + i]; }
            }
            LDS_BARRIER();
        }
        LDS_BARRIER();
#pragma unroll
        for (int kt = 0; kt < 2; ++kt)
#pragma unroll
            for (int e = 0; e < 16; ++e) { if (!dup) s_out[v * 64 + 32 * kt + (e & 3) + 8 * (e >> 2) + 4 * h] = sT[kt][e]; }
    } else if (wave < 3) {
        bf16x8 gr[2][4], gu[2][4]; u32x4 ga[2][2];
        LDS_BARRIER();
#pragma unroll 1
        for (int cc = 0; cc < nch + 2; ++cc) {
            if ((((cc ^ wave) & 1) != 0) && dup != 3) { const int c2 = cc - 2;
                if (c2 >= 0) { const LAS unsigned char* ex = L + SX_OFF + (c2 % 3) * 8192;
                    bf16x8 Sf[4], Uf[4];
#pragma unroll
                    for (int q = 0; q < 4; ++q) { Sf[q] = *(const LAS bf16x8*)(ex + q * 1024 + lane * 16); Uf[q] = *(const LAS bf16x8*)(ex + 4096 + q * 1024 + lane * 16); }
                    f32x16 o[2];
#pragma unroll
                    for (int rt = 0; rt < 2; ++rt) o[rt] = unpack_acc(ga[rt][0], ga[rt][1]);
#pragma unroll
                    for (int q = 0; q < 4; ++q)
#pragma unroll
                        for (int rt = 0; rt < 2; ++rt) o[rt] = MFMA32(gr[rt][q], Sf[q], o[rt]);
#pragma unroll
                    for (int q = 0; q < 4; ++q)
#pragma unroll
                        for (int rt = 0; rt < 2; ++rt) o[rt] = MFMA32(gu[rt][q], Uf[q], o[rt]);
                    bf16_t* op = Ob + (size_t)(row0 + 64 * c2 + 4 * h) * DM + hd * 64 + v;
#pragma unroll
                    for (int rt = 0; rt < 2; ++rt)
#pragma unroll
                        for (int e = 0; e < 16; ++e) { const unsigned short ov = f2bf(o[rt][e]); if (!dup) op[(size_t)(32 * rt + (e & 3) + 8 * (e >> 2)) * DM] = ov; }
                }
                if (cc < nch) { const unsigned char* rec = recs + (size_t)cc * rec_stride;
#pragma unroll
                    for (int rt = 0; rt < 2; ++rt) { const u32x4* ap = (const u32x4*)(rec + REC_AKV + ((rt * 2 + vh) * 64 + lane) * 32); ga[rt][0] = ap[0]; ga[rt][1] = ap[1];
#pragma unroll
                        for (int q = 0; q < 4; ++q) { gr[rt][q] = *(const bf16x8*)(rec + REC_RT + ((32 * rt + r) * 64 + 16 * q + 8 * h) * 2); gu[rt][q] = *(const bf16x8*)(rec + REC_ARB + ((32 * rt + r) * 64 + 16 * q + 8 * h) * 2); } } }
            }
            LDS_BARRIER();
        }
        LDS_BARRIER();
    } else {
        sc_issue(recs, rec_stride, nch, 0, L, wave, lane, vh); sc_issue(recs, rec_stride, nch, 1, L, wave, lane, vh); sc_issue(recs, rec_stride, nch, 2, L, wave, lane, vh); asm volatile("s_waitcnt vmcnt(10)" ::: "memory");
        LDS_BARRIER();
#pragma unroll 1
        for (int cc = 0; cc < nch + 2; ++cc) { sc_issue(recs, rec_stride, nch, cc + 3, L, wave, lane, vh); if (dup != 2) asm volatile("s_waitcnt vmcnt(10)" ::: "memory");
            LDS_BARRIER(); }
        asm volatile("s_waitcnt vmcnt(0)" ::: "memory");
        LDS_BARRIER();
    }
}
DI float sum8_dpp(float v) {
#define DPP_ADD_(ctrl) v += __builtin_bit_cast(float, __builtin_amdgcn_update_dpp(0, __builtin_bit_cast(int, v), ctrl, 0xf, 0xf, true));
    DPP_ADD_(0xB1) DPP_ADD_(0x4E) DPP_ADD_(0x141)
#undef DPP_ADD_
    return v;
}
constexpr int FIN_RPW = 36, FIN_RG_A = (MP - 64 * WSEG) / FIN_RPW  , FIN_RG_B = (MP + FIN_RPW - 1) / FIN_RPW  ;
template <bool EARLY> DI void rwkv_final_phase(const WG& w, const RwkvIn& in, bf16_t* Odst, int gw, int ngw) {
    constexpr int RPW = FIN_RPW, NRG = M / RPW, NE = FIN_RG_A + (NRG - FIN_RG_B), NL = FIN_RG_B - FIN_RG_A;
    for (int task = gw; task < 4 * (EARLY ? NE : NL); task += ngw) { const int cq = task & 3, ix = task >> 2, rg = EARLY ? (ix < FIN_RG_A ? ix : ix - FIN_RG_A + FIN_RG_B) : ix + FIN_RG_A, m0 = rg * RPW, c0 = 512 * cq + 8 * w.lane, hd = c0 >> 6;
        const f32x4 w0 = *(const f32x4*)(in.ln_w + c0), w1 = *(const f32x4*)(in.ln_w + c0 + 4), b0 = *(const f32x4*)(in.ln_b + c0), b1 = *(const f32x4*)(in.ln_b + c0 + 4);
        const float lw8[8] = {w0.x, w0.y, w0.z, w0.w, w1.x, w1.y, w1.z, w1.w}, lb8[8] = {b0.x, b0.y, b0.z, b0.w, b1.x, b1.y, b1.z, b1.w};
#pragma unroll 4
        for (int rr = 0; rr < RPW; ++rr) { const int m = m0 + rr; const size_t off = (size_t)m * DM + c0;
            const u32x4 ov = *(const u32x4*)(in.Ob + off), vv = *(const u32x4*)(in.Vb + off), gv = *(const u32x4*)(in.Gb + off);
            const float bon = in.bonus[(size_t)m * WH + hd];
            float o[8] = {bflo(ov.x), bfhi(ov.x), bflo(ov.y), bfhi(ov.y), bflo(ov.z), bfhi(ov.z), bflo(ov.w), bfhi(ov.w)};
            const float vf[8] = {bflo(vv.x), bfhi(vv.x), bflo(vv.y), bfhi(vv.y), bflo(vv.z), bfhi(vv.z), bflo(vv.w), bfhi(vv.w)};
            const float gf[8] = {bflo(gv.x), bfhi(gv.x), bflo(gv.y), bfhi(gv.y), bflo(gv.z), bfhi(gv.z), bflo(gv.w), bfhi(gv.w)};
            float s1 = 0.f;
#pragma unroll
            for (int e = 0; e < 8; ++e) s1 += o[e];
            const float mean = sum8_dpp(s1) * (1.f / 64.f); float s2 = 0.f;
#pragma unroll
            for (int e = 0; e < 8; ++e) { o[e] -= mean; s2 += o[e] * o[e]; }
            const float rs = 1.f / sqrtf(sum8_dpp(s2) * (1.f / 64.f) + 64e-5f);
#pragma unroll
            for (int e = 0; e < 8; ++e) o[e] = (o[e] * rs * lw8[e] + lb8[e] + bon * vf[e]) * gf[e];
            u32x4 r; r.x = pk2(o[0], o[1]); r.y = pk2(o[2], o[3]); r.z = pk2(o[4], o[5]); r.w = pk2(o[6], o[7]); *(u32x4*)(Odst + off) = r; }
    }
}
DI void rwkv_phi(const WG& w, const RwkvIn& in, int k, unsigned char* seg0, unsigned char* seg1, unsigned char* sbuf, const float* st_in, float* outP, float* outS, int dup, gu32* qctr, volatile LAS unsigned* qw) {
    if (k >= 1 && w.bid < 64) {
        const int sg = k - 1, hd = w.bid >> 1, vh = w.bid & 1; const unsigned char* sb = (sg & 1) ? seg1 : seg0; float* st = outP + (size_t)hd * 4096;
        rwkv_scan_prompt(w, sb + (size_t)hd * REC, (size_t)WH * REC, WSEG, hd, vh, 64 * WSEG * sg, sg == 0 ? nullptr : st, st, in.Ob, dup);
    }
    {
        const int nseg = (k < WNSEG) ? WSEG * WH : 0, nsmp = (k == 1 || k == 2) ? 512 : 0, lo = (k - 1) * 512, ntot = nseg + nsmp;
        unsigned char* sb = (k & 1) ? seg1 : seg0;
#define PAIR_OF(q, cvar, hvar, rvar) { if ((q) < nseg) { cvar = WSEG * k + ((q) >> 5); hvar = (q) & 31; rvar = sb + (size_t)(q) * REC; } else { const int p_ = lo + (q) - nseg; cvar = NCHP + (p_ >> 5); hvar = p_ & 31; rvar = sbuf + (size_t)p_ * REC; } }
#define Q_FETCH(var) { if (w.tid == 0) qw[0] = __hip_atomic_fetch_add(qctr, 1u, __ATOMIC_RELAXED, __HIP_MEMORY_SCOPE_AGENT); LDS_BARRIER(); var = (int)qw[0]; LDS_BARRIER(); }
        if (ntot > 0) {
            PrepRaw cur, nxt; int q, qn; Q_FETCH(q) Q_FETCH(qn)
            if (q < ntot) { int c0, h0; unsigned char* r0; PAIR_OF(q, c0, h0, r0) (void)r0; prep_load(w, in, c0, h0, cur); }
#pragma unroll 1
            while (q < ntot) { int cc_, hh_; unsigned char* rr_; PAIR_OF(q, cc_, hh_, rr_)
                if (qn < ntot) { int c1, h1; unsigned char* r1; PAIR_OF(qn, c1, h1, r1) (void)r1; prep_load(w, in, c1, h1, nxt); }
                rwkv_prep_pair(w, in, cc_, hh_, rr_, cur, qctr, qw);
                const int q2 = (int)qw[0];
                cur = nxt; q = qn; qn = q2; }
        }
#undef Q_FETCH
#undef PAIR_OF
    }
    if (k == 3) { const int nb = w.G, b0 = w.bid;
        for (int id = b0 * 8 + w.wave; id < DBATCH * WH * 2; id += nb * 8) { const int p = id >> 1, vh = id & 1, b = p >> 5, hd = p & 31;
            rwkv_scan_task(w.lane, sbuf + (size_t)p * REC, 0, 1, hd, vh, MP + 64 * b, st_in + (size_t)p * 4096, outS + (size_t)p * 4096, in.Ob, dup); } }
    if (k == WNSEG && w.bid >= 64 && !dup) rwkv_final_phase<true>(w, in, in.Ob, (w.bid - 64) * 8 + w.wave, (w.G - 64) * 8);
}
constexpr size_t MiB = (size_t)1 << 20;
constexpr size_t WS_CTL = 0, CTL_ZERO_BYTES = 1 * MiB;
constexpr size_t WS_WUP = 1 * MiB, WS_WDN = 33 * MiB, WS_WMIX = 65 * MiB, WS_H = 129 * MiB, WS_BIG = 201 * MiB, WS_SS = WS_BIG + 777 * MiB, WS_WUP2 = WS_SS + 23 * MiB, WS_END = WS_WUP2 + 32 * MiB;
constexpr size_t U72 = 72 * MiB;
constexpr int CW_BAR = 4096, CW_QUEUE = 16384, CW_SPLIT = 65536;
constexpr int LDS_BYTES = 163840, LDSCTL_OFF = LDS_BYTES - 512, MISC_OFF = LDSCTL_OFF + 320;
constexpr int NPHASE = 36;

constexpr size_t O_Y = 0, O_KP = (size_t)M * DM, O_VP = O_KP + 65536, O_KS = O_VP + 65536, O_VS = O_KS + 2097152, O_RP = O_VS + 2097152, O_RS = O_RP + 1048576,
                 O_WP = O_RS + 33554432, O_WS = O_WP + 131072, O_SHP = O_WS + 4194304, O_SHS = O_SHP + 2048, O_END = O_SHS + 65536;

struct Args { const float* in[34]; float* out; unsigned char* ws; int ph_lo, ph_hi, dup, pad; };

DI void up_convert(const WG& w, const Args& a, int layer, int b0, int nb, int part = 0) { convert_w(w, a.in[32] + (size_t)layer * DM * DFF, DM, DFF, (bf16_t*)(a.ws + ((layer & 1) ? WS_WUP2 : WS_WUP)), DM, DFF, a.in[8] + (size_t)layer * DM, b0, nb, part); }
DI void dn_convert(const WG& w, const Args& a, int layer, int b0, int nb, int part = 0) { convert_w(w, a.in[33] + (size_t)layer * DFF * DM, DFF, DM, (bf16_t*)(a.ws + WS_WDN), DFF, DM, nullptr, b0, nb, part); }
DI void attn_convert(const WG& w, const Args& a, int j, int layer, int b0, int nb, int part = 0) {
    convert_w(w, a.in[10] + (size_t)j * DM * AQKV, DM, AQKV, (bf16_t*)(a.ws + WS_WMIX), DM, AQKV, a.in[7] + (size_t)layer * DM, b0, nb, part);
    convert_w(w, a.in[12] + (size_t)j * DM * DM, DM, DM, (bf16_t*)(a.ws + WS_WMIX + 10 * MiB), DM, DM, nullptr, b0, nb, part);
}
DI void ret_convert(const WG& w, const Args& a, int b0, int nb, int part = 0) {
    convert_w(w, a.in[13], DM, RIN, (bf16_t*)(a.ws + WS_WMIX), DM, RIN, a.in[7] + 1 * DM, b0, nb, part); convert_w(w, a.in[15], RVD, DM, (bf16_t*)(a.ws + WS_WMIX + 48 * MiB), RVD, DM, nullptr, b0, nb, part);
}
DI void rwkv_convert(const WG& w, const Args& a, int b0, int nb, int part = 0) {
    unsigned char* WMIX = a.ws + WS_WMIX;
#pragma unroll 1
    for (int z = 0; z < 3; ++z) convert_w(w, a.in[17] + (size_t)z * DM * DM, DM, DM, (bf16_t*)(WMIX + (size_t)z * 8 * MiB), DM, DM, nullptr, b0, nb, part);
    convert_w(w, a.in[18], DM, DM, (bf16_t*)(WMIX + 24 * MiB), DM, DM, nullptr, b0, nb, part);
    convert_w(w, a.in[20], DM, 96, (bf16_t*)(WMIX + 32 * MiB), DM, 256, nullptr, b0, nb, part); convert_w(w, a.in[23], DM, 96, (bf16_t*)(WMIX + 33 * MiB), DM, 256, nullptr, b0, nb, part); convert_w(w, a.in[25], DM, 256, (bf16_t*)(WMIX + 34 * MiB), DM, 256, nullptr, b0, nb, part);
    convert_w(w, a.in[21], 96, DM, (bf16_t*)(WMIX + 35 * MiB), 256, DM, nullptr, b0, nb, part); convert_w(w, a.in[24], 96, DM, (bf16_t*)(WMIX + 36 * MiB), 256, DM, nullptr, b0, nb, part); convert_w(w, a.in[26], 256, DM, (bf16_t*)(WMIX + 37 * MiB), 256, DM, nullptr, b0, nb, part);
}

__global__ void __launch_bounds__(512, 2) fwd_kernel(Args args) {
    extern __shared__ __attribute__((aligned(16))) unsigned char lds_raw[];
    WG w; w.lds = (LAS unsigned char*)lds_raw; w.tid = threadIdx.x; w.lane = w.tid & 63; w.wave = __builtin_amdgcn_readfirstlane(w.tid >> 6);
    w.G = gridDim.x; w.bid = blockIdx.x; w.gw = w.bid * 8 + w.wave; w.ngw = w.G * 8;
    volatile LAS unsigned* MISC = (volatile LAS unsigned*)(w.lds + MISC_OFF);
    for (int u = w.tid; u < (LDS_BYTES - LDSCTL_OFF) / 4; u += 512) ((LAS unsigned*)(w.lds + LDSCTL_OFF))[u] = 0u;
    __syncthreads();
    unsigned char* ws = args.ws; gu32* ctl = (gu32*)(ws + WS_CTL);
    XcdBarrier bar; bar.bar = (unsigned*)(ctl + CW_BAR); bar.x = 0; bar.st = nullptr;
#if !MK_PER_PHASE
    bar = xcd_barrier_post((unsigned*)(ctl + CW_BAR), MISC + 8, w.wave);
#endif
    const int lo = args.ph_lo, hi = args.ph_hi;
    bf16_t* XBO = args.dup ? (bf16_t*)(ws + WS_BIG + 432 * MiB) : (bf16_t*)(ws + WS_H); const size_t ssd = args.dup ? ((WS_BIG + 504 * MiB) - WS_SS) / 4 : 0;
    bf16_t* XB = (bf16_t*)(ws + WS_H);
    float* SS = (float*)(ws + WS_SS);
    bf16_t* WUP = (bf16_t*)(ws + WS_WUP); bf16_t* WUP2 = (bf16_t*)(ws + WS_WUP2); bf16_t* WDN = (bf16_t*)(ws + WS_WDN); unsigned char* WMIX = ws + WS_WMIX; unsigned char* BIG = ws + WS_BIG;
    const float* norm_mix = args.in[7];
    int ph = 0;
#if MK_PER_PHASE
#define SEAM() do { } while (0)
#else
#define SEAM() xcd_barrier(bar, w.wave)
#endif
#define PH_BEGIN if (ph >= lo && ph < hi) { { const int l_ = lane_now(); w.lane = l_; w.tid = w.wave * 64 + l_; }
#define PH_END   if (ph + 1 < hi) SEAM(); } ++ph;
#define GEMM_LDS ((PG8_LAS unsigned char*)w.lds)
#define SSQ(s) (SS + (size_t)(s) * M * 32)
#define RSTAB ((const LAS float*)(w.lds + pg8::RSTAB_OFF))
#define SK_SLAB ((float*)(BIG + 300 * MiB))
#define SK_CNT ((unsigned*)(ctl + CW_SPLIT + (size_t)(ph * 16 + (args.dup & 15)) * 256))
#define SK_SETUP if (w.tid == 0) { volatile LAS unsigned long long* skp_ = (volatile LAS unsigned long long*)(w.lds + pg8::SK_LDS_OFF); skp_[0] = (unsigned long long)SK_SLAB; }
#define GEMM_RESID_SK(Aexpr, Wexpr, Kdim, ssq_, nsl_) { pg8::Gemm g{Aexpr, Wexpr, M, DM, Kdim, 0, 0}; pg8::Order S; S.init_full_rounds(M, DM, w.G, w.bid); pg8::EpiResid E{nullptr, nullptr, XBO, ssq_}; pg8::gemm_phase<pg8::EpiResid>(GEMM_LDS, g, S, E, w.wave); \
        pg8::OrderSK S2; S2.init(M, DM, w.G, w.bid, nsl_); pg8::Unit u2; if (!(args.dup & 32) && S2.next(0, u2, (Kdim) / 64)) { SK_SETUP const int st_ = w.bid % (w.G >> 2), ks_ = w.bid / (w.G >> 2); pg8::EpiSlab E2{(const LAS unsigned*)(w.lds + pg8::SK_LDS_OFF), st_ * 4 + ks_}; \
            pg8::gemm_phase<pg8::EpiSlab, true, true, true, pg8::OrderSK>(GEMM_LDS, g, S2, E2, w.wave); pg8::sk_reduce(w.lds, SK_SLAB, SK_CNT, u2, st_, ks_, nsl_, XBO, ssq_, w.wave); } }
#define TAIL_SK 192
#define TAIL_B0 64
#define MLP_PHASES(s_in, nsl_, wup_, tail_stmt) \
    PH_BEGIN { pg8::Gemm g{XB, wup_, M, DFF, DM, 0, 0}; pg8::Order S; S.init(M, DFF, 1, w.G, w.bid); pg8::fill_rs_table(w.lds, S, SSQ(s_in), w.tid); pg8::EpiRelu2 E{(bf16_t*)BIG, DFF, RSTAB}; pg8::gemm_phase<pg8::EpiRelu2>(GEMM_LDS, g, S, E, w.wave); } PH_END \
    PH_BEGIN { GEMM_RESID_SK((bf16_t*)BIG, WDN, DFF, SSQ((s_in) + 1) + ssd, nsl_) if (!(args.dup & 16)) { tail_stmt } } PH_END
#define ATTN_PHASES(j, resP_, resS_, s_in, tail_stmt) { \
    bf16_t* Qb = (bf16_t*)BIG; bf16_t* Kb = (bf16_t*)(BIG + 72 * MiB); bf16_t* Vb = (bf16_t*)(BIG + 81 * MiB); bf16_t* AO = (bf16_t*)(BIG + 90 * MiB); \
    const float* ck = args.in[2] + (size_t)(j) * 1048576; const float* cv = args.in[3] + (size_t)(j) * 1048576; \
    float* kS = args.out + O_KS + (size_t)(j) * 1048576; float* vS = args.out + O_VS + (size_t)(j) * 1048576; \
    PH_BEGIN { pg8::Gemm g{XB, (bf16_t*)WMIX, M, AQKV, DM, 0, 0}; pg8::Order S; S.init(M, AQKV, 1, w.G, w.bid); pg8::fill_rs_table(w.lds, S, SSQ(s_in), w.tid); pg8::EpiAttnQKV E{Qb, args.out, O_KP + (size_t)(j) * 32768, O_KS + (size_t)(j) * 1048576, RSTAB}; pg8::gemm_phase<pg8::EpiAttnQKV>(GEMM_LDS, g, S, E, w.wave); } PH_END \
    PH_BEGIN attn_phase(w, Qb, Kb, Vb, ck, cv, args.in[11] + (j) * AH, AO); cache_shift(w, ck, cv, kS, vS); PH_END \
    PH_BEGIN { pg8::Gemm g{AO, (bf16_t*)(WMIX + 10 * MiB), M, DM, DM, 0, 0}; pg8::Order S; S.init(M, DM, 1, w.G, w.bid); pg8::EpiResid E{resP_, resS_, XBO, SSQ((s_in) + 1) + ssd}; pg8::gemm_phase<pg8::EpiResid>(GEMM_LDS, g, S, E, w.wave); tail_stmt } PH_END }

    PH_BEGIN rows0(w, args.in[0], args.in[1], XB, SSQ(0)); attn_convert(w, args, 0, 0, 0, 0); up_convert(w, args, 0, 0, 0); PH_END
    ATTN_PHASES(0, args.in[0], args.in[1], 0, dn_convert(w, args, 0, TAIL_B0, w.G - TAIL_B0); up_convert(w, args, 1, TAIL_B0, w.G - TAIL_B0);)
    MLP_PHASES(1, 3, WUP, ret_convert(w, args, TAIL_SK, w.G - TAIL_SK);)
    {
        bf16_t* P = (bf16_t*)BIG; bf16_t* RO = (bf16_t*)(BIG + 432 * MiB);
        PH_BEGIN { pg8::Gemm g{XB, (bf16_t*)WMIX, M, RIN, DM, 0, 0}; pg8::Order S; S.init(M, RIN, 1, w.G, w.bid); pg8::fill_rs_table(w.lds, S, SSQ(2), w.tid); pg8::EpiRetProj E{P, RSTAB}; pg8::gemm_phase<pg8::EpiRetProj>(GEMM_LDS, g, S, E, w.wave); } PH_END
        bf16_t* slots = (bf16_t*)(BIG + 576 * MiB);
        PH_BEGIN ret_chain_phase<0>(w, P, RO, args.in[4], slots, args.out + O_RS, 0); PH_END
        PH_BEGIN ret_prefix_phase(w, slots, args.out + O_RP); PH_END
        PH_BEGIN ret_chain_phase<1>(w, P, RO, args.in[4], slots, args.out + O_RS, args.dup); PH_END
        PH_BEGIN ret_gn_phase(w, P, RO, args.in[14], args.dup ? (bf16_t*)(BIG + 576 * MiB) : RO); PH_END
        PH_BEGIN { GEMM_RESID_SK(RO, (bf16_t*)(WMIX + 48 * MiB), RVD, SSQ(3) + ssd, 3) dn_convert(w, args, 1, TAIL_SK, w.G - TAIL_SK); } PH_END
    }
    MLP_PHASES(3, 3, WUP2, rwkv_convert(w, args, TAIL_SK, w.G - TAIL_SK); up_convert(w, args, 2, TAIL_SK, w.G - TAIL_SK);)
    {
        bf16_t* XL = (bf16_t*)BIG; bf16_t* Rb = (bf16_t*)(BIG + 432 * MiB); bf16_t* L1 = (bf16_t*)(BIG + 648 * MiB);
        float* LW = (float*)BIG; bf16_t* Ab = (bf16_t*)(BIG + 144 * MiB); bf16_t* Gb = (bf16_t*)(BIG + 216 * MiB);
        unsigned char* seg0 = BIG + 288 * MiB; unsigned char* seg1 = BIG + 345 * MiB; float* bonus = (float*)(BIG + 402 * MiB); unsigned char* sbuf = BIG + 648 * MiB;
        bf16_t* Ob = (bf16_t*)(BIG + 705 * MiB);
        RwkvIn rin{Rb, Rb + (size_t)M * DM, Rb + (size_t)2 * M * DM, Ab, Gb, LW, args.in[27], args.in[28], args.in[29], args.in[30], args.in[31], bonus, Ob};
        PH_BEGIN lerp_rows(w, XB, SSQ(4), norm_mix + 2 * DM, args.in[6], args.in[16], XL, args.out + O_SHP, args.out + O_SHS); PH_END
        PH_BEGIN { { pg8::Gemm g{XL, (bf16_t*)WMIX, M, DM, DM, U72, 8 * MiB}; pg8::Order S; S.init(M, DM, 3, w.G, w.bid); pg8::EpiAct E{Rb, DM, (size_t)M * DM, 0, (const LAS float*)nullptr}; pg8::gemm_phase<pg8::EpiAct>(GEMM_LDS, g, S, E, w.wave); }
                   { pg8::Gemm g{XL + (size_t)3 * M * DM, (bf16_t*)(WMIX + 32 * MiB), M, 256, DM, U72, 1 * MiB}; pg8::Order S; S.init(M, 256, 3, w.G, w.bid); pg8::EpiAct E{L1, 256, (size_t)M * 256, 2 | (0 << 4) | (3 << 8), (const LAS float*)nullptr}; pg8::gemm_phase<pg8::EpiAct>(GEMM_LDS, g, S, E, w.wave); } } PH_END
        PH_BEGIN { int k2 = 256; asm volatile("" : "+s"(k2));     pg8::Gemm g{L1, (bf16_t*)(WMIX + 35 * MiB), M, DM, k2, (size_t)M * 256 * 2, 1 * MiB}; pg8::Order S; S.init(M, DM, 3, w.G, w.bid); pg8::EpiRwkv2 E{LW, Ab, args.in[19], args.in[22]}; pg8::gemm_phase<pg8::EpiRwkv2>(GEMM_LDS, g, S, E, w.wave); } PH_END
#pragma unroll 1
        for (int k = 0; k < 9; ++k) { PH_BEGIN rwkv_phi(w, rin, k, seg0, seg1, sbuf, args.in[5], args.out + O_WP, args.out + O_WS, args.dup, ctl + CW_QUEUE + 64 * (k + 16 * (args.dup & 15)), MISC + 16); PH_END }
        PH_BEGIN rwkv_final_phase<false>(w, rin, args.dup ? (bf16_t*)(BIG + 576 * MiB) : Ob, w.gw, w.ngw); PH_END
        PH_BEGIN { pg8::Gemm g{Ob, (bf16_t*)(WMIX + 24 * MiB), M, DM, DM, 0, 0}; pg8::Order S; S.init(M, DM, 1, w.G, w.bid); pg8::EpiResid E{nullptr, nullptr, XBO, SSQ(5) + ssd}; pg8::gemm_phase<pg8::EpiResid>(GEMM_LDS, g, S, E, w.wave); dn_convert(w, args, 2, TAIL_B0, w.G - TAIL_B0); up_convert(w, args, 3, TAIL_B0, w.G - TAIL_B0); } PH_END
    }
    MLP_PHASES(5, 3, WUP, attn_convert(w, args, 1, 3, TAIL_SK, w.G - TAIL_SK);)
    ATTN_PHASES(1, (const float*)nullptr, (const float*)nullptr, 6, dn_convert(w, args, 3, TAIL_B0, w.G - TAIL_B0);)
    PH_BEGIN { pg8::Gemm g{XB, WUP2, M, DFF, DM, 0, 0}; pg8::Order S; S.init(M, DFF, 1, w.G, w.bid); pg8::fill_rs_table(w.lds, S, SSQ(7), w.tid); pg8::EpiRelu2 E{(bf16_t*)BIG, DFF, RSTAB}; pg8::gemm_phase<pg8::EpiRelu2>(GEMM_LDS, g, S, E, w.wave); } PH_END
    PH_BEGIN { GEMM_RESID_SK((bf16_t*)BIG, WDN, DFF, SSQ(8) + ssd, 3) } PH_END
    PH_BEGIN final_norm(w, XB, SSQ(8), args.in[9], args.out); PH_END
}

extern "C" void kernel_launch(void* const* d_in, const int* in_sizes, int n_in, void* d_out, int out_size, void* d_ws, size_t ws_size, hipStream_t stream) {
    static int grid = 0;
    if (grid == 0) {
        if (n_in != 34 || (size_t)out_size != O_END || ws_size < WS_END) { fprintf(stderr, "kernel_launch: unexpected shapes: n_in %d out %d ws %zu (need %zu)\n", n_in, out_size, ws_size, (size_t)WS_END); grid = -1; return; }
        int dev = 0, cus = 0;
        if (hipGetDevice(&dev) != hipSuccess || hipDeviceGetAttribute(&cus, hipDeviceAttributeMultiprocessorCount, dev) != hipSuccess) { grid = -1; return; }
        if (hipFuncSetAttribute((const void*)fwd_kernel, hipFuncAttributeMaxDynamicSharedMemorySize, LDS_BYTES) != hipSuccess) { fprintf(stderr, "kernel_launch: hipFuncSetAttribute failed\n"); grid = -1; return; }
        int per_cu = 0;
        if (hipOccupancyMaxActiveBlocksPerMultiprocessor(&per_cu, (const void*)fwd_kernel, 512, LDS_BYTES) != hipSuccess || per_cu < 1) { fprintf(stderr, "kernel_launch: occupancy query reports %d\n", per_cu); }
        (void)hipGetLastError();
        grid = cus;
    }
    if (grid < 0) return;
    (void)hipMemsetAsync((char*)d_ws + WS_CTL, 0, CTL_ZERO_BYTES, stream);
    Args a{};
    for (int i = 0; i < 34; ++i) a.in[i] = (const float*)d_in[i];
    a.out = (float*)d_out; a.ws = (unsigned char*)d_ws;
#if MK_PER_PHASE
    static const unsigned char REP[NPHASE] = { 1 };
    for (int p = 0; p < NPHASE; ++p) for (int r = 0; r < REP[p]; ++r) { a.ph_lo = p; a.ph_hi = p + 1; a.dup = (r == 0) ? 0 : 1; hipLaunchKernelGGL(fwd_kernel, dim3(grid), dim3(512), LDS_BYTES, stream, a); }
#else
    a.ph_lo = 0; a.ph_hi = NPHASE;
    hipLaunchKernelGGL(fwd_kernel, dim3(grid), dim3(512), LDS_BYTES, stream, a);
#endif
}
```
